# Optimizing an MI355X kernel written in HIP

```python
import math
import jax, jax.numpy as jnp
from jax import lax
import numpy as np

D_MODEL = 1024
BATCH = 2
SEQ = 16384
DEPTH = 2

GRID_W = 64
CTX_LEN = 256
EPS = 1e-6
F32 = jnp.float32

N_EVEN = (DEPTH + 1) // 2
N_ODD = DEPTH // 2

DA_HEADS = 4
DA_QK_DIM = 64
DA_V_DIM = 2 * DA_QK_DIM
DA_SCALE = DA_QK_DIM ** -0.5
DA_QBLOCK = 128
ROPE_THETA = 10000.0
ROPE_PAIRS = DA_QK_DIM // 4
DA_QW = DA_HEADS * 2 * DA_QK_DIM
DA_VW = DA_HEADS * DA_V_DIM
DA_IN = 2 * DA_QW + DA_VW

GDN_HEADS = 4
GDN_DK = 128
GDN_DV = 128
GDN_CONV = 4
GDN_CHUNK = 64
GDN_W = GDN_HEADS * GDN_DK
GDN_VW = GDN_HEADS * GDN_DV
GDN_IN = 2 * GDN_W + 2 * GDN_VW + 4 * GDN_HEADS

L0_IN = DA_IN + GDN_IN
MIX0_OUT = DA_VW + GDN_VW

LRU_WIDTH = D_MODEL
LRU_BLOCKS = 8
LRU_BW = LRU_WIDTH // LRU_BLOCKS
LRU_CONV = 4
LRU_C = 8.0

FFN_HIDDEN = int(math.ceil(8 * D_MODEL / 3 / 256)) * 256

kernel_name = "hybrid_diffattn_gdn_rglru_prefix_dit"


def rmsnorm(x, gain):
    xf = x.astype(F32)
    y = xf * lax.rsqrt(jnp.mean(xf * xf, axis=-1, keepdims=True) + EPS)
    return (y * gain.astype(F32)).astype(x.dtype)


def l2norm(x):
    xf = x.astype(F32)
    return (xf * lax.rsqrt(jnp.sum(xf * xf, axis=-1, keepdims=True) + EPS)).astype(x.dtype)


def ada_mod(cond, w, b):
    m = jax.nn.silu(cond) @ w + b
    return jnp.split(m[..., None, :], 6, axis=-1)


def modulate(h, gain, shift, scale):
    return rmsnorm(h, gain) * (1.0 + scale) + shift


def swiglu(h, w_gu, w_down):
    gu = h @ w_gu
    return (jax.nn.silu(gu[..., :FFN_HIDDEN]) * gu[..., FFN_HIDDEN:]) @ w_down


def short_conv_centred(x, w):
    K = w.shape[0]
    n = x.shape[1]
    left = K // 2
    xp = jnp.pad(x, ((0, 0), (left, K - 1 - left), (0, 0)))
    out = xp[:, 0:n] * w[0]
    for j in range(1, K):
        out = out + xp[:, j:j + n] * w[j]
    return out


def axial_rope_tables(row, col):
    inv = ROPE_THETA ** (-jnp.arange(ROPE_PAIRS, dtype=F32) / ROPE_PAIRS)
    ang = jnp.stack([row.astype(F32)[:, None] * inv, col.astype(F32)[:, None] * inv], axis=1)
    return jnp.cos(ang), jnp.sin(ang)


def apply_axial_rope(x, cos, sin):
    shp = x.shape
    xr = x.astype(F32).reshape(shp[:-1] + (2, 2, ROPE_PAIRS))
    x1, x2 = xr[..., 0, :], xr[..., 1, :]
    c = cos[:, None, None]
    s = sin[:, None, None]
    out = jnp.stack([x1 * c - x2 * s, x2 * c + x1 * s], axis=-2)
    return out.reshape(shp).astype(x.dtype)


def diff_softmax_attend(q, k, v, lam):
    s = jnp.einsum('bqhmd,bkhmd->bhmqk', q, k, preferred_element_type=F32) * DA_SCALE
    p = jax.nn.softmax(s, axis=-1)
    w = p[:, :, 0] - lam * p[:, :, 1]
    return jnp.einsum('bhqk,bkhe->bqhe', w.astype(v.dtype), v)


def diff_attn_blocked(q, k, v, lam):
    B, T = q.shape[:2]
    nb = T // DA_QBLOCK
    qb = q.reshape((B, nb, DA_QBLOCK) + q.shape[2:]).swapaxes(0, 1)
    ob = lax.map(lambda qq: diff_softmax_attend(qq, k, v, lam), qb)
    return ob.swapaxes(0, 1).reshape((B, T) + ob.shape[3:])


def diff_attention(u_c, u_x, cos, sin, lambda_init, need_ctx,
                   q_norm, k_norm, lam_q1, lam_k1, lam_q2, lam_k2, sub_norm):
    def split(u):
        B, n, _ = u.shape
        q = rmsnorm(u[..., :DA_QW].reshape(B, n, DA_HEADS, 2, DA_QK_DIM), q_norm)
        k = rmsnorm(u[..., DA_QW:2 * DA_QW].reshape(B, n, DA_HEADS, 2, DA_QK_DIM), k_norm)
        v = u[..., 2 * DA_QW:DA_IN].reshape(B, n, DA_HEADS, DA_V_DIM)
        return q, k, v

    qc, kc, vc = split(u_c)
    qx, kx, vx = split(u_x)
    qx = apply_axial_rope(qx, cos, sin)
    kx = apply_axial_rope(kx, cos, sin)
    lam = (jnp.exp(jnp.sum(lam_q1.astype(F32) * lam_k1.astype(F32)))
           - jnp.exp(jnp.sum(lam_q2.astype(F32) * lam_k2.astype(F32))) + lambda_init)

    def finish(o):
        o = rmsnorm(o, sub_norm) * (1.0 - lambda_init)
        return o.reshape(o.shape[:2] + (-1,))

    k_all = jnp.concatenate([kc, kx], axis=1)
    v_all = jnp.concatenate([vc, vx], axis=1)
    ox = finish(diff_attn_blocked(qx, k_all, v_all, lam))
    oc = finish(diff_softmax_attend(qc, kc, vc, lam)) if need_ctx else None
    return oc, ox


def gated_delta_chunked(q, k, v, g, beta, state0):
    B, T, H, dk = q.shape
    dv = v.shape[-1]
    N = T // GDN_CHUNK

    def chunks(a):
        a = a.astype(F32).reshape((B, N, GDN_CHUNK) + a.shape[2:])
        return jnp.moveaxis(jnp.moveaxis(a, 1, 0), 3, 2)

    q = chunks(q) * dk ** -0.5
    k, v, g, beta = chunks(k), chunks(v), chunks(g), chunks(beta)
    gcum = jnp.cumsum(g, axis=-1)
    idx = jnp.arange(GDN_CHUNK)
    lower = idx[:, None] >= idx[None, :]
    strict = idx[:, None] > idx[None, :]
    decay = jnp.exp(jnp.where(lower, gcum[..., :, None] - gcum[..., None, :], -jnp.inf))
    kb = k * beta[..., None]
    a_in = jnp.where(strict, jnp.einsum('nbhid,nbhjd->nbhij', kb, k) * decay, 0.0)
    a_in = a_in + jnp.eye(GDN_CHUNK, dtype=F32)
    rhs = jnp.concatenate([v * beta[..., None], kb * jnp.exp(gcum)[..., None]], axis=-1)
    sol = lax.linalg.triangular_solve(a_in, rhs, left_side=True, lower=True)
    u, w = sol[..., :dv], sol[..., dv:]
    attn = jnp.einsum('nbhid,nbhjd->nbhij', q, k) * decay

    def step(S, xs):
        q_i, k_i, u_i, w_i, g_i, attn_i = xs
        v_new = u_i - w_i @ S
        o = (q_i * jnp.exp(g_i)[..., None]) @ S + attn_i @ v_new
        g_last = g_i[..., -1:]
        S = S * jnp.exp(g_last)[..., None] + jnp.einsum(
            'bhcd,bhce->bhde', k_i * jnp.exp(g_last - g_i)[..., None], v_new)
        return S, o

    S, o = lax.scan(step, state0.astype(F32), (q, k, u, w, gcum, attn))
    o = jnp.moveaxis(jnp.moveaxis(o, 2, 3), 0, 1).reshape(B, T, H, dv)
    return S, o


def gated_deltanet(u_c, u_x, conv_w, a_log, dt_bias, o_norm):
    def prep(u):
        B, n, _ = u.shape
        qkv = jax.nn.silu(short_conv_centred(u[..., :2 * GDN_W + GDN_VW], conv_w))
        q = l2norm(qkv[..., :GDN_W].reshape(B, n, GDN_HEADS, GDN_DK))
        k = l2norm(qkv[..., GDN_W:2 * GDN_W].reshape(B, n, GDN_HEADS, GDN_DK))
        v = qkv[..., 2 * GDN_W:].reshape(B, n, GDN_HEADS, GDN_DV)
        z = u[..., 2 * GDN_W + GDN_VW:2 * GDN_W + 2 * GDN_VW].reshape(B, n, GDN_HEADS, GDN_DV)
        s = u[..., 2 * GDN_W + 2 * GDN_VW:].astype(F32).reshape(B, n, 2, 2, GDN_HEADS)
        beta = jax.nn.sigmoid(s[:, :, 0])
        g = -jnp.exp(a_log.astype(F32)) * jax.nn.softplus(s[:, :, 1] + dt_bias.astype(F32))
        return q, k, v, z, beta, g

    qc, kc, vc, zc, bc, g_c = prep(u_c)
    qx, kx, vx, zx, bx, g_x = prep(u_x)
    fl = lambda a: jnp.flip(a, axis=1)
    s0 = jnp.zeros((u_x.shape[0], GDN_HEADS, GDN_DK, GDN_DV), F32)
    sc_f, oc_f = gated_delta_chunked(qc, kc, vc, g_c[:, :, 0], bc[:, :, 0], s0)
    _, ox_f = gated_delta_chunked(qx, kx, vx, g_x[:, :, 0], bx[:, :, 0], sc_f)
    sc_b, oc_b = gated_delta_chunked(fl(qc), fl(kc), fl(vc), fl(g_c[:, :, 1]), fl(bc[:, :, 1]), s0)
    _, ox_b = gated_delta_chunked(fl(qx), fl(kx), fl(vx), fl(g_x[:, :, 1]), fl(bx[:, :, 1]), sc_b)

    def out(o, z, dt):
        o = rmsnorm(o, o_norm) * jax.nn.silu(z.astype(F32))
        return o.reshape(o.shape[:2] + (-1,)).astype(dt)

    return out(oc_f + fl(oc_b), zc, u_c.dtype), out(ox_f + fl(ox_b), zx, u_x.dtype)


def rglru_gates(xr, conv_w, conv_b, w_r, b_r, w_i, b_i, lam):
    xc = (short_conv_centred(xr, conv_w) + conv_b).astype(F32)
    B, n, W = xc.shape
    xb = xc.reshape(B, n, LRU_BLOCKS, LRU_BW)
    r = jax.nn.sigmoid(jnp.einsum('bnkc,zkcd->zbnkd', xb, w_r.astype(F32)).reshape(2, B, n, W)
                       + b_r.astype(F32)[:, None, None])
    i = jax.nn.sigmoid(jnp.einsum('bnkc,zkcd->zbnkd', xb, w_i.astype(F32)).reshape(2, B, n, W)
                       + b_i.astype(F32)[:, None, None])
    log_a = -LRU_C * r * jax.nn.softplus(-lam.astype(F32))[:, None, None]
    a = jnp.exp(log_a)
    b = jnp.sqrt(-jnp.expm1(2.0 * log_a)) * (i * xc[None])
    return a, b


def linear_recurrence(a, b, h0):
    b = b.at[:, 0].add(a[:, 0] * h0)
    _, h = lax.associative_scan(lambda l, r: (l[0] * r[0], r[0] * l[1] + r[1]), (a, b), axis=1)
    return h


def bidir_rglru(a_c, b_c, a_x, b_x):
    fl = lambda t: jnp.flip(t, axis=1)
    h0 = jnp.zeros_like(b_x[0, :, 0])
    hc_f = linear_recurrence(a_c[0], b_c[0], h0)
    hx_f = linear_recurrence(a_x[0], b_x[0], hc_f[:, -1])
    hc_b = linear_recurrence(fl(a_c[1]), fl(b_c[1]), h0)
    hx_b = linear_recurrence(fl(a_x[1]), fl(b_x[1]), hc_b[:, -1])
    return hc_f + fl(hc_b), hx_f + fl(hx_b)


def even_layer(hc, hx, c, c_ctx, cos, sin, lambda_init, last,
               norm1, norm2, ada_w, ada_b, w_in, w_out,
               q_norm, k_norm, lam_q1, lam_k1, lam_q2, lam_k2, sub_norm,
               gdn_conv, gdn_a_log, gdn_dt_bias, gdn_o_norm, w_gu, w_down):
    mx = ada_mod(c, ada_w, ada_b)
    mc = ada_mod(c_ctx, ada_w, ada_b)
    uc = modulate(hc, norm1, mc[0], mc[1]) @ w_in
    ux = modulate(hx, norm1, mx[0], mx[1]) @ w_in
    ac, ax = diff_attention(uc[..., :DA_IN], ux[..., :DA_IN], cos, sin, lambda_init, not last,
                            q_norm, k_norm, lam_q1, lam_k1, lam_q2, lam_k2, sub_norm)
    bc, bx = gated_deltanet(uc[..., DA_IN:], ux[..., DA_IN:], gdn_conv, gdn_a_log, gdn_dt_bias, gdn_o_norm)
    hx = hx + mx[2] * (jnp.concatenate([ax, bx], axis=-1) @ w_out)
    hx = hx + mx[5] * swiglu(modulate(hx, norm2, mx[3], mx[4]), w_gu, w_down)
    if not last:
        hc = hc + mc[2] * (jnp.concatenate([ac, bc], axis=-1) @ w_out)
        hc = hc + mc[5] * swiglu(modulate(hc, norm2, mc[3], mc[4]), w_gu, w_down)
    return hc, hx


def odd_layer(hc, hx, c, c_ctx, last, norm1, norm2, ada_w, ada_b, w_in, conv_w, conv_b,
              w_r, b_r, w_i, b_i, lam, w_out, w_gu, w_down):
    mx = ada_mod(c, ada_w, ada_b)
    mc = ada_mod(c_ctx, ada_w, ada_b)
    ux = modulate(hx, norm1, mx[0], mx[1]) @ w_in
    w_c = w_in[:, LRU_WIDTH:] if last else w_in
    uc = modulate(hc, norm1, mc[0], mc[1]) @ w_c
    a_c, b_c = rglru_gates(uc[..., -LRU_WIDTH:], conv_w, conv_b, w_r, b_r, w_i, b_i, lam)
    a_x, b_x = rglru_gates(ux[..., LRU_WIDTH:], conv_w, conv_b, w_r, b_r, w_i, b_i, lam)
    h_c, h_x = bidir_rglru(a_c, b_c, a_x, b_x)

    def out(u, h):
        return (jax.nn.gelu(u[..., :LRU_WIDTH]) * h.astype(u.dtype)) @ w_out

    hx = hx + mx[2] * out(ux, h_x)
    hx = hx + mx[5] * swiglu(modulate(hx, norm2, mx[3], mx[4]), w_gu, w_down)
    if not last:
        hc = hc + mc[2] * out(uc, h_c)
        hc = hc + mc[5] * swiglu(modulate(hc, norm2, mc[3], mc[4]), w_gu, w_down)
    return hc, hx


def setup_inputs(seed: int = 0) -> dict:
    key = jax.random.key(seed)
    keys = iter(jax.random.split(key, 64))

    def normal(shape, scale):
        return scale * jax.random.normal(next(keys), shape, F32)

    def gain(shape):
        return 1.0 + 0.05 * jax.random.normal(next(keys), shape, F32)

    def uniform(shape, lo, hi):
        return jax.random.uniform(next(keys), shape, F32, lo, hi)

    D, NE, NO = D_MODEL, N_EVEN, N_ODD
    dt = jnp.exp(uniform((NE, 2, GDN_HEADS), math.log(1e-3), math.log(1e-1)))
    sg = uniform((NO, 2, LRU_WIDTH), 0.9, 0.999) ** (1.0 / LRU_C)
    return {
        "x": normal((BATCH, SEQ, D), 1.0),
        "c": normal((BATCH, D), 1.0),
        "ctx": normal((BATCH, CTX_LEN, D), 1.0),
        "c_ctx": normal((D,), 1.0),
        "ev_norm1": gain((NE, D)),
        "ev_norm2": gain((NE, D)),
        "ev_ada_w": normal((NE, D, 6 * D), 0.5 * D ** -0.5),
        "ev_ada_b": normal((NE, 6 * D), 0.02),
        "ev_w_in": normal((NE, D, L0_IN), D ** -0.5),
        "ev_w_out": normal((NE, MIX0_OUT, D), MIX0_OUT ** -0.5),
        "ev_q_norm": gain((NE, DA_QK_DIM)),
        "ev_k_norm": gain((NE, DA_QK_DIM)),
        "ev_lam_q1": normal((NE, DA_QK_DIM), 0.1),
        "ev_lam_k1": normal((NE, DA_QK_DIM), 0.1),
        "ev_lam_q2": normal((NE, DA_QK_DIM), 0.1),
        "ev_lam_k2": normal((NE, DA_QK_DIM), 0.1),
        "ev_sub_norm": gain((NE, DA_V_DIM)),
        "ev_gdn_conv": normal((NE, GDN_CONV, 2 * GDN_W + GDN_VW), GDN_CONV ** -0.5),
        "ev_gdn_a_log": jnp.log(uniform((NE, 2, GDN_HEADS), 1.0, 16.0)),
        "ev_gdn_dt_bias": dt + jnp.log(-jnp.expm1(-dt)),
        "ev_gdn_o_norm": gain((NE, GDN_DV)),
        "ev_ffn_w_gu": normal((NE, D, 2 * FFN_HIDDEN), D ** -0.5),
        "ev_ffn_w_down": normal((NE, FFN_HIDDEN, D), FFN_HIDDEN ** -0.5),
        "od_norm1": gain((NO, D)),
        "od_norm2": gain((NO, D)),
        "od_ada_w": normal((NO, D, 6 * D), 0.5 * D ** -0.5),
        "od_ada_b": normal((NO, 6 * D), 0.02),
        "od_w_in": normal((NO, D, 2 * LRU_WIDTH), D ** -0.5),
        "od_conv_w": normal((NO, LRU_CONV, LRU_WIDTH), LRU_CONV ** -0.5),
        "od_conv_b": normal((NO, LRU_WIDTH), 0.02),
        "od_w_r": normal((NO, 2, LRU_BLOCKS, LRU_BW, LRU_BW), LRU_BW ** -0.5),
        "od_b_r": normal((NO, 2, LRU_WIDTH), 0.02),
        "od_w_i": normal((NO, 2, LRU_BLOCKS, LRU_BW, LRU_BW), LRU_BW ** -0.5),
        "od_b_i": normal((NO, 2, LRU_WIDTH), 0.02),
        "od_lam": jnp.log(sg) - jnp.log1p(-sg),
        "od_w_out": normal((NO, LRU_WIDTH, D), LRU_WIDTH ** -0.5),
        "od_ffn_w_gu": normal((NO, D, 2 * FFN_HIDDEN), D ** -0.5),
        "od_ffn_w_down": normal((NO, FFN_HIDDEN, D), FFN_HIDDEN ** -0.5),
    }


def reference(x, c, ctx, c_ctx,
              ev_norm1, ev_norm2, ev_ada_w, ev_ada_b, ev_w_in, ev_w_out,
              ev_q_norm, ev_k_norm, ev_lam_q1, ev_lam_k1, ev_lam_q2, ev_lam_k2, ev_sub_norm,
              ev_gdn_conv, ev_gdn_a_log, ev_gdn_dt_bias, ev_gdn_o_norm,
              ev_ffn_w_gu, ev_ffn_w_down,
              od_norm1, od_norm2, od_ada_w, od_ada_b, od_w_in, od_conv_w, od_conv_b,
              od_w_r, od_b_r, od_w_i, od_b_i, od_lam, od_w_out,
              od_ffn_w_gu, od_ffn_w_down):
    n = x.shape[1]
    rows = n // GRID_W
    row = jnp.repeat(jnp.arange(rows), GRID_W)
    col = jnp.tile(jnp.arange(GRID_W), rows)
    cos, sin = axial_rope_tables(row, col)
    hc, hx = ctx, x
    for layer in range(DEPTH):
        last = layer == DEPTH - 1
        j = layer // 2
        if layer % 2 == 0:
            lambda_init = 0.8 - 0.6 * math.exp(-0.3 * layer)
            hc, hx = even_layer(hc, hx, c, c_ctx, cos, sin, lambda_init, last,
                                ev_norm1[j], ev_norm2[j], ev_ada_w[j], ev_ada_b[j], ev_w_in[j], ev_w_out[j],
                                ev_q_norm[j], ev_k_norm[j], ev_lam_q1[j], ev_lam_k1[j], ev_lam_q2[j],
                                ev_lam_k2[j], ev_sub_norm[j], ev_gdn_conv[j], ev_gdn_a_log[j],
                                ev_gdn_dt_bias[j], ev_gdn_o_norm[j], ev_ffn_w_gu[j], ev_ffn_w_down[j])
        else:
            hc, hx = odd_layer(hc, hx, c, c_ctx, last,
                               od_norm1[j], od_norm2[j], od_ada_w[j], od_ada_b[j], od_w_in[j],
                               od_conv_w[j], od_conv_b[j], od_w_r[j], od_b_r[j], od_w_i[j], od_b_i[j],
                               od_lam[j], od_w_out[j], od_ffn_w_gu[j], od_ffn_w_down[j])
    return hx
```

```cpp
#include <hip/hip_runtime.h>
#include <hip/hip_cooperative_groups.h>
#include <cstdio>
namespace cg = cooperative_groups;

#ifndef MULTI_LAUNCH
#define MULTI_LAUNCH 0
#endif
#ifndef PROBE_DUP
#define PROBE_DUP -1
#define PROBE_DUP2 -1
#define PROBE_SYNCS 0
#endif

#define DI __device__ __forceinline__
typedef unsigned short u16;
typedef unsigned int u32;
using bf16x8 = __attribute__((ext_vector_type(8))) short;
using f32x16 = __attribute__((ext_vector_type(16))) float;
typedef __bf16 bf2_t __attribute__((ext_vector_type(2)));
typedef float f2_t __attribute__((ext_vector_type(2)));

constexpr int SEQ = 16384, CTXL = 256, DM = 1024, MROWS = 33280, LAT0 = 512;
constexpr int SK = 16640;
constexpr int FFH = 2816;
constexpr int NCH = 260;
constexpr float EPSF = 1e-6f;

constexpr size_t MiB = 1048576;
constexpr size_t WS_WT0IN = 0, WS_WT0OUT = 8 * MiB, WS_WT0GU = 10 * MiB, WS_WT0DN = 21 * MiB;
constexpr size_t WS_WT1IN = 27 * MiB, WS_WT1G = 31 * MiB, WS_WT1OUT = 32 * MiB, WS_WT1GU = 34 * MiB, WS_WT1DN = 45 * MiB;
constexpr size_t WS_MOD = 51 * MiB, WS_G0 = 52 * MiB, WS_HCTX = 55 * MiB, WS_GL = 57 * MiB, WS_PH = 58 * MiB;
constexpr size_t WS_CNT = 67 * MiB;
constexpr size_t WS_BAR = 67 * MiB + 65536;
constexpr size_t WS_BIG = 68 * MiB;
constexpr size_t WS_FRAGS = WS_BIG;
constexpr size_t WS_A = WS_BIG;
constexpr size_t WS_VRAW = WS_BIG + 65 * MiB;
constexpr size_t WS_ACT = WS_BIG + 65 * MiB;
constexpr size_t WS_U0G = 361 * MiB;
constexpr size_t WS_MIX = 361 * MiB;
constexpr size_t WS_Z = 459 * MiB;
constexpr size_t WS_UR = WS_BIG + 65 * MiB;
constexpr size_t WS_AB = WS_BIG;
constexpr size_t WS_XC = 328 * MiB;
constexpr size_t WS_UG = 393 * MiB;
constexpr size_t WS_CIN = 459 * MiB;
constexpr size_t WS_NEED = 512 * MiB;
constexpr size_t FRAG_ITEM = 73728;
constexpr size_t FR_W = 0, FR_Q = 16384, FR_KT = 32768, FR_AT = 49152, FR_U = 57344;
constexpr size_t DO_QK = 0, DO_VT = 65 * MiB;

struct Params {
  const float* in[38];
  float* out;
  char* ws;
};
enum { I_X = 0, I_C, I_CTX, I_CCTX, I_EN1, I_EN2, I_EADAW, I_EADAB, I_EWIN, I_EWOUT, I_QN, I_KN, I_LQ1, I_LK1, I_LQ2, I_LK2,
       I_SUBN, I_GCONV, I_ALOG, I_DTB, I_ONORM, I_EWGU, I_EWDN, I_ON1, I_ON2, I_OADAW, I_OADAB, I_OWIN, I_OCONVW, I_OCONVB,
       I_OWR, I_OBR, I_OWI, I_OBI, I_OLAM, I_OWOUT, I_OWGU, I_OWDN };

DI u32 pk2(float a, float b) { f2_t v = {a, b}; bf2_t r = __builtin_convertvector(v, bf2_t); return __builtin_bit_cast(u32, r); }
DI u16 f2bf(float a) { return (u16)(pk2(a, 0.f) & 0xffffu); }
DI float bf2f(u16 v) { return __uint_as_float(((u32)v) << 16); }
DI float bflo(u32 v) { return __uint_as_float(v << 16); }
DI float bfhi(u32 v) { return __uint_as_float(v & 0xffff0000u); }
DI int crow(int reg, int h) { return (reg & 3) + 8 * (reg >> 2) + 4 * h; }
DI int krow(int s, int h, int j) { return 16 * s + 8 * (j >> 2) + 4 * h + (j & 3); }
DI float sigmoidf_(float x) { return 1.f / (1.f + __expf(-x)); }
DI float siluf_(float x) { return x / (1.f + __expf(-x)); }
DI float siluf_fast(float x) { return x * __builtin_amdgcn_rcpf(1.f + __expf(-x)); }
DI float sigmoidf_fast(float x) { return __builtin_amdgcn_rcpf(1.f + __expf(-x)); }
DI float softplusf_(float x) { return x > 20.f ? x : log1pf(__expf(x)); }
DI float wave_sum(float v) {
#pragma unroll
  for (int o = 32; o >= 1; o >>= 1) v += __shfl_xor(v, o);
  return v;
}
DI f32x16 mfma32(bf16x8 a, bf16x8 b, f32x16 c) { return __builtin_amdgcn_mfma_f32_32x32x16_bf16(a, b, c, 0, 0, 0); }
DI bf16x8 ld8(const u16* p) { return *reinterpret_cast<const bf16x8*>(p); }
DI bf16x8 pack_step(const f32x16& x, int s) {
  uint4 r;
  r.x = pk2(x[8 * s + 0], x[8 * s + 1]); r.y = pk2(x[8 * s + 2], x[8 * s + 3]);
  r.z = pk2(x[8 * s + 4], x[8 * s + 5]); r.w = pk2(x[8 * s + 6], x[8 * s + 7]);
  return __builtin_bit_cast(bf16x8, r);
}
DI int row_cond(int row) { return row < LAT0 ? 2 : ((row - LAT0) >> 14); }
DI f32x16 zero16() { f32x16 z; for (int i = 0; i < 16; ++i) z[i] = 0.f; return z; }

__shared__ int g_wtab[64];
DI int hw_wave_slot() { return (int)((unsigned)__builtin_amdgcn_s_getreg((5 << 11) | 4) & 63u); }
DI int opaque_tid() {
  const int w = __builtin_amdgcn_readfirstlane(g_wtab[hw_wave_slot()]);
  int t = w * 64 + (int)__builtin_amdgcn_mbcnt_hi(~0u, __builtin_amdgcn_mbcnt_lo(~0u, 0u));
  asm volatile("" : "+v"(t));
  return t;
}
constexpr int SMEM_BYTES = 77824;

template <class RowFn>
DI void convert_weight(u16* dst, int nrows, int K, RowFn rowfn, char* smem, int& job_base, int njobs_total) {
  float* tile = (float*)smem;
  const int ktiles = K / 64, rtiles = nrows / 64, ntile = ktiles * rtiles;
  const int tid = opaque_tid();
  int first = blockIdx.x - (job_base % gridDim.x);
  if (first < 0) first += gridDim.x;
  for (int t = first; t < ntile; t += gridDim.x) {
    const int rt = t / ktiles, kt = t % ktiles;
    const int tx = tid & 63, ty = tid >> 6;
    int ld = 0;
    const float* src = rowfn(rt * 64 + tx, ld);
#pragma unroll 4
    for (int i = 0; i < 16; ++i) {
      const int k = ty + 4 * i;
      tile[k * 65 + tx] = src ? src[(size_t)(kt * 64 + k) * ld] : 0.f;
    }
    __syncthreads();
    const int r = tid >> 2, kq = (tid & 3) * 16;
    u32 w[8];
#pragma unroll
    for (int i = 0; i < 8; ++i) w[i] = pk2(tile[(kq + 2 * i) * 65 + r], tile[(kq + 2 * i + 1) * 65 + r]);
    uint4* d = reinterpret_cast<uint4*>(dst + (size_t)(rt * 64 + r) * K + kt * 64 + kq);
    d[0] = make_uint4(w[0], w[1], w[2], w[3]);
    d[1] = make_uint4(w[4], w[5], w[6], w[7]);
    __syncthreads();
  }
  job_base += ntile;
}

DI void phase_convert(const Params& p, char* smem) {
  int jb = 0;
  u16* ws16 = (u16*)p.ws;
  {
    const float* w = p.in[I_EWIN];
    convert_weight((u16*)(p.ws + WS_WT0IN), 3712, 1024, [=](int n, int& ld) { ld = 3600; return n < 3600 ? w + n : (const float*)nullptr; }, smem, jb, 0);
  }
  {
    const float* w = p.in[I_EWOUT];
    convert_weight((u16*)(p.ws + WS_WT0OUT), 1024, 1024, [=](int n, int& ld) { ld = 1024; return w + n; }, smem, jb, 0);
  }
  auto gu_row = [](const float* w, int n, int& ld) {
    ld = 2 * FFH;
    const int j = n >> 7, wq = n & 127, wn = wq >> 6, sub = (wq & 63) >> 5, c = wq & 31;
    const int hid = 64 * j + 32 * wn + c;
    return w + (sub ? FFH + hid : hid);
  };
  {
    const float* w = p.in[I_EWGU];
    convert_weight((u16*)(p.ws + WS_WT0GU), 2 * FFH, 1024, [=](int n, int& ld) { return gu_row(w, n, ld); }, smem, jb, 0);
  }
  {
    const float* w = p.in[I_EWDN];
    convert_weight((u16*)(p.ws + WS_WT0DN), 1024, FFH, [=](int n, int& ld) { ld = 1024; return w + n; }, smem, jb, 0);
  }
  {
    const float* w = p.in[I_OWIN];
    convert_weight((u16*)(p.ws + WS_WT1IN), 2048, 1024, [=](int n, int& ld) { ld = 2048; return w + n; }, smem, jb, 0);
  }
  {
    const float* wr = p.in[I_OWR];
    const float* wi = p.in[I_OWI];
    convert_weight((u16*)(p.ws + WS_WT1G), 4096, 128, [=](int n, int& ld) {
      ld = 128;
      const int kb = n >> 9, w512 = n & 511, jt = w512 >> 7, z = jt >> 1, half = jt & 1;
      const int wq = w512 & 127, wn = wq >> 6, sub = (wq & 63) >> 5, c = wq & 31;
      const int dch = half * 64 + wn * 32 + c;
      return (sub ? wi : wr) + (size_t)(z * 8 + kb) * 16384 + dch;
    }, smem, jb, 0);
  }
  {
    const float* w = p.in[I_OWOUT];
    convert_weight((u16*)(p.ws + WS_WT1OUT), 1024, 1024, [=](int n, int& ld) { ld = 1024; return w + n; }, smem, jb, 0);
  }
  {
    const float* w = p.in[I_OWGU];
    convert_weight((u16*)(p.ws + WS_WT1GU), 2 * FFH, 1024, [=](int n, int& ld) { return gu_row(w, n, ld); }, smem, jb, 0);
  }
  {
    const float* w = p.in[I_OWDN];
    convert_weight((u16*)(p.ws + WS_WT1DN), 1024, FFH, [=](int n, int& ld) { ld = 1024; return w + n; }, smem, jb, 0);
  }
  (void)ws16;
}

DI void phase_mod(const Params& p, char* smem) {
  float* sc = (float*)smem;
  float* part = sc + 3 * 1024;
  const int tid = opaque_tid();
  bool loaded = false;
  for (int item = blockIdx.x; item < 192; item += gridDim.x) {
    if (!loaded) {
      for (int i = tid; i < 3072; i += 256) {
        const int cnd = i >> 10, k = i & 1023;
        const float v = cnd < 2 ? p.in[I_C][cnd * 1024 + k] : p.in[I_CCTX][k];
        sc[i] = siluf_(v);
      }
      loaded = true;
      __syncthreads();
    }
    const int l = item / 96, cgp = item % 96;
    const float* W = p.in[l ? I_OADAW : I_EADAW];
    const float* Bv = p.in[l ? I_OADAB : I_EADAB];
    const int col = cgp * 64 + (tid & 63), kq = tid >> 6;
    float a0 = 0.f, a1 = 0.f, a2 = 0.f;
#pragma unroll 8
    for (int k = kq * 256; k < kq * 256 + 256; ++k) {
      const float w = W[(size_t)k * 6144 + col];
      a0 += sc[k] * w; a1 += sc[1024 + k] * w; a2 += sc[2048 + k] * w;
    }
    part[(kq * 3 + 0) * 64 + (tid & 63)] = a0;
    part[(kq * 3 + 1) * 64 + (tid & 63)] = a1;
    part[(kq * 3 + 2) * 64 + (tid & 63)] = a2;
    __syncthreads();
    if (tid < 192) {
      const int cnd = tid >> 6, c = tid & 63;
      float s = Bv[cgp * 64 + c];
      for (int q = 0; q < 4; ++q) s += part[(q * 3 + cnd) * 64 + c];
      ((float*)(p.ws + WS_MOD))[(size_t)(l * 3 + cnd) * 6144 + cgp * 64 + c] = s;
    }
    __syncthreads();
  }
}

DI void phase_modulate(const float* hc, const float* hx, const float* gain, const float* mod, int shift_idx, int row_lo, u16* Aout) {
  const int tid0 = opaque_tid();
  const int lane = tid0 & 63, wid = tid0 >> 6;
  const int nw = gridDim.x * 4;
  for (int rowA = row_lo + blockIdx.x * 4 + wid; rowA < MROWS; rowA += 2 * nw) {
    const int rowB = rowA + nw;
    const bool hasB = rowB < MROWS;
    const int rB = hasB ? rowB : rowA;
    const float* srcA = rowA < LAT0 ? hc + (size_t)rowA * DM : hx + (size_t)(rowA - LAT0) * DM;
    const float* srcB = rB < LAT0 ? hc + (size_t)rB * DM : hx + (size_t)(rB - LAT0) * DM;
    float4 va[4], vb[4];
#pragma unroll
    for (int i = 0; i < 4; ++i) {
      va[i] = *reinterpret_cast<const float4*>(srcA + (i * 64 + lane) * 4);
      vb[i] = *reinterpret_cast<const float4*>(srcB + (i * 64 + lane) * 4);
    }
    float sa = 0.f, sb = 0.f;
#pragma unroll
    for (int i = 0; i < 4; ++i) {
      sa += va[i].x * va[i].x + va[i].y * va[i].y + va[i].z * va[i].z + va[i].w * va[i].w;
      sb += vb[i].x * vb[i].x + vb[i].y * vb[i].y + vb[i].z * vb[i].z + vb[i].w * vb[i].w;
    }
    sa = wave_sum(sa); sb = wave_sum(sb);
    const float ra = rsqrtf(sa * (1.f / 1024.f) + EPSF), rb = rsqrtf(sb * (1.f / 1024.f) + EPSF);
    const float* shA = mod + (size_t)row_cond(rowA) * 6144 + shift_idx * 1024;
    const float* shB = mod + (size_t)row_cond(rB) * 6144 + shift_idx * 1024;
    uint2 oa[4], ob[4];
#pragma unroll
    for (int i = 0; i < 4; ++i) {
      const int c = (i * 64 + lane) * 4;
      const float4 g = *reinterpret_cast<const float4*>(gain + c);
      const float4 s1 = *reinterpret_cast<const float4*>(shA + c), c1 = *reinterpret_cast<const float4*>(shA + 1024 + c);
      const float4 s2 = *reinterpret_cast<const float4*>(shB + c), c2 = *reinterpret_cast<const float4*>(shB + 1024 + c);
      oa[i] = make_uint2(pk2(va[i].x * ra * g.x * (1.f + c1.x) + s1.x, va[i].y * ra * g.y * (1.f + c1.y) + s1.y),
                         pk2(va[i].z * ra * g.z * (1.f + c1.z) + s1.z, va[i].w * ra * g.w * (1.f + c1.w) + s1.w));
      ob[i] = make_uint2(pk2(vb[i].x * rb * g.x * (1.f + c2.x) + s2.x, vb[i].y * rb * g.y * (1.f + c2.y) + s2.y),
                         pk2(vb[i].z * rb * g.z * (1.f + c2.z) + s2.z, vb[i].w * rb * g.w * (1.f + c2.w) + s2.w));
    }
#pragma unroll
    for (int i = 0; i < 4; ++i) {
      const int c = (i * 64 + lane) * 4;
      *reinterpret_cast<uint2*>(Aout + (size_t)rowA * DM + c) = oa[i];
      if (hasB) *reinterpret_cast<uint2*>(Aout + (size_t)rowB * DM + c) = ob[i];
    }
  }
}

constexpr int LDT = 72;
template <class Epi>
DI void gemm_phase(const u16* __restrict__ A, int lda, const u16* __restrict__ Bt, int ldb, int K, int mt_lo, int mtiles, int ntiles,
                   int nt_per_group, char* smem, Epi epi) {
  u16* sA = (u16*)smem;
  u16* sB = sA + 2 * 128 * LDT;
  const int tid = opaque_tid(), lane = tid & 63, wid = __builtin_amdgcn_readfirstlane(tid >> 6), wm = wid >> 1, wn = wid & 1;
  const int lr = lane & 31, lh = lane >> 5;
  const int ldrow = tid >> 3, ldc = (tid & 7) * 8;
  const int nk = K / 64;
  const int total = mtiles * ntiles;
  const int per_xcd = (total + 7) >> 3;
  const int xcd = blockIdx.x & 7, qx = blockIdx.x >> 3, nq = gridDim.x >> 3;
  for (int v = qx; v < per_xcd; v += nq) {
    const int u = xcd * per_xcd + v;
    if (u >= total) break;
    const int gsz_full = 8 * ntiles;
    const int g = u / gsz_full, r = u - g * gsz_full;
    const int gm = min(8, mtiles - g * 8);
    const int mt = mt_lo + g * 8 + r % gm, nt = r / gm;
    const unsigned oA = (unsigned)(((mt * 128 + ldrow) * lda + (nt / nt_per_group) * K + ldc) * 2);
    const unsigned oB = (unsigned)(((nt * 128 + ldrow) * ldb + ldc) * 2);
    const char* Ab = (const char*)A;
    const char* Bb = (const char*)Bt;
    f32x16 acc[2][2];
    acc[0][0] = zero16(); acc[0][1] = zero16(); acc[1][0] = zero16(); acc[1][1] = zero16();
    uint4 xa0, xa1, xa2, xa3, xb0, xb1, xb2, xb3, ya0, ya1, ya2, ya3, yb0, yb1, yb2, yb3;
#define G_LOADX(KT) do { const unsigned ka_ = oA + (unsigned)(KT) * 128u, kb_ = oB + (unsigned)(KT) * 128u; \
      xa0 = *reinterpret_cast<const uint4*>(Ab + (ka_ + 0u * (unsigned)lda * 2u)); \
      xa1 = *reinterpret_cast<const uint4*>(Ab + (ka_ + 32u * (unsigned)lda * 2u)); \
      xa2 = *reinterpret_cast<const uint4*>(Ab + (ka_ + 64u * (unsigned)lda * 2u)); \
      xa3 = *reinterpret_cast<const uint4*>(Ab + (ka_ + 96u * (unsigned)lda * 2u)); \
      xb0 = *reinterpret_cast<const uint4*>(Bb + (kb_ + 0u * (unsigned)ldb * 2u)); \
      xb1 = *reinterpret_cast<const uint4*>(Bb + (kb_ + 32u * (unsigned)ldb * 2u)); \
      xb2 = *reinterpret_cast<const uint4*>(Bb + (kb_ + 64u * (unsigned)ldb * 2u)); \
      xb3 = *reinterpret_cast<const uint4*>(Bb + (kb_ + 96u * (unsigned)ldb * 2u)); } while (0)
#define G_LOADY(KT) do { const unsigned ka_ = oA + (unsigned)(KT) * 128u, kb_ = oB + (unsigned)(KT) * 128u; \
      ya0 = *reinterpret_cast<const uint4*>(Ab + (ka_ + 0u * (unsigned)lda * 2u)); \
      ya1 = *reinterpret_cast<const uint4*>(Ab + (ka_ + 32u * (unsigned)lda * 2u)); \
      ya2 = *reinterpret_cast<const uint4*>(Ab + (ka_ + 64u * (unsigned)lda * 2u)); \
      ya3 = *reinterpret_cast<const uint4*>(Ab + (ka_ + 96u * (unsigned)lda * 2u)); \
      yb0 = *reinterpret_cast<const uint4*>(Bb + (kb_ + 0u * (unsigned)ldb * 2u)); \
      yb1 = *reinterpret_cast<const uint4*>(Bb + (kb_ + 32u * (unsigned)ldb * 2u)); \
      yb2 = *reinterpret_cast<const uint4*>(Bb + (kb_ + 64u * (unsigned)ldb * 2u)); \
      yb3 = *reinterpret_cast<const uint4*>(Bb + (kb_ + 96u * (unsigned)ldb * 2u)); } while (0)
#define G_STOREX(BUF) do { u16* wa_ = sA + (BUF) * 128 * LDT + ldrow * LDT + ldc; u16* wb_ = sB + (BUF) * 128 * LDT + ldrow * LDT + ldc; \
      *reinterpret_cast<uint4*>(wa_) = xa0; *reinterpret_cast<uint4*>(wa_ + 32 * LDT) = xa1; \
      *reinterpret_cast<uint4*>(wa_ + 64 * LDT) = xa2; *reinterpret_cast<uint4*>(wa_ + 96 * LDT) = xa3; \
      *reinterpret_cast<uint4*>(wb_) = xb0; *reinterpret_cast<uint4*>(wb_ + 32 * LDT) = xb1; \
      *reinterpret_cast<uint4*>(wb_ + 64 * LDT) = xb2; *reinterpret_cast<uint4*>(wb_ + 96 * LDT) = xb3; } while (0)
#define G_STOREY(BUF) do { u16* wa_ = sA + (BUF) * 128 * LDT + ldrow * LDT + ldc; u16* wb_ = sB + (BUF) * 128 * LDT + ldrow * LDT + ldc; \
      *reinterpret_cast<uint4*>(wa_) = ya0; *reinterpret_cast<uint4*>(wa_ + 32 * LDT) = ya1; \
      *reinterpret_cast<uint4*>(wa_ + 64 * LDT) = ya2; *reinterpret_cast<uint4*>(wa_ + 96 * LDT) = ya3; \
      *reinterpret_cast<uint4*>(wb_) = yb0; *reinterpret_cast<uint4*>(wb_ + 32 * LDT) = yb1; \
      *reinterpret_cast<uint4*>(wb_ + 64 * LDT) = yb2; *reinterpret_cast<uint4*>(wb_ + 96 * LDT) = yb3; } while (0)
#define G_COMPUTE(BUF) do { \
      const u16* a_ = sA + (BUF) * 128 * LDT + (wm * 64 + lr) * LDT + lh * 8; \
      const u16* b_ = sB + (BUF) * 128 * LDT + (wn * 64 + lr) * LDT + lh * 8; \
      _Pragma("unroll") for (int ks = 0; ks < 4; ++ks) { \
        const bf16x8 a0 = ld8(a_ + ks * 16), a1 = ld8(a_ + 32 * LDT + ks * 16); \
        const bf16x8 b0 = ld8(b_ + ks * 16), b1 = ld8(b_ + 32 * LDT + ks * 16); \
        acc[0][0] = mfma32(a0, b0, acc[0][0]); acc[0][1] = mfma32(a0, b1, acc[0][1]); \
        acc[1][0] = mfma32(a1, b0, acc[1][0]); acc[1][1] = mfma32(a1, b1, acc[1][1]); } } while (0)
    G_LOADX(0);
    G_STOREX(0);
    G_LOADX(1);
    if (nk > 2) G_LOADY(2);
    __syncthreads();
    for (int kt = 0; kt < nk; kt += 2) {
      G_COMPUTE(0);
      G_STOREX(1);
      if (kt + 3 < nk) G_LOADX(kt + 3);
      __syncthreads();
      G_COMPUTE(1);
      if (kt + 2 < nk) G_STOREY(0);
      if (kt + 4 < nk) G_LOADY(kt + 4);
      __syncthreads();
    }
    { int lr_ = lr, lh_ = lh; asm volatile("" : "+v"(lr_), "+v"(lh_));
      epi(acc, mt * 128 + wm * 64, nt * 128 + wn * 64, nt, wn, lr_, lh_); }
  }
}

struct EpiIn0 {
  u16 *qk, *vraw, *u0g, *z; float* g0;
  template <int MI>
  DI void operator()(f32x16 (&acc)[MI][2], int mb, int nb, int, int, int lr, int lh) const {
#pragma unroll
    for (int ni = 0; ni < 2; ++ni) {
      const int c0 = nb + ni * 32;
      u16* dst; int ld;
      if (c0 < 1024) { dst = qk + c0; ld = 1024; }
      else if (c0 < 1536) { dst = vraw + (c0 - 1024); ld = 512; }
      else if (c0 < 3072) { dst = u0g + (c0 - 1536); ld = 1536; }
      else if (c0 < 3584) { dst = z + (c0 - 3072); ld = 512; }
      else { dst = nullptr; ld = 0; }
#pragma unroll
      for (int mi = 0; mi < MI; ++mi) {
#pragma unroll
        for (int i = 0; i < 16; ++i) {
          const int row = mb + mi * 32 + crow(i, lh);
          if (dst) dst[(size_t)row * ld + lr] = f2bf(acc[mi][ni][i]);
          else if (c0 == 3584 && lr < 16) g0[(size_t)row * 16 + lr] = acc[mi][ni][i];
        }
      }
    }
  }
};
struct EpiResid {
  const float *hc_in, *hx_in; float *hc_out, *hx_out; const float* gate;
  DI void operator()(f32x16 (&acc)[2][2], int mb, int nb, int, int, int lr, int lh) const {
    const bool isc = mb < LAT0;
    if (isc && !hc_out) return;
    const float* in = isc ? hc_in + (size_t)mb * DM : hx_in + (size_t)(mb - LAT0) * DM;
    float* out = isc ? hc_out + (size_t)mb * DM : hx_out + (size_t)(mb - LAT0) * DM;
    const float* gt = gate + (size_t)row_cond(mb) * 6144;
#pragma unroll
    for (int ni = 0; ni < 2; ++ni) {
      const int col = nb + ni * 32 + lr;
      const float g = gt[col];
#pragma unroll
      for (int mi = 0; mi < 2; ++mi) {
#pragma unroll
        for (int i8 = 0; i8 < 16; i8 += 8) {
          float hv[8];
#pragma unroll
          for (int i = 0; i < 8; ++i) hv[i] = in[(size_t)(mi * 32 + crow(i8 + i, lh)) * DM + col];
#pragma unroll
          for (int i = 0; i < 8; ++i) out[(size_t)(mi * 32 + crow(i8 + i, lh)) * DM + col] = hv[i] + g * acc[mi][ni][i8 + i];
        }
      }
    }
  }
};
struct EpiSwiglu {
  u16* act;
  template <int MI>
  DI void operator()(f32x16 (&acc)[MI][2], int mb, int, int nt, int wn, int lr, int lh) const {
    const int hid = nt * 64 + wn * 32 + lr;
#pragma unroll
    for (int mi = 0; mi < MI; ++mi) {
#pragma unroll
      for (int i = 0; i < 16; ++i) {
        const int row = mb + mi * 32 + crow(i, lh);
        const float g = acc[mi][0][i], u = acc[mi][1][i];
        act[(size_t)row * FFH + hid] = f2bf(siluf_fast(g) * u);
      }
      __builtin_amdgcn_sched_barrier(0);
    }
  }
};
struct EpiIn1 {
  u16 *ug, *ur;
  template <int MI>
  DI void operator()(f32x16 (&acc)[MI][2], int mb, int nb, int, int, int lr, int lh) const {
#pragma unroll
    for (int mi = 0; mi < MI; ++mi)
#pragma unroll
      for (int ni = 0; ni < 2; ++ni) {
        const int col = nb + ni * 32 + lr;
#pragma unroll
        for (int i = 0; i < 16; ++i) {
          const int row = mb + mi * 32 + crow(i, lh);
          if (col < 1024) { if (row >= LAT0) ug[(size_t)(row - LAT0) * DM + col] = f2bf(acc[mi][ni][i]); }
          else ur[(size_t)row * DM + col - 1024] = f2bf(acc[mi][ni][i]);
        }
      }
  }
};
struct EpiGates {
  const u16* xc; u16* ab; const float *b_r, *b_i, *lam;
  DI void operator()(f32x16 (&acc)[2][2], int mb, int, int nt, int wn, int lr, int lh) const {
    const int kb = nt >> 2, jt = nt & 3, z = jt >> 1, half = jt & 1;
    const int ch = kb * 128 + half * 64 + wn * 32 + lr;
    const float br = b_r[z * 1024 + ch], bi = b_i[z * 1024 + ch];
    const float sp = softplusf_(-lam[z * 1024 + ch]);
    u16* la = ab + (size_t)z * 2 * MROWS * DM;
    u16* bb = la + (size_t)MROWS * DM;
#pragma unroll
    for (int mi = 0; mi < 2; ++mi) {
      float xv[16];
#pragma unroll
      for (int i = 0; i < 16; ++i) xv[i] = bf2f(xc[(size_t)(mb + mi * 32 + crow(i, lh)) * DM + ch]);
#pragma unroll
      for (int i = 0; i < 16; ++i) {
        const int row = mb + mi * 32 + crow(i, lh);
        const float r = sigmoidf_fast(acc[mi][0][i] + br), ig = sigmoidf_fast(acc[mi][1][i] + bi);
        const float loga = -8.f * r * sp;
        const float a2 = __expf(2.f * loga);
        const float bval = __builtin_amdgcn_sqrtf(fmaxf(1.f - a2, 0.f)) * (ig * xv[i]);
        la[(size_t)row * DM + ch] = f2bf(loga);
        bb[(size_t)row * DM + ch] = f2bf(bval);
      }
      __builtin_amdgcn_sched_barrier(0);
    }
  }
};


constexpr int LD4 = 40;
template <class Epi>
DI void gemm_phase4(const u16* __restrict__ A, int lda, const u16* __restrict__ Bt, int ldb, int K, int mt_lo, int mtiles, int ntiles,
                    char* smem, Epi epi) {
  u16* sA = (u16*)smem;
  u16* sB = sA + 2 * 256 * LD4;
  const int tid = opaque_tid(), lane = tid & 63, wid = __builtin_amdgcn_readfirstlane(tid >> 6), wm = wid >> 1, wn = wid & 1;
  const int lr = lane & 31, lh = lane >> 5;
  const int ldrow = tid >> 2, ldc = (tid & 3) * 8;
  const int nk = K / 32;
  const int total = mtiles * ntiles;
  const int per_xcd = (total + 7) >> 3;
  const int xcd = blockIdx.x & 7, qx = blockIdx.x >> 3, nq = gridDim.x >> 3;
  for (int v = qx; v < per_xcd; v += nq) {
    const int u = xcd * per_xcd + v;
    if (u >= total) break;
    const int gsz_full = 8 * ntiles;
    const int g = u / gsz_full, r = u - g * gsz_full;
    const int gm = min(8, mtiles - g * 8);
    const int mt = mt_lo + g * 8 + r % gm, nt = r / gm;
    const unsigned oA = (unsigned)(((mt * 256 + ldrow) * lda + ldc) * 2);
    const unsigned oB = (unsigned)(((nt * 128 + ldrow) * ldb + ldc) * 2);
    const char* Ab = (const char*)A;
    const char* Bb = (const char*)Bt;
    f32x16 acc[4][2];
#pragma unroll
    for (int mi = 0; mi < 4; ++mi) { acc[mi][0] = zero16(); acc[mi][1] = zero16(); }
    uint4 xa0, xa1, xa2, xa3, xb0, xb1, ya0, ya1, ya2, ya3, yb0, yb1;
#define G4_LOADX(KT) do { const unsigned ka_ = oA + (unsigned)(KT) * 64u, kb_ = oB + (unsigned)(KT) * 64u; \
      xa0 = *reinterpret_cast<const uint4*>(Ab + ka_); xa1 = *reinterpret_cast<const uint4*>(Ab + (ka_ + 64u * (unsigned)lda * 2u)); \
      xa2 = *reinterpret_cast<const uint4*>(Ab + (ka_ + 128u * (unsigned)lda * 2u)); xa3 = *reinterpret_cast<const uint4*>(Ab + (ka_ + 192u * (unsigned)lda * 2u)); \
      xb0 = *reinterpret_cast<const uint4*>(Bb + kb_); xb1 = *reinterpret_cast<const uint4*>(Bb + (kb_ + 64u * (unsigned)ldb * 2u)); } while (0)
#define G4_LOADY(KT) do { const unsigned ka_ = oA + (unsigned)(KT) * 64u, kb_ = oB + (unsigned)(KT) * 64u; \
      ya0 = *reinterpret_cast<const uint4*>(Ab + ka_); ya1 = *reinterpret_cast<const uint4*>(Ab + (ka_ + 64u * (unsigned)lda * 2u)); \
      ya2 = *reinterpret_cast<const uint4*>(Ab + (ka_ + 128u * (unsigned)lda * 2u)); ya3 = *reinterpret_cast<const uint4*>(Ab + (ka_ + 192u * (unsigned)lda * 2u)); \
      yb0 = *reinterpret_cast<const uint4*>(Bb + kb_); yb1 = *reinterpret_cast<const uint4*>(Bb + (kb_ + 64u * (unsigned)ldb * 2u)); } while (0)
#define G4_STOREX(BUF) do { u16* wa_ = sA + (BUF) * 256 * LD4 + ldrow * LD4 + ldc; u16* wb_ = sB + (BUF) * 128 * LD4 + ldrow * LD4 + ldc; \
      *reinterpret_cast<uint4*>(wa_) = xa0; *reinterpret_cast<uint4*>(wa_ + 64 * LD4) = xa1; \
      *reinterpret_cast<uint4*>(wa_ + 128 * LD4) = xa2; *reinterpret_cast<uint4*>(wa_ + 192 * LD4) = xa3; \
      *reinterpret_cast<uint4*>(wb_) = xb0; *reinterpret_cast<uint4*>(wb_ + 64 * LD4) = xb1; } while (0)
#define G4_STOREY(BUF) do { u16* wa_ = sA + (BUF) * 256 * LD4 + ldrow * LD4 + ldc; u16* wb_ = sB + (BUF) * 128 * LD4 + ldrow * LD4 + ldc; \
      *reinterpret_cast<uint4*>(wa_) = ya0; *reinterpret_cast<uint4*>(wa_ + 64 * LD4) = ya1; \
      *reinterpret_cast<uint4*>(wa_ + 128 * LD4) = ya2; *reinterpret_cast<uint4*>(wa_ + 192 * LD4) = ya3; \
      *reinterpret_cast<uint4*>(wb_) = yb0; *reinterpret_cast<uint4*>(wb_ + 64 * LD4) = yb1; } while (0)
#define G4_COMPUTE(BUF) do { \
      const u16* a_ = sA + (BUF) * 256 * LD4 + (wm * 128 + lr) * LD4 + lh * 8; \
      const u16* b_ = sB + (BUF) * 128 * LD4 + (wn * 64 + lr) * LD4 + lh * 8; \
      _Pragma("unroll") for (int ks = 0; ks < 2; ++ks) { \
        const bf16x8 b0 = ld8(b_ + ks * 16), b1 = ld8(b_ + 32 * LD4 + ks * 16); \
        _Pragma("unroll") for (int mi = 0; mi < 4; ++mi) { \
          const bf16x8 a0 = ld8(a_ + mi * 32 * LD4 + ks * 16); \
          acc[mi][0] = mfma32(a0, b0, acc[mi][0]); acc[mi][1] = mfma32(a0, b1, acc[mi][1]); } } } while (0)
    G4_LOADX(0);
    G4_STOREX(0);
    G4_LOADX(1);
    if (nk > 2) G4_LOADY(2);
    __syncthreads();
    for (int kt = 0; kt < nk; kt += 2) {
      G4_COMPUTE(0);
      G4_STOREX(1);
      if (kt + 3 < nk) G4_LOADX(kt + 3);
      __syncthreads();
      G4_COMPUTE(1);
      if (kt + 2 < nk) G4_STOREY(0);
      if (kt + 4 < nk) G4_LOADY(kt + 4);
      __syncthreads();
    }
    { int lr_ = lr, lh_ = lh; asm volatile("" : "+v"(lr_), "+v"(lh_));
      epi.template operator()<4>(acc, mt * 256 + wm * 128, nt * 128 + wn * 64, nt, wn, lr_, lh_); }
  }
}

DI void phase_da_prep(const Params& p, char* smem) {
  u16* qk = (u16*)((char*)p.out + DO_QK);
  const int tid0 = opaque_tid();
  const int lane = tid0 & 63, wid = tid0 >> 6;
  const int nw = gridDim.x * 4;
  const int qq = lane & 3;
  const bool isk = lane >= 32;
  const float* gain = p.in[isk ? I_KN : I_QN] + qq * 16;
  for (int row = blockIdx.x * 4 + wid; row < MROWS; row += nw) {
    uint4* ptr = reinterpret_cast<uint4*>(qk + (size_t)row * 1024 + lane * 16);
    const uint4 v0 = ptr[0], v1 = ptr[1];
    float x[16];
    x[0] = bflo(v0.x); x[1] = bfhi(v0.x); x[2] = bflo(v0.y); x[3] = bfhi(v0.y); x[4] = bflo(v0.z); x[5] = bfhi(v0.z); x[6] = bflo(v0.w); x[7] = bfhi(v0.w);
    x[8] = bflo(v1.x); x[9] = bfhi(v1.x); x[10] = bflo(v1.y); x[11] = bfhi(v1.y); x[12] = bflo(v1.z); x[13] = bfhi(v1.z); x[14] = bflo(v1.w); x[15] = bfhi(v1.w);
    float ss = 0.f;
#pragma unroll
    for (int i = 0; i < 16; ++i) ss += x[i] * x[i];
    ss += __shfl_xor(ss, 1); ss += __shfl_xor(ss, 2);
    const float rinv = rsqrtf(ss * (1.f / 64.f) + EPSF) * (isk ? 1.f : 0.125f * 1.4426950408889634f);
#pragma unroll
    for (int i = 0; i < 16; ++i) x[i] = x[i] * rinv * gain[i];
    if (row >= LAT0) {
      const int t = (row - LAT0) & (SEQ - 1);
      const float pos = (float)((qq >> 1) ? (t & 63) : (t >> 6));
#pragma unroll
      for (int i = 0; i < 16; ++i) {
        const float other = __shfl_xor(x[i], 1);
        const float inv = exp2f(-(float)i * (13.287712379549449f / 16.f));
        const float ang = pos * inv;
        float rev = ang * 0.15915494309189535f;
        rev -= floorf(rev);
        const float sn = __builtin_amdgcn_sinf(rev), cs = __builtin_amdgcn_cosf(rev);
        x[i] = (qq & 1) ? (x[i] * cs + other * sn) : (x[i] * cs - other * sn);
      }
    }
    ptr[0] = make_uint4(pk2(x[0], x[1]), pk2(x[2], x[3]), pk2(x[4], x[5]), pk2(x[6], x[7]));
    ptr[1] = make_uint4(pk2(x[8], x[9]), pk2(x[10], x[11]), pk2(x[12], x[13]), pk2(x[14], x[15]));
  }
  const u16* vraw = (const u16*)(p.ws + WS_VRAW);
  u16* vt = (u16*)((char*)p.out + DO_VT);
  u16* sv = (u16*)smem;
  const int tid = tid0;
  for (int item = blockIdx.x; item < 2 * 4 * NCH; item += gridDim.x) {
    const int t = item % NCH, bh = item / NCH, b = bh >> 2, h = bh & 3;
    const int row0 = t < 4 ? b * CTXL + t * 64 : LAT0 + b * SEQ + (t - 4) * 64;
    {
      const int key = tid >> 2, ec = (tid & 3) * 32;
      const uint4* s = reinterpret_cast<const uint4*>(vraw + (size_t)(row0 + key) * 512 + h * 128 + ec);
#pragma unroll
      for (int i = 0; i < 4; ++i) {
        const uint4 v = s[i];
        u32* d = reinterpret_cast<u32*>(sv + key * 130 + ec + i * 8);
        d[0] = v.x; d[1] = v.y; d[2] = v.z; d[3] = v.w;
      }
    }
    __syncthreads();
    {
      const int e = tid >> 1, half = tid & 1;
      u32 w[16];
#pragma unroll
      for (int i = 0; i < 16; ++i) {
        const int p0 = half * 32 + 2 * i, p1 = p0 + 1;
        const int k0 = (p0 & ~12) | ((p0 & 4) << 1) | ((p0 & 8) >> 1);
        const int k1 = (p1 & ~12) | ((p1 & 4) << 1) | ((p1 & 8) >> 1);
        w[i] = (u32)sv[k0 * 130 + e] | ((u32)sv[k1 * 130 + e] << 16);
      }
      uint4* d = reinterpret_cast<uint4*>(vt + ((size_t)(bh * 128 + e)) * SK + t * 64 + half * 32);
      d[0] = make_uint4(w[0], w[1], w[2], w[3]); d[1] = make_uint4(w[4], w[5], w[6], w[7]);
      d[2] = make_uint4(w[8], w[9], w[10], w[11]); d[3] = make_uint4(w[12], w[13], w[14], w[15]);
    }
    __syncthreads();
  }
}

#define LDS_AS __attribute__((address_space(3)))
DI void glds16(const void* g, char* lds_wave_base) {
  __builtin_amdgcn_global_load_lds((const unsigned*)g, (LDS_AS unsigned*)lds_wave_base, 16, 0, 0);
}
#define RAW_BARRIER() do { asm volatile("s_waitcnt lgkmcnt(0)" ::: "memory"); __builtin_amdgcn_s_barrier(); } while (0)
DI void phase_da_attn(const Params& p, char* smem) {
  const u16* qk = (const u16*)((const char*)p.out + DO_QK);
  const u16* vt = (const u16*)((const char*)p.out + DO_VT);
  u16* mix = (u16*)(p.ws + WS_MIX);
  char* sK = smem;
  char* sV = smem + 32768;
  float* ex = (float*)smem;
  const int tid = opaque_tid(), lane = tid & 63, wid = __builtin_amdgcn_readfirstlane(tid >> 6), lr = lane & 31, lh = lane >> 5;
  const int qg = wid >> 1, mp = wid & 1;
  float lam;
  {
    const float a = p.in[I_LQ1][lane] * p.in[I_LK1][lane], b2 = p.in[I_LQ2][lane] * p.in[I_LK2][lane];
    lam = __expf(wave_sum(a)) - __expf(wave_sum(b2)) + 0.2f;
  }
  int* cnt = (int*)(p.ws + WS_CNT);
  int* sitem = (int*)(smem + 73728);
  if (tid == 0) { sitem[1] = (int)((unsigned)__builtin_amdgcn_s_getreg((3 << 11) | 20) & 7u); sitem[2] = 0; }
  const int x15 = lr & 15, f3 = (lr >> 2) & 3;
  for (;;) {
    if (tid == 0) {
      int got = -1, tries = sitem[2];
      const int home = sitem[1];
      while (tries < 8) {
        const int it = atomicAdd(&cnt[(home + tries) & 7], 1);
        if (it < 260) { got = ((home + tries) & 7) | (it << 3); break; }
        ++tries;
      }
      sitem[2] = tries;
      *sitem = got;
    }
    __syncthreads();
    const int item = *sitem;
    if (item < 0) break;
    const int bh = item & 7, b = bh >> 2, h = bh & 3, qb = item >> 3;
    const bool isctx = qb >= 256;
    const int qrow0 = isctx ? b * CTXL + (qb - 256) * 64 : LAT0 + b * SEQ + qb * 64;
    const int ntile = isctx ? 8 : 2 * NCH;
    const int myq = qrow0 + qg * 32 + lr;
    bf16x8 qf[4];
#pragma unroll
    for (int ks = 0; ks < 4; ++ks) qf[ks] = ld8(qk + (size_t)myq * 1024 + h * 128 + mp * 64 + ks * 16 + lh * 8);
    f32x16 O[4];
#pragma unroll
    for (int dt = 0; dt < 4; ++dt) O[dt] = zero16();
    float l = 0.f;
    const u16* vsrc0 = vt + (size_t)(bh * 128) * SK;
#define DA_DMA(T) do { const int t_ = (T); const int st_ = t_ & 3; \
      int lq = lane; asm volatile("" : "+v"(lq)); \
      const int krl_ = lq >> 4, kpl_ = lq & 15, vrl_ = lq >> 2, vpl_ = lq & 3; \
      const int krow0 = t_ < 8 ? b * CTXL + t_ * 32 : LAT0 + b * SEQ + (t_ - 8) * 32; \
      const char* kbt = (const char*)(qk + (size_t)krow0 * 1024 + 512 + h * 128); \
      const char* vbt = (const char*)(vsrc0 + t_ * 32); \
      char* kd = sK + st_ * 8192 + wid * 2048; char* vd = sV + st_ * 8192 + wid * 2048; \
      const unsigned kob = (unsigned)((wid * 8 + krl_) * 2048), vob = (unsigned)(((wid * 32 + vrl_) * SK) * 2); \
      glds16(kbt + (kob + (unsigned)(0 * 2048 + ((kpl_ ^ ((wid * 8 + 0 + krl_) & 15)) << 4))), kd); \
      glds16(kbt + (kob + (unsigned)(4 * 2048 + ((kpl_ ^ ((wid * 8 + 4 + krl_) & 15)) << 4))), kd + 1024); \
      glds16(vbt + (vob + (unsigned)(0 * SK * 2 + ((vpl_ ^ (((0 + vrl_) >> 2) & 3)) << 4))), vd); \
      glds16(vbt + (vob + (unsigned)(16 * SK * 2 + ((vpl_ ^ (((16 + vrl_) >> 2) & 3)) << 4))), vd + 1024); } while (0)
    DA_DMA(0); DA_DMA(1); DA_DMA(2);
#pragma unroll 1
    for (int t = 0; t < ntile; ++t) {
      if (t + 2 < ntile) asm volatile("s_waitcnt vmcnt(8)" ::: "memory");
      else if (t + 1 < ntile) asm volatile("s_waitcnt vmcnt(4)" ::: "memory");
      else asm volatile("s_waitcnt vmcnt(0)" ::: "memory");
      RAW_BARRIER();
      if (t + 3 < ntile) DA_DMA(t + 3);
      const int st = t & 3;
      const unsigned kb = (unsigned)(size_t)(LDS_AS char*)(sK + st * 8192 + lr * 256);
      const unsigned vb = (unsigned)(size_t)(LDS_AS char*)(sV + st * 8192 + lr * 64);
      bf16x8 k0, k1, k2, k3, v0, v1, v2, v3, v4, v5, v6, v7;
      asm volatile("ds_read_b128 %0, %4\n\tds_read_b128 %1, %5\n\tds_read_b128 %2, %6\n\tds_read_b128 %3, %7"
                   : "=&v"(k0), "=&v"(k1), "=&v"(k2), "=&v"(k3)
                   : "v"(kb + (((mp * 8 + 0 + lh) ^ x15) << 4)), "v"(kb + (((mp * 8 + 2 + lh) ^ x15) << 4)),
                     "v"(kb + (((mp * 8 + 4 + lh) ^ x15) << 4)), "v"(kb + (((mp * 8 + 6 + lh) ^ x15) << 4)) : "memory");
      const unsigned va = vb + (((0 + lh) ^ f3) << 4), vc = vb + (((2 + lh) ^ f3) << 4);
      asm volatile("ds_read_b128 %0, %8\n\tds_read_b128 %1, %9\n\tds_read_b128 %2, %8 offset:2048\n\tds_read_b128 %3, %9 offset:2048\n\t"
                   "ds_read_b128 %4, %8 offset:4096\n\tds_read_b128 %5, %9 offset:4096\n\tds_read_b128 %6, %8 offset:6144\n\tds_read_b128 %7, %9 offset:6144"
                   : "=&v"(v0), "=&v"(v1), "=&v"(v2), "=&v"(v3), "=&v"(v4), "=&v"(v5), "=&v"(v6), "=&v"(v7)
                   : "v"(va), "v"(vc) : "memory");
      asm volatile("s_waitcnt lgkmcnt(8)" : "+v"(k0), "+v"(k1), "+v"(k2), "+v"(k3) :: "memory");
      f32x16 s = zero16();
      s = mfma32(k0, qf[0], s); s = mfma32(k1, qf[1], s); s = mfma32(k2, qf[2], s); s = mfma32(k3, qf[3], s);
      float rs = 0.f;
#pragma unroll
      for (int i = 0; i < 16; ++i) { s[i] = __builtin_amdgcn_exp2f(s[i]); rs += s[i]; }
      l += rs;
      const bf16x8 pb0 = pack_step(s, 0), pb1 = pack_step(s, 1);
      asm volatile("s_waitcnt lgkmcnt(0)" : "+v"(v0), "+v"(v1), "+v"(v2), "+v"(v3), "+v"(v4), "+v"(v5), "+v"(v6), "+v"(v7) :: "memory");
      O[0] = mfma32(v0, pb0, O[0]); O[1] = mfma32(v2, pb0, O[1]); O[2] = mfma32(v4, pb0, O[2]); O[3] = mfma32(v6, pb0, O[3]);
      O[0] = mfma32(v1, pb1, O[0]); O[1] = mfma32(v3, pb1, O[1]); O[2] = mfma32(v5, pb1, O[2]); O[3] = mfma32(v7, pb1, O[3]);
    }
    __syncthreads();
    l += __shfl_xor(l, 32);
    if (mp == 1) {
      const float sc = lam / l;
#pragma unroll
      for (int dt = 0; dt < 4; ++dt)
#pragma unroll
        for (int i = 0; i < 16; ++i) ex[((qg * 4 + dt) * 16 + i) * 64 + lane] = O[dt][i] * sc;
    }
    __syncthreads();
    if (mp == 0) {
      const float i0 = 1.f / l;
      float ss = 0.f;
#pragma unroll
      for (int dt = 0; dt < 4; ++dt)
#pragma unroll
        for (int i = 0; i < 16; ++i) {
          const float v = O[dt][i] * i0 - ex[((qg * 4 + dt) * 16 + i) * 64 + lane];
          O[dt][i] = v; ss += v * v;
        }
      ss += __shfl_xor(ss, 32);
      const float rinv = rsqrtf(ss * (1.f / 128.f) + EPSF) * 0.8f;
      const float* sn = p.in[I_SUBN];
#pragma unroll
      for (int dt = 0; dt < 4; ++dt)
#pragma unroll
        for (int g = 0; g < 4; ++g) {
          const int dv = dt * 32 + 8 * g + 4 * lh;
          const float4 gn = *reinterpret_cast<const float4*>(sn + dv);
          const u32 w0 = pk2(O[dt][4 * g] * rinv * gn.x, O[dt][4 * g + 1] * rinv * gn.y);
          const u32 w1 = pk2(O[dt][4 * g + 2] * rinv * gn.z, O[dt][4 * g + 3] * rinv * gn.w);
          *reinterpret_cast<uint2*>(mix + (size_t)myq * 1024 + h * 128 + dv) = make_uint2(w0, w1);
        }
    }
    __syncthreads();
  }
}

template <int DIR>
DI void gdn_solve(float (&X)[64], int c, const float* sAm, const float* gc, const float* bt, const u16* skn, const u16* svv) {
  if (c < 128) {
#pragma unroll
    for (int i = 0; i < 64; ++i) {
      const int tok = DIR ? 63 - i : i;
      X[i] = bt[i] * bf2f(svv[tok * 128 + c]);
    }
  } else {
#pragma unroll
    for (int i = 0; i < 64; ++i) {
      const int tok = DIR ? 63 - i : i;
      X[i] = bt[i] * __expf(gc[i]) * bf2f(skn[tok * 136 + c - 128]);
    }
  }
  __builtin_amdgcn_sched_barrier(0);
#pragma unroll
  for (int i = 1; i < 64; ++i) {
    float acc = X[i];
    const float4* arow = reinterpret_cast<const float4*>(sAm + i * 64);
#pragma unroll
    for (int j4 = 0; j4 < (i + 3) / 4; ++j4) {
      const float4 a4 = arow[j4];
      if (4 * j4 + 0 < i) acc = __builtin_fmaf(-a4.x, X[4 * j4 + 0], acc);
      if (4 * j4 + 1 < i) acc = __builtin_fmaf(-a4.y, X[4 * j4 + 1], acc);
      if (4 * j4 + 2 < i) acc = __builtin_fmaf(-a4.z, X[4 * j4 + 2], acc);
      if (4 * j4 + 3 < i) acc = __builtin_fmaf(-a4.w, X[4 * j4 + 3], acc);
    }
    X[i] = acc;
    __builtin_amdgcn_sched_barrier(0);
  }
}

constexpr int QS = 136;
DI void phase_gdn_prep(const Params& p, char* smem) {
  u16* sq = (u16*)smem;
  u16* skn = sq + 64 * QS;
  float* sAm = (float*)(skn + 64 * QS);
  u16* sat = (u16*)(sAm + 64 * 64);
  float* sgc = (float*)(sat + 64 * 72);
  float* sbt = sgc + 128;
  u16* svv = (u16*)(sbt + 128);
  const u16* u0g = (const u16*)(p.ws + WS_U0G);
  const float* g0 = (const float*)(p.ws + WS_G0);
  const float* cw = p.in[I_GCONV];
  for (int item = blockIdx.x; item < 2 * NCH * 4; item += gridDim.x) {
    int tid = opaque_tid();
    const int lane = tid & 63, wid = __builtin_amdgcn_readfirstlane(tid >> 6), lr = lane & 31, lh = lane >> 5;
    const int h = item & 3, n = (item >> 2) % NCH, b = item / (4 * NCH);
    const int row0 = n < 4 ? b * CTXL + n * 64 : LAT0 + b * SEQ + (n - 4) * 64;
    const int t0 = n < 4 ? n * 64 : (n - 4) * 64;
    const int slen = n < 4 ? CTXL : SEQ;
    {
      int t1 = tid; asm volatile("" : "+v"(t1));
      const int cgp = t1 & 15, rg = t1 >> 4;
#pragma unroll
      for (int qk_ = 0; qk_ < 3; ++qk_) {
        const int chb = qk_ * 512 + h * 128 + cgp * 8;
        float wv[4][8];
#pragma unroll
        for (int j = 0; j < 4; ++j)
#pragma unroll
          for (int e = 0; e < 8; ++e) wv[j][e] = cw[j * 1536 + chb + e];
        float xin[7][8];
#pragma unroll
        for (int r = 0; r < 7; ++r) {
          const int tt = rg * 4 + r - 2;
          const int pos = t0 + tt;
          if (pos >= 0 && pos < slen) {
            const uint4 v = *reinterpret_cast<const uint4*>(u0g + (size_t)(row0 + tt) * 1536 + chb);
            xin[r][0] = bflo(v.x); xin[r][1] = bfhi(v.x); xin[r][2] = bflo(v.y); xin[r][3] = bfhi(v.y);
            xin[r][4] = bflo(v.z); xin[r][5] = bfhi(v.z); xin[r][6] = bflo(v.w); xin[r][7] = bfhi(v.w);
          } else {
#pragma unroll
            for (int e = 0; e < 8; ++e) xin[r][e] = 0.f;
          }
        }
#pragma unroll
        for (int r = 0; r < 4; ++r) {
          float y[8]; float ss = 0.f;
#pragma unroll
          for (int e = 0; e < 8; ++e) {
            float a = 0.f;
#pragma unroll
            for (int j = 0; j < 4; ++j) a += wv[j][e] * xin[r + j][e];
            y[e] = siluf_fast(a); ss += y[e] * y[e];
          }
          ss += __shfl_xor(ss, 1); ss += __shfl_xor(ss, 2); ss += __shfl_xor(ss, 4); ss += __shfl_xor(ss, 8);
          const float rinv = qk_ == 2 ? 1.f : rsqrtf(ss + EPSF);
          u16* d = qk_ == 2 ? svv + (rg * 4 + r) * 128 + cgp * 8 : (qk_ ? skn : sq) + (rg * 4 + r) * QS + cgp * 8;
          *reinterpret_cast<uint4*>(d) = make_uint4(pk2(y[0] * rinv, y[1] * rinv), pk2(y[2] * rinv, y[3] * rinv),
                                                    pk2(y[4] * rinv, y[5] * rinv), pk2(y[6] * rinv, y[7] * rinv));
        }
      }
    }
    if (wid < 2) {
      const int d = wid, tok = d ? 63 - lane : lane;
      const float* gr = g0 + (size_t)(row0 + tok) * 16;
      const float beta = sigmoidf_(gr[d * 4 + h]);
      const float g = -__expf(p.in[I_ALOG][d * 4 + h]) * softplusf_(gr[8 + d * 4 + h] + p.in[I_DTB][d * 4 + h]);
      float cs = g;
#pragma unroll
      for (int o = 1; o < 64; o <<= 1) { const float v = __shfl_up(cs, o); if (lane >= o) cs += v; }
      sgc[d * 64 + lane] = cs; sbt[d * 64 + lane] = beta;
    }
    __syncthreads();
    for (int d = 0; d < 2; ++d) {
      char* fr = p.ws + WS_FRAGS + (size_t)(((b * 2 + d) * 4 + h) * NCH + n) * FRAG_ITEM;
      const float* gc = sgc + d * 64;
      const float* bt = sbt + d * 64;
      {
        int lr_ = lr; asm volatile("" : "+v"(lr_));
        const int ti = wid >> 1, tj = wid & 1;
        const int ri = d ? 63 - (ti * 32 + lr_) : ti * 32 + lr_;
        const int rj = d ? 63 - (tj * 32 + lr_) : tj * 32 + lr_;
        f32x16 kk = zero16(), qkk = zero16();
#pragma unroll
        for (int ks = 0; ks < 8; ++ks) {
          const bf16x8 bk = ld8(skn + rj * QS + ks * 16 + lh * 8);
          kk = mfma32(ld8(skn + ri * QS + ks * 16 + lh * 8), bk, kk);
          qkk = mfma32(ld8(sq + ri * QS + ks * 16 + lh * 8), bk, qkk);
        }
        const int j = tj * 32 + lr_;
        const float gcj = gc[j];
#pragma unroll
        for (int r = 0; r < 16; ++r) {
          const int i = ti * 32 + crow(r, lh);
          const float dec = __expf(fminf(gc[i] - gcj, 0.f));
          sAm[i * 64 + j] = (i > j) ? bt[i] * kk[r] * dec : 0.f;
          sat[i * 72 + j] = f2bf((i >= j) ? qkk[r] * dec * 0.08838834764831845f : 0.f);
        }
      }
      __syncthreads();
      float X[64];
      if (d == 0) gdn_solve<0>(X, tid, sAm, gc, bt, skn, svv);
      else gdn_solve<1>(X, tid, sAm, gc, bt, skn, svv);
      __syncthreads();
      u16* sW = (u16*)sAm;
      if (tid >= 128) {
#pragma unroll
        for (int i = 0; i < 64; ++i) sW[i * 128 + tid - 128] = f2bf(-X[i]);
      } else {
        int tu = tid; asm volatile("" : "+v"(tu));
        const int sl = tu >> 5, n_ = tu & 31;
        u16* ud = (u16*)(fr + FR_U);
#pragma unroll
        for (int mt = 0; mt < 2; ++mt)
#pragma unroll
          for (int hh = 0; hh < 2; ++hh) {
            u32 w[8];
#pragma unroll
            for (int r2 = 0; r2 < 8; ++r2) w[r2] = pk2(X[mt * 32 + crow(2 * r2, hh)], X[mt * 32 + crow(2 * r2 + 1, hh)]);
            uint4* dd = reinterpret_cast<uint4*>(ud + ((size_t)((sl * 2 + mt) * 64 + hh * 32 + n_)) * 16);
            dd[0] = make_uint4(w[0], w[1], w[2], w[3]); dd[1] = make_uint4(w[4], w[5], w[6], w[7]);
          }
      }
      __syncthreads();
      int tq = tid; asm volatile("" : "+v"(tq));
      const float glast = gc[63];
      if (tid == 0) ((float*)(p.ws + WS_GL))[((b * 2 + d) * 4 + h) * NCH + n] = __expf(glast);
#pragma unroll 1
      for (int idx = tq; idx < 16 * 64; idx += 256) {
        const int L = idx & 63, f = idx >> 6, mt = f >> 3, ks = f & 7, m = L & 31, hh = L >> 5;
        const int i = mt * 32 + m, tok = d ? 63 - i : i;
        const int dk0 = 32 * (ks >> 1) + 16 * (ks & 1) + 4 * hh;
        const uint2 wa = *reinterpret_cast<const uint2*>(sW + i * 128 + dk0);
        const uint2 wb = *reinterpret_cast<const uint2*>(sW + i * 128 + dk0 + 8);
        reinterpret_cast<uint4*>(fr + FR_W)[idx] = make_uint4(wa.x, wa.y, wb.x, wb.y);
        const float sc = __expf(gc[i]) * 0.08838834764831845f;
        const uint2 qa = *reinterpret_cast<const uint2*>(sq + tok * QS + dk0);
        const uint2 qb = *reinterpret_cast<const uint2*>(sq + tok * QS + dk0 + 8);
        reinterpret_cast<uint4*>(fr + FR_Q)[idx] = make_uint4(pk2(bflo(qa.x) * sc, bfhi(qa.x) * sc), pk2(bflo(qa.y) * sc, bfhi(qa.y) * sc),
                                                             pk2(bflo(qb.x) * sc, bfhi(qb.x) * sc), pk2(bflo(qb.y) * sc, bfhi(qb.y) * sc));
      }
#pragma unroll 1
      for (int idx = tq; idx < 16 * 64; idx += 256) {
        const int L = idx & 63, f = idx >> 6, kt = f >> 2, ks = f & 3, m = L & 31, hh = L >> 5;
        float v[8];
#pragma unroll
        for (int j = 0; j < 8; ++j) {
          const int i = 32 * (ks >> 1) + krow(ks & 1, hh, j), tok = d ? 63 - i : i;
          v[j] = bf2f(skn[tok * QS + kt * 32 + m]) * __expf(glast - gc[i]);
        }
        reinterpret_cast<uint4*>(fr + FR_KT)[idx] = make_uint4(pk2(v[0], v[1]), pk2(v[2], v[3]), pk2(v[4], v[5]), pk2(v[6], v[7]));
      }
#pragma unroll 1
      for (int idx = tq; idx < 8 * 64; idx += 256) {
        const int L = idx & 63, f = idx >> 6, it = f >> 2, ks = f & 3, m = L & 31, hh = L >> 5;
        const int j0 = 32 * (ks >> 1) + 16 * (ks & 1) + 4 * hh;
        const uint2 a = *reinterpret_cast<const uint2*>(sat + (it * 32 + m) * 72 + j0);
        const uint2 bq = *reinterpret_cast<const uint2*>(sat + (it * 32 + m) * 72 + j0 + 8);
        reinterpret_cast<uint4*>(fr + FR_AT)[idx] = make_uint4(a.x, a.y, bq.x, bq.y);
      }
      __syncthreads();
    }
  }
}

DI void gdn_scan_chain(const Params& p, char* smem, int chain) {
  const int tid = opaque_tid(), lane = tid & 63, sl = __builtin_amdgcn_readfirstlane(tid >> 6);
  const int d = (chain >> 2) & 1;
  const float* GL = (const float*)(p.ws + WS_GL) + chain * NCH;
  uint4* sfr = reinterpret_cast<uint4*>(smem);
  f32x16 S[4];
#pragma unroll
  for (int kt = 0; kt < 4; ++kt) S[kt] = zero16();
  uint4 pf0, pf1, pf2, pf3, pf4, pf5, pf6, pf7, pf8, pf9, pf10, pf11, pf12, pf13;
  {
    const int n0 = d ? 3 : 0;
    const char* fr = p.ws + WS_FRAGS + (size_t)(chain * NCH + n0) * FRAG_ITEM;
    const uint4* g = reinterpret_cast<const uint4*>(fr) + tid;
    pf0 = g[0 * 256]; pf1 = g[1 * 256]; pf2 = g[2 * 256]; pf3 = g[3 * 256]; pf4 = g[4 * 256]; pf5 = g[5 * 256]; pf6 = g[6 * 256]; pf7 = g[7 * 256]; pf8 = g[8 * 256]; pf9 = g[9 * 256]; pf10 = g[10 * 256]; pf11 = g[11 * 256]; pf12 = g[12 * 256]; pf13 = g[13 * 256];
  }
  for (int step = 0; step < NCH; ++step) {
    const int n = d ? (step < 4 ? 3 - step : 263 - step) : step;
    char* frc = p.ws + WS_FRAGS + (size_t)(chain * NCH + n) * FRAG_ITEM;
    __syncthreads();
    sfr[0 * 256 + tid] = pf0; sfr[1 * 256 + tid] = pf1; sfr[2 * 256 + tid] = pf2; sfr[3 * 256 + tid] = pf3; sfr[4 * 256 + tid] = pf4; sfr[5 * 256 + tid] = pf5; sfr[6 * 256 + tid] = pf6; sfr[7 * 256 + tid] = pf7; sfr[8 * 256 + tid] = pf8; sfr[9 * 256 + tid] = pf9; sfr[10 * 256 + tid] = pf10; sfr[11 * 256 + tid] = pf11; sfr[12 * 256 + tid] = pf12; sfr[13 * 256 + tid] = pf13;
    __syncthreads();
    f32x16 Vn[2], O[2];
    const uint4* fuc = reinterpret_cast<const uint4*>(frc + FR_U) + (size_t)(sl * 128 + lane) * 2;
    const uint4 un0 = fuc[0], un1 = fuc[1], un2 = fuc[128], un3 = fuc[129];
    Vn[0] = zero16(); Vn[1] = zero16();
    O[0] = zero16(); O[1] = zero16();
    {
      const int s1 = step + 1 < NCH ? step + 1 : step;
      const int n1 = d ? (s1 < 4 ? 3 - s1 : 263 - s1) : s1;
      const char* fr = p.ws + WS_FRAGS + (size_t)(chain * NCH + n1) * FRAG_ITEM;
      const uint4* g = reinterpret_cast<const uint4*>(fr) + tid;
      pf0 = g[0 * 256]; pf1 = g[1 * 256]; pf2 = g[2 * 256]; pf3 = g[3 * 256]; pf4 = g[4 * 256]; pf5 = g[5 * 256]; pf6 = g[6 * 256]; pf7 = g[7 * 256]; pf8 = g[8 * 256]; pf9 = g[9 * 256]; pf10 = g[10 * 256]; pf11 = g[11 * 256]; pf12 = g[12 * 256]; pf13 = g[13 * 256];
    }
    const uint4* lw = sfr + lane;
    const uint4* lq = sfr + 1024 + lane;
    const uint4* lk = sfr + 2048 + lane;
    const uint4* la = sfr + 3072 + lane;
#pragma unroll
    for (int ks = 0; ks < 8; ++ks) {
      const bf16x8 sb = pack_step(S[ks >> 1], ks & 1);
#pragma unroll
      for (int mt = 0; mt < 2; ++mt) {
        Vn[mt] = mfma32(__builtin_bit_cast(bf16x8, lw[(mt * 8 + ks) * 64]), sb, Vn[mt]);
        O[mt] = mfma32(__builtin_bit_cast(bf16x8, lq[(mt * 8 + ks) * 64]), sb, O[mt]);
      }
    }
    {
      const uint4 a = un0, b2 = un1;
      Vn[0][0] += bflo(a.x); Vn[0][1] += bfhi(a.x); Vn[0][2] += bflo(a.y); Vn[0][3] += bfhi(a.y);
      Vn[0][4] += bflo(a.z); Vn[0][5] += bfhi(a.z); Vn[0][6] += bflo(a.w); Vn[0][7] += bfhi(a.w);
      Vn[0][8] += bflo(b2.x); Vn[0][9] += bfhi(b2.x); Vn[0][10] += bflo(b2.y); Vn[0][11] += bfhi(b2.y);
      Vn[0][12] += bflo(b2.z); Vn[0][13] += bfhi(b2.z); Vn[0][14] += bflo(b2.w); Vn[0][15] += bfhi(b2.w);
    }
    {
      const uint4 a = un2, b2 = un3;
      Vn[1][0] += bflo(a.x); Vn[1][1] += bfhi(a.x); Vn[1][2] += bflo(a.y); Vn[1][3] += bfhi(a.y);
      Vn[1][4] += bflo(a.z); Vn[1][5] += bfhi(a.z); Vn[1][6] += bflo(a.w); Vn[1][7] += bfhi(a.w);
      Vn[1][8] += bflo(b2.x); Vn[1][9] += bfhi(b2.x); Vn[1][10] += bflo(b2.y); Vn[1][11] += bfhi(b2.y);
      Vn[1][12] += bflo(b2.z); Vn[1][13] += bfhi(b2.z); Vn[1][14] += bflo(b2.w); Vn[1][15] += bfhi(b2.w);
    }
    bf16x8 Vb[2][2];
#pragma unroll
    for (int mt = 0; mt < 2; ++mt) { Vb[mt][0] = pack_step(Vn[mt], 0); Vb[mt][1] = pack_step(Vn[mt], 1); }
#pragma unroll
    for (int it = 0; it < 2; ++it)
#pragma unroll
      for (int ks = 0; ks < 4; ++ks) O[it] = mfma32(__builtin_bit_cast(bf16x8, la[(it * 4 + ks) * 64]), Vb[ks >> 1][ks & 1], O[it]);
    const float gl = GL[n];
#pragma unroll
    for (int kt = 0; kt < 4; ++kt) {
#pragma unroll
      for (int i = 0; i < 16; ++i) S[kt][i] *= gl;
#pragma unroll
      for (int ks = 0; ks < 4; ++ks) S[kt] = mfma32(__builtin_bit_cast(bf16x8, lk[(kt * 4 + ks) * 64]), Vb[ks >> 1][ks & 1], S[kt]);
    }
    uint4* fo = reinterpret_cast<uint4*>(frc + FR_U) + (size_t)(sl * 128 + lane) * 2;
#pragma unroll
    for (int mt = 0; mt < 2; ++mt) {
      fo[mt * 128] = make_uint4(pk2(O[mt][0], O[mt][1]), pk2(O[mt][2], O[mt][3]), pk2(O[mt][4], O[mt][5]), pk2(O[mt][6], O[mt][7]));
      fo[mt * 128 + 1] = make_uint4(pk2(O[mt][8], O[mt][9]), pk2(O[mt][10], O[mt][11]), pk2(O[mt][12], O[mt][13]), pk2(O[mt][14], O[mt][15]));
    }
  }
  __syncthreads();
}

DI void phase_gdn_finish(const Params& p, char* smem) {
  u16* so = (u16*)smem;
  const u16* zb = (const u16*)(p.ws + WS_Z);
  u16* mix = (u16*)(p.ws + WS_MIX);
  const float* on = p.in[I_ONORM];
  const int tid = opaque_tid();
  for (int item = blockIdx.x; item < 2 * NCH * 4; item += gridDim.x) {
    const int h = item & 3, n = (item >> 2) % NCH, b = item / (4 * NCH);
    const int row0 = n < 4 ? b * CTXL + n * 64 : LAT0 + b * SEQ + (n - 4) * 64;
#pragma unroll
    for (int d = 0; d < 2; ++d) {
      const uint4* src = reinterpret_cast<const uint4*>(p.ws + WS_FRAGS + (size_t)(((b * 2 + d) * 4 + h) * NCH + n) * FRAG_ITEM + FR_U);
      uint4* dst = reinterpret_cast<uint4*>(so + d * 8192);
#pragma unroll
      for (int i = 0; i < 4; ++i) dst[tid + 256 * i] = src[tid + 256 * i];
    }
    __syncthreads();
    const int t = tid >> 2, sl = tid & 3;
    float v[32]; float ss = 0.f;
    {
      const int i0 = t, i1 = 63 - t;
      const int mt0 = i0 >> 5, m0 = i0 & 31, hh0 = (m0 >> 2) & 1, rg0 = (m0 & 3) + 4 * (m0 >> 3);
      const int mt1 = i1 >> 5, m1 = i1 & 31, hh1 = (m1 >> 2) & 1, rg1 = (m1 & 3) + 4 * (m1 >> 3);
#pragma unroll
      for (int e = 0; e < 32; ++e) {
        const float a = bf2f(so[((sl * 2 + mt0) * 64 + hh0 * 32 + e) * 16 + rg0]);
        const float c = bf2f(so[8192 + ((sl * 2 + mt1) * 64 + hh1 * 32 + e) * 16 + rg1]);
        v[e] = a + c; ss += v[e] * v[e];
      }
    }
    ss += __shfl_xor(ss, 1); ss += __shfl_xor(ss, 2);
    const float rinv = rsqrtf(ss * (1.f / 128.f) + EPSF);
    const u16* zr = zb + (size_t)(row0 + t) * 512 + h * 128 + sl * 32;
    u16* mr = mix + (size_t)(row0 + t) * 1024 + 512 + h * 128 + sl * 32;
    uint4 zq0 = *reinterpret_cast<const uint4*>(zr), zq1 = *reinterpret_cast<const uint4*>(zr + 8);
    uint4 zq2 = *reinterpret_cast<const uint4*>(zr + 16), zq3 = *reinterpret_cast<const uint4*>(zr + 24);
#pragma unroll
    for (int e8 = 0; e8 < 4; ++e8) {
      const uint4 zz = e8 == 0 ? zq0 : (e8 == 1 ? zq1 : (e8 == 2 ? zq2 : zq3));
      const u32 zw[4] = {zz.x, zz.y, zz.z, zz.w};
      u32 w[4];
#pragma unroll
      for (int q = 0; q < 4; ++q) {
        const int e = e8 * 8 + 2 * q;
        const float o0 = v[e] * rinv * on[sl * 32 + e] * siluf_fast(bflo(zw[q]));
        const float o1 = v[e + 1] * rinv * on[sl * 32 + e + 1] * siluf_fast(bfhi(zw[q]));
        w[q] = pk2(o0, o1);
      }
      *reinterpret_cast<uint4*>(mr + e8 * 8) = make_uint4(w[0], w[1], w[2], w[3]);
    }
    __syncthreads();
  }
}

DI void phase_lru_conv(const Params& p) {
  const u16* ur = (const u16*)(p.ws + WS_UR);
  u16* xc = (u16*)(p.ws + WS_XC);
  const float* cw = p.in[I_OCONVW];
  const float* cb = p.in[I_OCONVB];
  const size_t total = (size_t)MROWS * 128;
  for (size_t idx = (size_t)blockIdx.x * 256 + opaque_tid(); idx < total; idx += (size_t)gridDim.x * 256) {
    const int row = (int)(idx >> 7), c0 = (int)(idx & 127) * 8;
    int pos, slen;
    if (row < LAT0) { pos = row & (CTXL - 1); slen = CTXL; } else { pos = (row - LAT0) & (SEQ - 1); slen = SEQ; }
    float a[8];
#pragma unroll
    for (int e = 0; e < 8; ++e) a[e] = cb[c0 + e];
#pragma unroll
    for (int j = 0; j < 4; ++j) {
      const int pp = pos + j - 2;
      if (pp >= 0 && pp < slen) {
        const uint4 v = *reinterpret_cast<const uint4*>(ur + (size_t)(row + j - 2) * DM + c0);
        const float4 w0 = *reinterpret_cast<const float4*>(cw + j * 1024 + c0);
        const float4 w1 = *reinterpret_cast<const float4*>(cw + j * 1024 + c0 + 4);
        a[0] += w0.x * bflo(v.x); a[1] += w0.y * bfhi(v.x); a[2] += w0.z * bflo(v.y); a[3] += w0.w * bfhi(v.y);
        a[4] += w1.x * bflo(v.z); a[5] += w1.y * bfhi(v.z); a[6] += w1.z * bflo(v.w); a[7] += w1.w * bfhi(v.w);
      }
    }
    *reinterpret_cast<uint4*>(xc + (size_t)row * DM + c0) = make_uint4(pk2(a[0], a[1]), pk2(a[2], a[3]), pk2(a[4], a[5]), pk2(a[6], a[7]));
  }
}

DI int chunk_row0(int b, int n) { return n < 4 ? b * CTXL + n * 64 : LAT0 + b * SEQ + (n - 4) * 64; }
DI void phase_lru_pass1(const Params& p) {
  const u16* ab = (const u16*)(p.ws + WS_AB);
  float* ph = (float*)(p.ws + WS_PH);
  const int total = 2 * 2 * NCH * 1024;
  for (int idx = blockIdx.x * 256 + opaque_tid(); idx < total; idx += gridDim.x * 256) {
    const int ch = idx & 1023, n = (idx >> 10) % NCH, b = ((idx >> 10) / NCH) & 1, d = (idx >> 10) / (2 * NCH);
    const u16* la = ab + (size_t)d * 2 * MROWS * DM + (size_t)chunk_row0(b, n) * DM + ch;
    const u16* bb = la + (size_t)MROWS * DM;
    float P = 0.f, H = 0.f;
#pragma unroll 8
    for (int i = 0; i < 64; ++i) {
      const int t = d ? 63 - i : i;
      const float lg = bf2f(la[(size_t)t * DM]);
      H = __expf(lg) * H + bf2f(bb[(size_t)t * DM]);
      P += lg;
    }
    ph[(size_t)idx * 2] = P; ph[(size_t)idx * 2 + 1] = H;
  }
}
DI void phase_lru_pass2(const Params& p) {
  const float2* __restrict__ ph = (const float2*)(p.ws + WS_PH);
  float* __restrict__ cin = (float*)(p.ws + WS_CIN);
  const int total = 2 * 2 * 1024;
  for (int idx = blockIdx.x * 256 + opaque_tid(); idx < total; idx += gridDim.x * 256) {
    const int ch = idx & 1023, b = (idx >> 10) & 1, d = idx >> 11;
    float hcar = 0.f;
    for (int s0 = 0; s0 < NCH; s0 += 20) {
      float2 v[20];
#pragma unroll
      for (int u = 0; u < 20; ++u) {
        const int step = s0 + u;
        const int n = d ? (step < 4 ? 3 - step : 263 - step) : step;
        v[u] = ph[(size_t)((d * 2 + b) * NCH + n) * 1024 + ch];
      }
#pragma unroll
      for (int u = 0; u < 20; ++u) {
        const int step = s0 + u;
        const int n = d ? (step < 4 ? 3 - step : 263 - step) : step;
        cin[(size_t)((d * 2 + b) * NCH + n) * 1024 + ch] = hcar;
        hcar = __expf(v[u].x) * hcar + v[u].y;
      }
    }
  }
}
DI float gelu_tanh(float x) {
  const float u = 0.7978845608028654f * (x + 0.044715f * x * x * x);
  const float t = 1.f - 2.f * __builtin_amdgcn_rcpf(1.f + __expf(2.f * u));
  return 0.5f * x * (1.f + t);
}
DI void phase_lru_pass3(const Params& p) {
  const u16* ab = (const u16*)(p.ws + WS_AB);
  const float* cin = (const float*)(p.ws + WS_CIN);
  u16* ug = (u16*)(p.ws + WS_UG);
  const int total = 2 * 256 * 1024;
  for (int idx = blockIdx.x * 256 + opaque_tid(); idx < total; idx += gridDim.x * 256) {
    const int ch = idx & 1023, nl = (idx >> 10) & 255, b = idx >> 18, n = nl + 4;
    const size_t rowoff = (size_t)chunk_row0(b, n) * DM + ch;
    float hf[64];
    {
      const u16* la = ab + rowoff;
      const u16* bb = la + (size_t)MROWS * DM;
      float hcur = cin[(size_t)((0 * 2 + b) * NCH + n) * 1024 + ch];
#pragma unroll
      for (int i = 0; i < 64; ++i) {
        hcur = __expf(bf2f(la[(size_t)i * DM])) * hcur + bf2f(bb[(size_t)i * DM]);
        hf[i] = hcur;
      }
    }
    {
      const u16* la = ab + (size_t)2 * MROWS * DM + rowoff;
      const u16* bb = la + (size_t)MROWS * DM;
      float hcur = cin[(size_t)((1 * 2 + b) * NCH + n) * 1024 + ch];
#pragma unroll
      for (int i = 63; i >= 0; --i) {
        hcur = __expf(bf2f(la[(size_t)i * DM])) * hcur + bf2f(bb[(size_t)i * DM]);
        hf[i] += hcur;
      }
      u16* y = ug + ((size_t)(b * SEQ + nl * 64)) * DM + ch;
#pragma unroll
      for (int g4 = 0; g4 < 4; ++g4) {
        float yv[16];
#pragma unroll
        for (int i = 0; i < 16; ++i) yv[i] = bf2f(y[(size_t)(g4 * 16 + i) * DM]);
#pragma unroll
        for (int i = 0; i < 16; ++i) y[(size_t)(g4 * 16 + i) * DM] = f2bf(gelu_tanh(yv[i]) * hf[g4 * 16 + i]);
      }
    }
  }
}

#define XB_TMO      128
#define XB_XCNT(j)  (256  + 64 * (j))
#define XB_XSUB(j)  (1280 + 64 * (j))
#define XB_XGEN(j)  (2304 + 64 * (j))
#define XB_TOP      3328
#define XB_TOPGEN   3392
#define XCD_BAR_WORDS 3456
#define XB_SPIN_CAP (1u << 18)
#define LAS __attribute__((address_space(3)))

__device__ __forceinline__ unsigned xb_ld(unsigned* p)              { return __hip_atomic_load(p, __ATOMIC_RELAXED, __HIP_MEMORY_SCOPE_AGENT); }
__device__ __forceinline__ unsigned xb_add(unsigned* p, unsigned v) { return __hip_atomic_fetch_add(p, v, __ATOMIC_RELAXED, __HIP_MEMORY_SCOPE_AGENT); }
__device__ __forceinline__ unsigned xb_xcc_id() { return (unsigned)__builtin_amdgcn_s_getreg((3 << 11) | 20) & 0xFu; }
#define XB_SPIN(cond, bar) do { unsigned _sp = 0; while (cond) { __builtin_amdgcn_s_sleep(1); \
    if ((++_sp & 255u) == 0u) { if (xb_ld(&(bar)[XB_TMO])) break; if (_sp > XB_SPIN_CAP) { atomicAdd(&(bar)[XB_TMO], 1u); break; } } } } while (0)

struct XcdBarrier {
    unsigned* bar; unsigned x;
    volatile LAS unsigned* st;
};

__device__ __forceinline__ XcdBarrier xcd_barrier_post(unsigned* bar, volatile LAS unsigned* st) {
    XcdBarrier b; b.bar = bar; b.x = xb_xcc_id(); b.st = st;
    if (threadIdx.x == 0) (void)xb_add(&bar[XB_XCNT(b.x)], 1u);
    return b;
}
__device__ __forceinline__ void xcd_barrier_complete(unsigned* bar, unsigned x, unsigned& nloc, unsigned& nx) {
    const unsigned G = gridDim.x * gridDim.y * gridDim.z;
    unsigned sum, cnt, mine, sp = 0u;
    for (;;) {
        sum = 0u; cnt = 0u; mine = 0u;
#pragma unroll
        for (unsigned j = 0; j < 16; ++j) { const unsigned c = xb_ld(&bar[XB_XCNT(j)]); sum += c; cnt += (c > 0u) ? 1u : 0u; mine = (j == x) ? c : mine; }
        if (sum == G) break;
        __builtin_amdgcn_s_sleep(1);
        if ((++sp & 255u) == 0u) { if (xb_ld(&bar[XB_TMO])) break; if (sp > XB_SPIN_CAP) { atomicAdd(&bar[XB_TMO], 1u); break; } }
    }
    nloc = mine > 0u ? mine : 1u; nx = cnt > 0u ? cnt : 1u;
}

__device__ __forceinline__ void xcd_barrier(const XcdBarrier& b) {
    asm volatile("s_waitcnt vmcnt(0)" ::: "memory");
    __syncthreads();
    if (opaque_tid() == 0) {
        unsigned* bar = b.bar;
        __builtin_amdgcn_s_waitcnt(0);
        unsigned nloc = b.st[0], nx = b.st[1];
        if (nloc == 0u) { xcd_barrier_complete(bar, b.x, nloc, nx); b.st[0] = nloc; b.st[1] = nx; }
        const unsigned old = xb_add(&bar[XB_XSUB(b.x)], 1u);
        const unsigned gen = old / nloc;
        if (old + 1u == (gen + 1u) * nloc) {
            __builtin_amdgcn_fence(__ATOMIC_RELEASE, "agent");
            asm volatile("s_waitcnt vmcnt(0)" ::: "memory");
            const unsigned og = xb_add(&bar[XB_TOP], 1u);
            const unsigned tg = og / nx;
            if (og + 1u == (tg + 1u) * nx) xb_add(&bar[XB_TOPGEN], 1u);
            else XB_SPIN(xb_ld(&bar[XB_TOPGEN]) == tg, bar);
            __builtin_amdgcn_fence(__ATOMIC_ACQUIRE, "agent");
            xb_add(&bar[XB_XGEN(b.x)], 1u);
            asm volatile("s_waitcnt vmcnt(0)" ::: "memory");
        } else {
            XB_SPIN(xb_ld(&bar[XB_XGEN(b.x)]) == gen, bar);
            __builtin_amdgcn_fence(__ATOMIC_ACQUIRE, "agent");
            asm volatile("s_waitcnt vmcnt(0)" ::: "memory");
        }
    }
    __syncthreads();
}


template <int PH>
DI void run_phase(const Params& p, char* smem) {
  char* ws = p.ws;
  const float* MOD = (const float*)(ws + WS_MOD);
  float* HC = (float*)(ws + WS_HCTX);
  if constexpr (PH == 0) { phase_convert(p, smem); phase_mod(p, smem); }
  else if constexpr (PH == 1) phase_modulate(p.in[I_CTX], p.in[I_X], p.in[I_EN1], MOD, 0, 0, (u16*)(ws + WS_A));
  else if constexpr (PH == 2) {
    EpiIn0 e{(u16*)((char*)p.out + DO_QK), (u16*)(ws + WS_VRAW), (u16*)(ws + WS_U0G), (u16*)(ws + WS_Z), (float*)(ws + WS_G0)};
    gemm_phase4((const u16*)(ws + WS_A), 1024, (const u16*)(ws + WS_WT0IN), 1024, 1024, 0, 130, 29, smem, e);
  }
  else if constexpr (PH == 3) phase_da_prep(p, smem);
  else if constexpr (PH == 4) phase_gdn_prep(p, smem);
  else if constexpr (PH == 5) { }
  else if constexpr (PH == 6) { if (blockIdx.x < 16) gdn_scan_chain(p, smem, blockIdx.x); phase_da_attn(p, smem); }
  else if constexpr (PH == 7) phase_gdn_finish(p, smem);
  else if constexpr (PH == 8) {
    EpiResid e{p.in[I_CTX], p.in[I_X], HC, p.out, MOD + 2 * 1024};
    gemm_phase((const u16*)(ws + WS_MIX), 1024, (const u16*)(ws + WS_WT0OUT), 1024, 1024, 0, 260, 8, 1 << 20, smem, e);
  }
  else if constexpr (PH == 9) phase_modulate(HC, p.out, p.in[I_EN2], MOD, 3, 0, (u16*)(ws + WS_A));
  else if constexpr (PH == 10) {
    EpiSwiglu e{(u16*)(ws + WS_ACT)};
    gemm_phase4((const u16*)(ws + WS_A), 1024, (const u16*)(ws + WS_WT0GU), 1024, 1024, 0, 130, 44, smem, e);
  }
  else if constexpr (PH == 11) {
    EpiResid e{HC, p.out, HC, p.out, MOD + 5 * 1024};
    gemm_phase((const u16*)(ws + WS_ACT), FFH, (const u16*)(ws + WS_WT0DN), FFH, FFH, 0, 260, 8, 1 << 20, smem, e);
  }
  else if constexpr (PH == 12) phase_modulate(HC, p.out, p.in[I_ON1], MOD + 3 * 6144, 0, 0, (u16*)(ws + WS_A));
  else if constexpr (PH == 13) {
    EpiIn1 e{(u16*)(ws + WS_UG), (u16*)(ws + WS_UR)};
    gemm_phase4((const u16*)(ws + WS_A), 1024, (const u16*)(ws + WS_WT1IN), 1024, 1024, 0, 130, 16, smem, e);
  }
  else if constexpr (PH == 14) phase_lru_conv(p);
  else if constexpr (PH == 15) {
    EpiGates e{(const u16*)(ws + WS_XC), (u16*)(ws + WS_AB), p.in[I_OBR], p.in[I_OBI], p.in[I_OLAM]};
    gemm_phase((const u16*)(ws + WS_XC), 1024, (const u16*)(ws + WS_WT1G), 128, 128, 0, 260, 32, 4, smem, e);
  }
  else if constexpr (PH == 16) phase_lru_pass1(p);
  else if constexpr (PH == 17) phase_lru_pass2(p);
  else if constexpr (PH == 18) phase_lru_pass3(p);
  else if constexpr (PH == 19) {
    EpiResid e{nullptr, p.out, nullptr, p.out, MOD + 3 * 6144 + 2 * 1024};
    gemm_phase((const u16*)(ws + WS_UG) - (size_t)LAT0 * DM, 1024, (const u16*)(ws + WS_WT1OUT), 1024, 1024, 4, 256, 8, 1 << 20, smem, e);
  }
  else if constexpr (PH == 20) phase_modulate(HC, p.out, p.in[I_ON2], MOD + 3 * 6144, 3, LAT0, (u16*)(ws + WS_A));
  else if constexpr (PH == 21) {
    EpiSwiglu e{(u16*)(ws + WS_ACT)};
    gemm_phase4((const u16*)(ws + WS_A), 1024, (const u16*)(ws + WS_WT1GU), 1024, 1024, 2, 128, 44, smem, e);
  }
  else if constexpr (PH == 22) {
    EpiResid e{nullptr, p.out, nullptr, p.out, MOD + 3 * 6144 + 5 * 1024};
    gemm_phase((const u16*)(ws + WS_ACT), FFH, (const u16*)(ws + WS_WT1DN), FFH, FFH, 4, 256, 8, 1 << 20, smem, e);
  }
}
constexpr int NPHASE = 23;

#if MULTI_LAUNCH
template <int PH>
__global__ void __launch_bounds__(256, 2) phase_kernel(Params p) {
  __shared__ __attribute__((aligned(16))) char smem[SMEM_BYTES];
  run_phase<PH>(p, smem);
}
template <int PH>
static void launch_all(const Params& p, int grid, hipStream_t stream) {
  if constexpr (PH < NPHASE) {
    hipLaunchKernelGGL(phase_kernel<PH>, dim3(grid), dim3(256), 0, stream, p);
    launch_all<PH + 1>(p, grid, stream);
  }
}
#else
template <int PH>
DI void run_all(const Params& p, char* smem, cg::grid_group& grid, const XcdBarrier& xb) {
  if constexpr (PH < NPHASE) {
    run_phase<PH>(p, smem);
    if constexpr (PH == PROBE_DUP || PH == PROBE_DUP2) { xcd_barrier(xb); run_phase<PH>(p, smem); }
    if constexpr (PH == 0) grid.sync();
    else if constexpr (PH + 1 < NPHASE && PH != 5) xcd_barrier(xb);
    run_all<PH + 1>(p, smem, grid, xb);
  }
}
__global__ void __launch_bounds__(256, 2) mega_kernel(Params p) {
  __shared__ __attribute__((aligned(16))) char smem[SMEM_BYTES];
  __shared__ uint4 xb_words;
  if (threadIdx.x == 0) xb_words = make_uint4(0u, 0u, 0u, 0u);
  if ((threadIdx.x & 63) == 0) g_wtab[hw_wave_slot()] = threadIdx.x >> 6;
  __syncthreads();
  cg::grid_group grid = cg::this_grid();
  XcdBarrier xb = xcd_barrier_post((unsigned*)(p.ws + WS_BAR), (volatile LAS unsigned*)&xb_words);
  for (int i = 0; i < PROBE_SYNCS; ++i) xcd_barrier(xb);
  run_all<0>(p, smem, grid, xb);
}
#endif

extern "C" void kernel_launch(void* const* d_in, const int* in_sizes, int n_in, void* d_out, int out_size, void* d_ws, size_t ws_size,
                              hipStream_t stream) {
  if (n_in != 38 || ws_size < WS_NEED || out_size != 2 * SEQ * DM) {
    fprintf(stderr, "kernel_launch: unexpected shapes (n_in %d, ws %zu, out %d)\n", n_in, ws_size, out_size);
    return;
  }
  Params p{};
  for (int i = 0; i < 38; ++i) p.in[i] = (const float*)d_in[i];
  p.out = (float*)d_out;
  p.ws = (char*)d_ws;
#if MULTI_LAUNCH
  launch_all<0>(p, 512, stream);
#else
  static int grid_blocks = 0;
  if (!grid_blocks) {
    int dev = 0, cus = 0, per_cu = 0;
    hipGetDevice(&dev);
    hipDeviceGetAttribute(&cus, hipDeviceAttributeMultiprocessorCount, dev);
    hipOccupancyMaxActiveBlocksPerMultiprocessor(&per_cu, mega_kernel, 256, 0);
    if (per_cu < 1) per_cu = 1;
    if (per_cu > 2) per_cu = 2;
    grid_blocks = cus * per_cu;
  }
  (void)hipMemsetAsync((char*)d_ws + WS_CNT, 0, 65536 + XCD_BAR_WORDS * 4, stream);
  void* args[] = {&p};
  hipError_t e = hipLaunchCooperativeKernel((void*)mega_kernel, dim3(grid_blocks), dim3(256), args, 0, stream);
  if (e != hipSuccess) fprintf(stderr, "cooperative launch failed: %s (grid %d)\n", hipGetErrorString(e), grid_blocks);
#endif
}
```

```cpp
#include <hip/hip_runtime.h>
#include <hip/hip_cooperative_groups.h>
#include <cstdio>
namespace cg = cooperative_groups;

#ifndef MULTI_LAUNCH
#define MULTI_LAUNCH 0
#endif
#ifndef PROBE_DUP
#define PROBE_DUP -1
#define PROBE_DUP2 -1
#define PROBE_SYNCS 0
#endif

#define DI __device__ __forceinline__
typedef unsigned short u16;
typedef unsigned int u32;
using bf16x8 = __attribute__((ext_vector_type(8))) short;
using f32x16 = __attribute__((ext_vector_type(16))) float;
typedef __bf16 bf2_t __attribute__((ext_vector_type(2)));
typedef float f2_t __attribute__((ext_vector_type(2)));

constexpr int SEQ = 16384, CTXL = 256, DM = 1024, MROWS = 33280, LAT0 = 512;
constexpr int SK = 16640;
constexpr int FFH = 2816;
constexpr int NCH = 260;
constexpr float EPSF = 1e-6f;

constexpr size_t MiB = 1048576;
constexpr size_t WS_WT0IN = 0, WS_WT0OUT = 8 * MiB, WS_WT0GU = 10 * MiB, WS_WT0DN = 21 * MiB;
constexpr size_t WS_WT1IN = 27 * MiB, WS_WT1G = 31 * MiB, WS_WT1OUT = 32 * MiB, WS_WT1GU = 34 * MiB, WS_WT1DN = 45 * MiB;
constexpr size_t WS_MOD = 51 * MiB, WS_G0 = 52 * MiB, WS_HCTX = 55 * MiB, WS_GL = 57 * MiB, WS_PH = 58 * MiB;
constexpr size_t WS_CNT = 67 * MiB;
constexpr size_t WS_BAR = 67 * MiB + 65536;
constexpr size_t WS_BIG = 68 * MiB;
constexpr size_t WS_FRAGS = WS_BIG;
constexpr size_t WS_A = WS_BIG;
constexpr size_t WS_VRAW = WS_BIG + 65 * MiB;
constexpr size_t WS_ACT = WS_BIG + 65 * MiB;
constexpr size_t WS_U0G = 361 * MiB;
constexpr size_t WS_MIX = 361 * MiB;
constexpr size_t WS_Z = 459 * MiB;
constexpr size_t WS_UR = WS_BIG + 65 * MiB;
constexpr size_t WS_AB = WS_BIG;
constexpr size_t WS_XC = 328 * MiB;
constexpr size_t WS_UG = 393 * MiB;
constexpr size_t WS_CIN = 459 * MiB;
constexpr size_t WS_NEED = 512 * MiB;
constexpr size_t FRAG_ITEM = 73728;
constexpr size_t FR_W = 0, FR_Q = 16384, FR_KT = 32768, FR_AT = 49152, FR_U = 57344;
constexpr size_t DO_QK = 0, DO_VT = 65 * MiB;

struct Params {
  const float* in[38];
  float* out;
  char* ws;
};
enum { I_X = 0, I_C, I_CTX, I_CCTX, I_EN1, I_EN2, I_EADAW, I_EADAB, I_EWIN, I_EWOUT, I_QN, I_KN, I_LQ1, I_LK1, I_LQ2, I_LK2,
       I_SUBN, I_GCONV, I_ALOG, I_DTB, I_ONORM, I_EWGU, I_EWDN, I_ON1, I_ON2, I_OADAW, I_OADAB, I_OWIN, I_OCONVW, I_OCONVB,
       I_OWR, I_OBR, I_OWI, I_OBI, I_OLAM, I_OWOUT, I_OWGU, I_OWDN };

DI u32 pk2(float a, float b) { f2_t v = {a, b}; bf2_t r = __builtin_convertvector(v, bf2_t); return __builtin_bit_cast(u32, r); }
DI u16 f2bf(float a) { return (u16)(pk2(a, 0.f) & 0xffffu); }
DI float bf2f(u16 v) { return __uint_as_float(((u32)v) << 16); }
DI float bflo(u32 v) { return __uint_as_float(v << 16); }
DI float bfhi(u32 v) { return __uint_as_float(v & 0xffff0000u); }
DI int crow(int reg, int h) { return (reg & 3) + 8 * (reg >> 2) + 4 * h; }
DI int krow(int s, int h, int j) { return 16 * s + 8 * (j >> 2) + 4 * h + (j & 3); }
DI float sigmoidf_(float x) { return 1.f / (1.f + __expf(-x)); }
DI float siluf_(float x) { return x / (1.f + __expf(-x)); }
DI float siluf_fast(float x) { return x * __builtin_amdgcn_rcpf(1.f + __expf(-x)); }
DI float sigmoidf_fast(float x) { return __builtin_amdgcn_rcpf(1.f + __expf(-x)); }
DI float softplusf_(float x) { return x > 20.f ? x : log1pf(__expf(x)); }
DI float wave_sum(float v) {
#pragma unroll
  for (int o = 32; o >= 1; o >>= 1) v += __shfl_xor(v, o);
  return v;
}
DI f32x16 mfma32(bf16x8 a, bf16x8 b, f32x16 c) { return __builtin_amdgcn_mfma_f32_32x32x16_bf16(a, b, c, 0, 0, 0); }
DI bf16x8 ld8(const u16* p) { return *reinterpret_cast<const bf16x8*>(p); }
DI bf16x8 pack_step(const f32x16& x, int s) {
  uint4 r;
  r.x = pk2(x[8 * s + 0], x[8 * s + 1]); r.y = pk2(x[8 * s + 2], x[8 * s + 3]);
  r.z = pk2(x[8 * s + 4], x[8 * s + 5]); r.w = pk2(x[8 * s + 6], x[8 * s + 7]);
  return __builtin_bit_cast(bf16x8, r);
}
DI int row_cond(int row) { return row < LAT0 ? 2 : ((row - LAT0) >> 14); }
DI f32x16 zero16() { f32x16 z; for (int i = 0; i < 16; ++i) z[i] = 0.f; return z; }

__shared__ int g_wtab[64];
DI int hw_wave_slot() { return (int)((unsigned)__builtin_amdgcn_s_getreg((5 << 11) | 4) & 63u); }
DI int opaque_tid() {
  const int w = __builtin_amdgcn_readfirstlane(g_wtab[hw_wave_slot()]);
  int t = w * 64 + (int)__builtin_amdgcn_mbcnt_hi(~0u, __builtin_amdgcn_mbcnt_lo(~0u, 0u));
  asm volatile("" : "+v"(t));
  return t;
}
constexpr int SMEM_BYTES = 77824;

template <class RowFn>
DI void convert_weight(u16* dst, int nrows, int K, RowFn rowfn, char* smem, int& job_base, int njobs_total) {
  float* tile = (float*)smem;
  const int ktiles = K / 64, rtiles = nrows / 64, ntile = ktiles * rtiles;
  const int tid = opaque_tid();
  int first = blockIdx.x - (job_base % gridDim.x);
  if (first < 0) first += gridDim.x;
  for (int t = first; t < ntile; t += gridDim.x) {
    const int rt = t / ktiles, kt = t % ktiles;
    const int tx = tid & 63, ty = tid >> 6;
    int ld = 0;
    const float* src = rowfn(rt * 64 + tx, ld);
#pragma unroll 4
    for (int i = 0; i < 16; ++i) {
      const int k = ty + 4 * i;
      tile[k * 65 + tx] = src ? src[(size_t)(kt * 64 + k) * ld] : 0.f;
    }
    __syncthreads();
    const int r = tid >> 2, kq = (tid & 3) * 16;
    u32 w[8];
#pragma unroll
    for (int i = 0; i < 8; ++i) w[i] = pk2(tile[(kq + 2 * i) * 65 + r], tile[(kq + 2 * i + 1) * 65 + r]);
    uint4* d = reinterpret_cast<uint4*>(dst + (size_t)(rt * 64 + r) * K + kt * 64 + kq);
    d[0] = make_uint4(w[0], w[1], w[2], w[3]);
    d[1] = make_uint4(w[4], w[5], w[6], w[7]);
    __syncthreads();
  }
  job_base += ntile;
}

DI void phase_convert(const Params& p, char* smem) {
  int jb = 0;
  u16* ws16 = (u16*)p.ws;
  {
    const float* w = p.in[I_EWIN];
    convert_weight((u16*)(p.ws + WS_WT0IN), 3712, 1024, [=](int n, int& ld) { ld = 3600; return n < 3600 ? w + n : (const float*)nullptr; }, smem, jb, 0);
  }
  {
    const float* w = p.in[I_EWOUT];
    convert_weight((u16*)(p.ws + WS_WT0OUT), 1024, 1024, [=](int n, int& ld) { ld = 1024; return w + n; }, smem, jb, 0);
  }
  auto gu_row = [](const float* w, int n, int& ld) {
    ld = 2 * FFH;
    const int j = n >> 7, wq = n & 127, wn = wq >> 6, sub = (wq & 63) >> 5, c = wq & 31;
    const int hid = 64 * j + 32 * wn + c;
    return w + (sub ? FFH + hid : hid);
  };
  {
    const float* w = p.in[I_EWGU];
    convert_weight((u16*)(p.ws + WS_WT0GU), 2 * FFH, 1024, [=](int n, int& ld) { return gu_row(w, n, ld); }, smem, jb, 0);
  }
  {
    const float* w = p.in[I_EWDN];
    convert_weight((u16*)(p.ws + WS_WT0DN), 1024, FFH, [=](int n, int& ld) { ld = 1024; return w + n; }, smem, jb, 0);
  }
  {
    const float* w = p.in[I_OWIN];
    convert_weight((u16*)(p.ws + WS_WT1IN), 2048, 1024, [=](int n, int& ld) { ld = 2048; return w + n; }, smem, jb, 0);
  }
  {
    const float* wr = p.in[I_OWR];
    const float* wi = p.in[I_OWI];
    convert_weight((u16*)(p.ws + WS_WT1G), 4096, 128, [=](int n, int& ld) {
      ld = 128;
      const int kb = n >> 9, w512 = n & 511, jt = w512 >> 7, z = jt >> 1, half = jt & 1;
      const int wq = w512 & 127, wn = wq >> 6, sub = (wq & 63) >> 5, c = wq & 31;
      const int dch = half * 64 + wn * 32 + c;
      return (sub ? wi : wr) + (size_t)(z * 8 + kb) * 16384 + dch;
    }, smem, jb, 0);
  }
  {
    const float* w = p.in[I_OWOUT];
    convert_weight((u16*)(p.ws + WS_WT1OUT), 1024, 1024, [=](int n, int& ld) { ld = 1024; return w + n; }, smem, jb, 0);
  }
  {
    const float* w = p.in[I_OWGU];
    convert_weight((u16*)(p.ws + WS_WT1GU), 2 * FFH, 1024, [=](int n, int& ld) { return gu_row(w, n, ld); }, smem, jb, 0);
  }
  {
    const float* w = p.in[I_OWDN];
    convert_weight((u16*)(p.ws + WS_WT1DN), 1024, FFH, [=](int n, int& ld) { ld = 1024; return w + n; }, smem, jb, 0);
  }
  (void)ws16;
}

DI void phase_mod(const Params& p, char* smem) {
  float* sc = (float*)smem;
  float* part = sc + 3 * 1024;
  const int tid = opaque_tid();
  bool loaded = false;
  for (int item = blockIdx.x; item < 192; item += gridDim.x) {
    if (!loaded) {
      for (int i = tid; i < 3072; i += 256) {
        const int cnd = i >> 10, k = i & 1023;
        const float v = cnd < 2 ? p.in[I_C][cnd * 1024 + k] : p.in[I_CCTX][k];
        sc[i] = siluf_(v);
      }
      loaded = true;
      __syncthreads();
    }
    const int l = item / 96, cgp = item % 96;
    const float* W = p.in[l ? I_OADAW : I_EADAW];
    const float* Bv = p.in[l ? I_OADAB : I_EADAB];
    const int col = cgp * 64 + (tid & 63), kq = tid >> 6;
    float a0 = 0.f, a1 = 0.f, a2 = 0.f;
#pragma unroll 8
    for (int k = kq * 256; k < kq * 256 + 256; ++k) {
      const float w = W[(size_t)k * 6144 + col];
      a0 += sc[k] * w; a1 += sc[1024 + k] * w; a2 += sc[2048 + k] * w;
    }
    part[(kq * 3 + 0) * 64 + (tid & 63)] = a0;
    part[(kq * 3 + 1) * 64 + (tid & 63)] = a1;
    part[(kq * 3 + 2) * 64 + (tid & 63)] = a2;
    __syncthreads();
    if (tid < 192) {
      const int cnd = tid >> 6, c = tid & 63;
      float s = Bv[cgp * 64 + c];
      for (int q = 0; q < 4; ++q) s += part[(q * 3 + cnd) * 64 + c];
      ((float*)(p.ws + WS_MOD))[(size_t)(l * 3 + cnd) * 6144 + cgp * 64 + c] = s;
    }
    __syncthreads();
  }
}

DI void phase_modulate(const float* hc, const float* hx, const float* gain, const float* mod, int shift_idx, int row_lo, u16* Aout) {
  const int tid0 = opaque_tid();
  const int lane = tid0 & 63, wid = tid0 >> 6;
  const int nw = gridDim.x * 4;
  for (int rowA = row_lo + blockIdx.x * 4 + wid; rowA < MROWS; rowA += 2 * nw) {
    const int rowB = rowA + nw;
    const bool hasB = rowB < MROWS;
    const int rB = hasB ? rowB : rowA;
    const float* srcA = rowA < LAT0 ? hc + (size_t)rowA * DM : hx + (size_t)(rowA - LAT0) * DM;
    const float* srcB = rB < LAT0 ? hc + (size_t)rB * DM : hx + (size_t)(rB - LAT0) * DM;
    float4 va[4], vb[4];
#pragma unroll
    for (int i = 0; i < 4; ++i) {
      va[i] = *reinterpret_cast<const float4*>(srcA + (i * 64 + lane) * 4);
      vb[i] = *reinterpret_cast<const float4*>(srcB + (i * 64 + lane) * 4);
    }
    float sa = 0.f, sb = 0.f;
#pragma unroll
    for (int i = 0; i < 4; ++i) {
      sa += va[i].x * va[i].x + va[i].y * va[i].y + va[i].z * va[i].z + va[i].w * va[i].w;
      sb += vb[i].x * vb[i].x + vb[i].y * vb[i].y + vb[i].z * vb[i].z + vb[i].w * vb[i].w;
    }
    sa = wave_sum(sa); sb = wave_sum(sb);
    const float ra = rsqrtf(sa * (1.f / 1024.f) + EPSF), rb = rsqrtf(sb * (1.f / 1024.f) + EPSF);
    const float* shA = mod + (size_t)row_cond(rowA) * 6144 + shift_idx * 1024;
    const float* shB = mod + (size_t)row_cond(rB) * 6144 + shift_idx * 1024;
    uint2 oa[4], ob[4];
#pragma unroll
    for (int i = 0; i < 4; ++i) {
      const int c = (i * 64 + lane) * 4;
      const float4 g = *reinterpret_cast<const float4*>(gain + c);
      const float4 s1 = *reinterpret_cast<const float4*>(shA + c), c1 = *reinterpret_cast<const float4*>(shA + 1024 + c);
      const float4 s2 = *reinterpret_cast<const float4*>(shB + c), c2 = *reinterpret_cast<const float4*>(shB + 1024 + c);
      oa[i] = make_uint2(pk2(va[i].x * ra * g.x * (1.f + c1.x) + s1.x, va[i].y * ra * g.y * (1.f + c1.y) + s1.y),
                         pk2(va[i].z * ra * g.z * (1.f + c1.z) + s1.z, va[i].w * ra * g.w * (1.f + c1.w) + s1.w));
      ob[i] = make_uint2(pk2(vb[i].x * rb * g.x * (1.f + c2.x) + s2.x, vb[i].y * rb * g.y * (1.f + c2.y) + s2.y),
                         pk2(vb[i].z * rb * g.z * (1.f + c2.z) + s2.z, vb[i].w * rb * g.w * (1.f + c2.w) + s2.w));
    }
#pragma unroll
    for (int i = 0; i < 4; ++i) {
      const int c = (i * 64 + lane) * 4;
      *reinterpret_cast<uint2*>(Aout + (size_t)rowA * DM + c) = oa[i];
      if (hasB) *reinterpret_cast<uint2*>(Aout + (size_t)rowB * DM + c) = ob[i];
    }
  }
}

constexpr int LDT = 72;
template <class Epi>
DI void gemm_phase(const u16* __restrict__ A, int lda, const u16* __restrict__ Bt, int ldb, int K, int mt_lo, int mtiles, int ntiles,
                   int nt_per_group, char* smem, Epi epi) {
  u16* sA = (u16*)smem;
  u16* sB = sA + 2 * 128 * LDT;
  const int tid = opaque_tid(), lane = tid & 63, wid = __builtin_amdgcn_readfirstlane(tid >> 6), wm = wid >> 1, wn = wid & 1;
  const int lr = lane & 31, lh = lane >> 5;
  const int ldrow = tid >> 3, ldc = (tid & 7) * 8;
  const int nk = K / 64;
  const int total = mtiles * ntiles;
  const int per_xcd = (total + 7) >> 3;
  const int xcd = blockIdx.x & 7, qx = blockIdx.x >> 3, nq = gridDim.x >> 3;
  for (int v = qx; v < per_xcd; v += nq) {
    const int u = xcd * per_xcd + v;
    if (u >= total) break;
    const int gsz_full = 8 * ntiles;
    const int g = u / gsz_full, r = u - g * gsz_full;
    const int gm = min(8, mtiles - g * 8);
    const int mt = mt_lo + g * 8 + r % gm, nt = r / gm;
    const unsigned oA = (unsigned)(((mt * 128 + ldrow) * lda + (nt / nt_per_group) * K + ldc) * 2);
    const unsigned oB = (unsigned)(((nt * 128 + ldrow) * ldb + ldc) * 2);
    const char* Ab = (const char*)A;
    const char* Bb = (const char*)Bt;
    f32x16 acc[2][2];
    acc[0][0] = zero16(); acc[0][1] = zero16(); acc[1][0] = zero16(); acc[1][1] = zero16();
    uint4 xa0, xa1, xa2, xa3, xb0, xb1, xb2, xb3, ya0, ya1, ya2, ya3, yb0, yb1, yb2, yb3;
#define G_LOADX(KT) do { const unsigned ka_ = oA + (unsigned)(KT) * 128u, kb_ = oB + (unsigned)(KT) * 128u; \
      xa0 = *reinterpret_cast<const uint4*>(Ab + (ka_ + 0u * (unsigned)lda * 2u)); \
      xa1 = *reinterpret_cast<const uint4*>(Ab + (ka_ + 32u * (unsigned)lda * 2u)); \
      xa2 = *reinterpret_cast<const uint4*>(Ab + (ka_ + 64u * (unsigned)lda * 2u)); \
      xa3 = *reinterpret_cast<const uint4*>(Ab + (ka_ + 96u * (unsigned)lda * 2u)); \
      xb0 = *reinterpret_cast<const uint4*>(Bb + (kb_ + 0u * (unsigned)ldb * 2u)); \
      xb1 = *reinterpret_cast<const uint4*>(Bb + (kb_ + 32u * (unsigned)ldb * 2u)); \
      xb2 = *reinterpret_cast<const uint4*>(Bb + (kb_ + 64u * (unsigned)ldb * 2u)); \
      xb3 = *reinterpret_cast<const uint4*>(Bb + (kb_ + 96u * (unsigned)ldb * 2u)); } while (0)
#define G_LOADY(KT) do { const unsigned ka_ = oA + (unsigned)(KT) * 128u, kb_ = oB + (unsigned)(KT) * 128u; \
      ya0 = *reinterpret_cast<const uint4*>(Ab + (ka_ + 0u * (unsigned)lda * 2u)); \
      ya1 = *reinterpret_cast<const uint4*>(Ab + (ka_ + 32u * (unsigned)lda * 2u)); \
      ya2 = *reinterpret_cast<const uint4*>(Ab + (ka_ + 64u * (unsigned)lda * 2u)); \
      ya3 = *reinterpret_cast<const uint4*>(Ab + (ka_ + 96u * (unsigned)lda * 2u)); \
      yb0 = *reinterpret_cast<const uint4*>(Bb + (kb_ + 0u * (unsigned)ldb * 2u)); \
      yb1 = *reinterpret_cast<const uint4*>(Bb + (kb_ + 32u * (unsigned)ldb * 2u)); \
      yb2 = *reinterpret_cast<const uint4*>(Bb + (kb_ + 64u * (unsigned)ldb * 2u)); \
      yb3 = *reinterpret_cast<const uint4*>(Bb + (kb_ + 96u * (unsigned)ldb * 2u)); } while (0)
#define G_STOREX(BUF) do { u16* wa_ = sA + (BUF) * 128 * LDT + ldrow * LDT + ldc; u16* wb_ = sB + (BUF) * 128 * LDT + ldrow * LDT + ldc; \
      *reinterpret_cast<uint4*>(wa_) = xa0; *reinterpret_cast<uint4*>(wa_ + 32 * LDT) = xa1; \
      *reinterpret_cast<uint4*>(wa_ + 64 * LDT) = xa2; *reinterpret_cast<uint4*>(wa_ + 96 * LDT) = xa3; \
      *reinterpret_cast<uint4*>(wb_) = xb0; *reinterpret_cast<uint4*>(wb_ + 32 * LDT) = xb1; \
      *reinterpret_cast<uint4*>(wb_ + 64 * LDT) = xb2; *reinterpret_cast<uint4*>(wb_ + 96 * LDT) = xb3; } while (0)
#define G_STOREY(BUF) do { u16* wa_ = sA + (BUF) * 128 * LDT + ldrow * LDT + ldc; u16* wb_ = sB + (BUF) * 128 * LDT + ldrow * LDT + ldc; \
      *reinterpret_cast<uint4*>(wa_) = ya0; *reinterpret_cast<uint4*>(wa_ + 32 * LDT) = ya1; \
      *reinterpret_cast<uint4*>(wa_ + 64 * LDT) = ya2; *reinterpret_cast<uint4*>(wa_ + 96 * LDT) = ya3; \
      *reinterpret_cast<uint4*>(wb_) = yb0; *reinterpret_cast<uint4*>(wb_ + 32 * LDT) = yb1; \
      *reinterpret_cast<uint4*>(wb_ + 64 * LDT) = yb2; *reinterpret_cast<uint4*>(wb_ + 96 * LDT) = yb3; } while (0)
#define G_COMPUTE(BUF) do { \
      const u16* a_ = sA + (BUF) * 128 * LDT + (wm * 64 + lr) * LDT + lh * 8; \
      const u16* b_ = sB + (BUF) * 128 * LDT + (wn * 64 + lr) * LDT + lh * 8; \
      _Pragma("unroll") for (int ks = 0; ks < 4; ++ks) { \
        const bf16x8 a0 = ld8(a_ + ks * 16), a1 = ld8(a_ + 32 * LDT + ks * 16); \
        const bf16x8 b0 = ld8(b_ + ks * 16), b1 = ld8(b_ + 32 * LDT + ks * 16); \
        acc[0][0] = mfma32(a0, b0, acc[0][0]); acc[0][1] = mfma32(a0, b1, acc[0][1]); \
        acc[1][0] = mfma32(a1, b0, acc[1][0]); acc[1][1] = mfma32(a1, b1, acc[1][1]); } } while (0)
    G_LOADX(0);
    G_STOREX(0);
    G_LOADX(1);
    if (nk > 2) G_LOADY(2);
    __syncthreads();
    for (int kt = 0; kt < nk; kt += 2) {
      G_COMPUTE(0);
      G_STOREX(1);
      if (kt + 3 < nk) G_LOADX(kt + 3);
      __syncthreads();
      G_COMPUTE(1);
      if (kt + 2 < nk) G_STOREY(0);
      if (kt + 4 < nk) G_LOADY(kt + 4);
      __syncthreads();
    }
    { int lr_ = lr, lh_ = lh; asm volatile("" : "+v"(lr_), "+v"(lh_));
      epi(acc, mt * 128 + wm * 64, nt * 128 + wn * 64, nt, wn, lr_, lh_); }
  }
}

struct EpiIn0 {
  u16 *qk, *vraw, *u0g, *z; float* g0;
  template <int MI>
  DI void operator()(f32x16 (&acc)[MI][2], int mb, int nb, int, int, int lr, int lh) const {
#pragma unroll
    for (int ni = 0; ni < 2; ++ni) {
      const int c0 = nb + ni * 32;
      u16* dst; int ld;
      if (c0 < 1024) { dst = qk + c0; ld = 1024; }
      else if (c0 < 1536) { dst = vraw + (c0 - 1024); ld = 512; }
      else if (c0 < 3072) { dst = u0g + (c0 - 1536); ld = 1536; }
      else if (c0 < 3584) { dst = z + (c0 - 3072); ld = 512; }
      else { dst = nullptr; ld = 0; }
#pragma unroll
      for (int mi = 0; mi < MI; ++mi) {
#pragma unroll
        for (int i = 0; i < 16; ++i) {
          const int row = mb + mi * 32 + crow(i, lh);
          if (dst) dst[(size_t)row * ld + lr] = f2bf(acc[mi][ni][i]);
          else if (c0 == 3584 && lr < 16) g0[(size_t)row * 16 + lr] = acc[mi][ni][i];
        }
      }
    }
  }
};
struct EpiResid {
  const float *hc_in, *hx_in; float *hc_out, *hx_out; const float* gate;
  DI void operator()(f32x16 (&acc)[2][2], int mb, int nb, int, int, int lr, int lh) const {
    const bool isc = mb < LAT0;
    if (isc && !hc_out) return;
    const float* in = isc ? hc_in + (size_t)mb * DM : hx_in + (size_t)(mb - LAT0) * DM;
    float* out = isc ? hc_out + (size_t)mb * DM : hx_out + (size_t)(mb - LAT0) * DM;
    const float* gt = gate + (size_t)row_cond(mb) * 6144;
#pragma unroll
    for (int ni = 0; ni < 2; ++ni) {
      const int col = nb + ni * 32 + lr;
      const float g = gt[col];
#pragma unroll
      for (int mi = 0; mi < 2; ++mi) {
#pragma unroll
        for (int i8 = 0; i8 < 16; i8 += 8) {
          float hv[8];
#pragma unroll
          for (int i = 0; i < 8; ++i) hv[i] = in[(size_t)(mi * 32 + crow(i8 + i, lh)) * DM + col];
#pragma unroll
          for (int i = 0; i < 8; ++i) out[(size_t)(mi * 32 + crow(i8 + i, lh)) * DM + col] = hv[i] + g * acc[mi][ni][i8 + i];
        }
      }
    }
  }
};
struct EpiSwiglu {
  u16* act;
  template <int MI>
  DI void operator()(f32x16 (&acc)[MI][2], int mb, int, int nt, int wn, int lr, int lh) const {
    const int hid = nt * 64 + wn * 32 + lr;
#pragma unroll
    for (int mi = 0; mi < MI; ++mi) {
#pragma unroll
      for (int i = 0; i < 16; ++i) {
        const int row = mb + mi * 32 + crow(i, lh);
        const float g = acc[mi][0][i], u = acc[mi][1][i];
        act[(size_t)row * FFH + hid] = f2bf(siluf_fast(g) * u);
      }
      __builtin_amdgcn_sched_barrier(0);
    }
  }
};
struct EpiIn1 {
  u16 *ug, *ur;
  template <int MI>
  DI void operator()(f32x16 (&acc)[MI][2], int mb, int nb, int, int, int lr, int lh) const {
#pragma unroll
    for (int mi = 0; mi < MI; ++mi)
#pragma unroll
      for (int ni = 0; ni < 2; ++ni) {
        const int col = nb + ni * 32 + lr;
#pragma unroll
        for (int i = 0; i < 16; ++i) {
          const int row = mb + mi * 32 + crow(i, lh);
          if (col < 1024) { if (row >= LAT0) ug[(size_t)(row - LAT0) * DM + col] = f2bf(acc[mi][ni][i]); }
          else ur[(size_t)row * DM + col - 1024] = f2bf(acc[mi][ni][i]);
        }
      }
  }
};
struct EpiGates {
  const u16* xc; u16* ab; const float *b_r, *b_i, *lam;
  DI void operator()(f32x16 (&acc)[2][2], int mb, int, int nt, int wn, int lr, int lh) const {
    const int kb = nt >> 2, jt = nt & 3, z = jt >> 1, half = jt & 1;
    const int ch = kb * 128 + half * 64 + wn * 32 + lr;
    const float br = b_r[z * 1024 + ch], bi = b_i[z * 1024 + ch];
    const float sp = softplusf_(-lam[z * 1024 + ch]);
    u16* la = ab + (size_t)z * 2 * MROWS * DM;
    u16* bb = la + (size_t)MROWS * DM;
#pragma unroll
    for (int mi = 0; mi < 2; ++mi) {
      float xv[16];
#pragma unroll
      for (int i = 0; i < 16; ++i) xv[i] = bf2f(xc[(size_t)(mb + mi * 32 + crow(i, lh)) * DM + ch]);
#pragma unroll
      for (int i = 0; i < 16; ++i) {
        const int row = mb + mi * 32 + crow(i, lh);
        const float r = sigmoidf_fast(acc[mi][0][i] + br), ig = sigmoidf_fast(acc[mi][1][i] + bi);
        const float loga = -8.f * r * sp;
        const float a2 = __expf(2.f * loga);
        const float bval = __builtin_amdgcn_sqrtf(fmaxf(1.f - a2, 0.f)) * (ig * xv[i]);
        la[(size_t)row * DM + ch] = f2bf(loga);
        bb[(size_t)row * DM + ch] = f2bf(bval);
      }
      __builtin_amdgcn_sched_barrier(0);
    }
  }
};


constexpr int LD4 = 40;
template <class Epi>
DI void gemm_phase4(const u16* __restrict__ A, int lda, const u16* __restrict__ Bt, int ldb, int K, int mt_lo, int mtiles, int ntiles,
                    char* smem, Epi epi) {
  u16* sA = (u16*)smem;
  u16* sB = sA + 2 * 256 * LD4;
  const int tid = opaque_tid(), lane = tid & 63, wid = __builtin_amdgcn_readfirstlane(tid >> 6), wm = wid >> 1, wn = wid & 1;
  const int lr = lane & 31, lh = lane >> 5;
  const int ldrow = tid >> 2, ldc = (tid & 3) * 8;
  const int nk = K / 32;
  const int total = mtiles * ntiles;
  const int per_xcd = (total + 7) >> 3;
  const int xcd = blockIdx.x & 7, qx = blockIdx.x >> 3, nq = gridDim.x >> 3;
  for (int v = qx; v < per_xcd; v += nq) {
    const int u = xcd * per_xcd + v;
    if (u >= total) break;
    const int gsz_full = 8 * ntiles;
    const int g = u / gsz_full, r = u - g * gsz_full;
    const int gm = min(8, mtiles - g * 8);
    const int mt = mt_lo + g * 8 + r % gm, nt = r / gm;
    const unsigned oA = (unsigned)(((mt * 256 + ldrow) * lda + ldc) * 2);
    const unsigned oB = (unsigned)(((nt * 128 + ldrow) * ldb + ldc) * 2);
    const char* Ab = (const char*)A;
    const char* Bb = (const char*)Bt;
    f32x16 acc[4][2];
#pragma unroll
    for (int mi = 0; mi < 4; ++mi) { acc[mi][0] = zero16(); acc[mi][1] = zero16(); }
    uint4 xa0, xa1, xa2, xa3, xb0, xb1, ya0, ya1, ya2, ya3, yb0, yb1;
#define G4_LOADX(KT) do { const unsigned ka_ = oA + (unsigned)(KT) * 64u, kb_ = oB + (unsigned)(KT) * 64u; \
      xa0 = *reinterpret_cast<const uint4*>(Ab + ka_); xa1 = *reinterpret_cast<const uint4*>(Ab + (ka_ + 64u * (unsigned)lda * 2u)); \
      xa2 = *reinterpret_cast<const uint4*>(Ab + (ka_ + 128u * (unsigned)lda * 2u)); xa3 = *reinterpret_cast<const uint4*>(Ab + (ka_ + 192u * (unsigned)lda * 2u)); \
      xb0 = *reinterpret_cast<const uint4*>(Bb + kb_); xb1 = *reinterpret_cast<const uint4*>(Bb + (kb_ + 64u * (unsigned)ldb * 2u)); } while (0)
#define G4_LOADY(KT) do { const unsigned ka_ = oA + (unsigned)(KT) * 64u, kb_ = oB + (unsigned)(KT) * 64u; \
      ya0 = *reinterpret_cast<const uint4*>(Ab + ka_); ya1 = *reinterpret_cast<const uint4*>(Ab + (ka_ + 64u * (unsigned)lda * 2u)); \
      ya2 = *reinterpret_cast<const uint4*>(Ab + (ka_ + 128u * (unsigned)lda * 2u)); ya3 = *reinterpret_cast<const uint4*>(Ab + (ka_ + 192u * (unsigned)lda * 2u)); \
      yb0 = *reinterpret_cast<const uint4*>(Bb + kb_); yb1 = *reinterpret_cast<const uint4*>(Bb + (kb_ + 64u * (unsigned)ldb * 2u)); } while (0)
#define G4_STOREX(BUF) do { u16* wa_ = sA + (BUF) * 256 * LD4 + ldrow * LD4 + ldc; u16* wb_ = sB + (BUF) * 128 * LD4 + ldrow * LD4 + ldc; \
      *reinterpret_cast<uint4*>(wa_) = xa0; *reinterpret_cast<uint4*>(wa_ + 64 * LD4) = xa1; \
      *reinterpret_cast<uint4*>(wa_ + 128 * LD4) = xa2; *reinterpret_cast<uint4*>(wa_ + 192 * LD4) = xa3; \
      *reinterpret_cast<uint4*>(wb_) = xb0; *reinterpret_cast<uint4*>(wb_ + 64 * LD4) = xb1; } while (0)
#define G4_STOREY(BUF) do { u16* wa_ = sA + (BUF) * 256 * LD4 + ldrow * LD4 + ldc; u16* wb_ = sB + (BUF) * 128 * LD4 + ldrow * LD4 + ldc; \
      *reinterpret_cast<uint4*>(wa_) = ya0; *reinterpret_cast<uint4*>(wa_ + 64 * LD4) = ya1; \
      *reinterpret_cast<uint4*>(wa_ + 128 * LD4) = ya2; *reinterpret_cast<uint4*>(wa_ + 192 * LD4) = ya3; \
      *reinterpret_cast<uint4*>(wb_) = yb0; *reinterpret_cast<uint4*>(wb_ + 64 * LD4) = yb1; } while (0)
#define G4_COMPUTE(BUF) do { \
      const u16* a_ = sA + (BUF) * 256 * LD4 + (wm * 128 + lr) * LD4 + lh * 8; \
      const u16* b_ = sB + (BUF) * 128 * LD4 + (wn * 64 + lr) * LD4 + lh * 8; \
      _Pragma("unroll") for (int ks = 0; ks < 2; ++ks) { \
        const bf16x8 b0 = ld8(b_ + ks * 16), b1 = ld8(b_ + 32 * LD4 + ks * 16); \
        _Pragma("unroll") for (int mi = 0; mi < 4; ++mi) { \
          const bf16x8 a0 = ld8(a_ + mi * 32 * LD4 + ks * 16); \
          acc[mi][0] = mfma32(a0, b0, acc[mi][0]); acc[mi][1] = mfma32(a0, b1, acc[mi][1]); } } } while (0)
    G4_LOADX(0);
    G4_STOREX(0);
    G4_LOADX(1);
    if (nk > 2) G4_LOADY(2);
    __syncthreads();
    for (int kt = 0; kt < nk; kt += 2) {
      G4_COMPUTE(0);
      G4_STOREX(1);
      if (kt + 3 < nk) G4_LOADX(kt + 3);
      __syncthreads();
      G4_COMPUTE(1);
      if (kt + 2 < nk) G4_STOREY(0);
      if (kt + 4 < nk) G4_LOADY(kt + 4);
      __syncthreads();
    }
    { int lr_ = lr, lh_ = lh; asm volatile("" : "+v"(lr_), "+v"(lh_));
      epi.template operator()<4>(acc, mt * 256 + wm * 128, nt * 128 + wn * 64, nt, wn, lr_, lh_); }
  }
}

DI void phase_da_prep(const Params& p, char* smem) {
  u16* qk = (u16*)((char*)p.out + DO_QK);
  const int tid0 = opaque_tid();
  const int lane = tid0 & 63, wid = tid0 >> 6;
  const int nw = gridDim.x * 4;
  const int qq = lane & 3;
  const bool isk = lane >= 32;
  const float* gain = p.in[isk ? I_KN : I_QN] + qq * 16;
  for (int row = blockIdx.x * 4 + wid; row < MROWS; row += nw) {
    uint4* ptr = reinterpret_cast<uint4*>(qk + (size_t)row * 1024 + lane * 16);
    const uint4 v0 = ptr[0], v1 = ptr[1];
    float x[16];
    x[0] = bflo(v0.x); x[1] = bfhi(v0.x); x[2] = bflo(v0.y); x[3] = bfhi(v0.y); x[4] = bflo(v0.z); x[5] = bfhi(v0.z); x[6] = bflo(v0.w); x[7] = bfhi(v0.w);
    x[8] = bflo(v1.x); x[9] = bfhi(v1.x); x[10] = bflo(v1.y); x[11] = bfhi(v1.y); x[12] = bflo(v1.z); x[13] = bfhi(v1.z); x[14] = bflo(v1.w); x[15] = bfhi(v1.w);
    float ss = 0.f;
#pragma unroll
    for (int i = 0; i < 16; ++i) ss += x[i] * x[i];
    ss += __shfl_xor(ss, 1); ss += __shfl_xor(ss, 2);
    const float rinv = rsqrtf(ss * (1.f / 64.f) + EPSF) * (isk ? 1.f : 0.125f * 1.4426950408889634f);
#pragma unroll
    for (int i = 0; i < 16; ++i) x[i] = x[i] * rinv * gain[i];
    if (row >= LAT0) {
      const int t = (row - LAT0) & (SEQ - 1);
      const float pos = (float)((qq >> 1) ? (t & 63) : (t >> 6));
#pragma unroll
      for (int i = 0; i < 16; ++i) {
        const float other = __shfl_xor(x[i], 1);
        const float inv = exp2f(-(float)i * (13.287712379549449f / 16.f));
        const float ang = pos * inv;
        float rev = ang * 0.15915494309189535f;
        rev -= floorf(rev);
        const float sn = __builtin_amdgcn_sinf(rev), cs = __builtin_amdgcn_cosf(rev);
        x[i] = (qq & 1) ? (x[i] * cs + other * sn) : (x[i] * cs - other * sn);
      }
    }
    ptr[0] = make_uint4(pk2(x[0], x[1]), pk2(x[2], x[3]), pk2(x[4], x[5]), pk2(x[6], x[7]));
    ptr[1] = make_uint4(pk2(x[8], x[9]), pk2(x[10], x[11]), pk2(x[12], x[13]), pk2(x[14], x[15]));
  }
  const u16* vraw = (const u16*)(p.ws + WS_VRAW);
  u16* vt = (u16*)((char*)p.out + DO_VT);
  u16* sv = (u16*)smem;
  const int tid = tid0;
  for (int item = blockIdx.x; item < 2 * 4 * NCH; item += gridDim.x) {
    const int t = item % NCH, bh = item / NCH, b = bh >> 2, h = bh & 3;
    const int row0 = t < 4 ? b * CTXL + t * 64 : LAT0 + b * SEQ + (t - 4) * 64;
    {
      const int key = tid >> 2, ec = (tid & 3) * 32;
      const uint4* s = reinterpret_cast<const uint4*>(vraw + (size_t)(row0 + key) * 512 + h * 128 + ec);
#pragma unroll
      for (int i = 0; i < 4; ++i) {
        const uint4 v = s[i];
        u32* d = reinterpret_cast<u32*>(sv + key * 130 + ec + i * 8);
        d[0] = v.x; d[1] = v.y; d[2] = v.z; d[3] = v.w;
      }
    }
    __syncthreads();
    {
      const int e = tid >> 1, half = tid & 1;
      u32 w[16];
#pragma unroll
      for (int i = 0; i < 16; ++i) {
        const int p0 = half * 32 + 2 * i, p1 = p0 + 1;
        const int k0 = (p0 & ~12) | ((p0 & 4) << 1) | ((p0 & 8) >> 1);
        const int k1 = (p1 & ~12) | ((p1 & 4) << 1) | ((p1 & 8) >> 1);
        w[i] = (u32)sv[k0 * 130 + e] | ((u32)sv[k1 * 130 + e] << 16);
      }
      uint4* d = reinterpret_cast<uint4*>(vt + ((size_t)(bh * 128 + e)) * SK + t * 64 + half * 32);
      d[0] = make_uint4(w[0], w[1], w[2], w[3]); d[1] = make_uint4(w[4], w[5], w[6], w[7]);
      d[2] = make_uint4(w[8], w[9], w[10], w[11]); d[3] = make_uint4(w[12], w[13], w[14], w[15]);
    }
    __syncthreads();
  }
}

#define LDS_AS __attribute__((address_space(3)))
DI void glds16(const void* g, char* lds_wave_base) {
  __builtin_amdgcn_global_load_lds((const unsigned*)g, (LDS_AS unsigned*)lds_wave_base, 16, 0, 0);
}
#define RAW_BARRIER() do { asm volatile("s_waitcnt lgkmcnt(0)" ::: "memory"); __builtin_amdgcn_s_barrier(); } while (0)
DI void phase_da_attn(const Params& p, char* smem) {
  const u16* qk = (const u16*)((const char*)p.out + DO_QK);
  const u16* vt = (const u16*)((const char*)p.out + DO_VT);
  u16* mix = (u16*)(p.ws + WS_MIX);
  char* sK = smem;
  char* sV = smem + 32768;
  float* ex = (float*)smem;
  const int tid = opaque_tid(), lane = tid & 63, wid = __builtin_amdgcn_readfirstlane(tid >> 6), lr = lane & 31, lh = lane >> 5;
  const int qg = wid >> 1, mp = wid & 1;
  float lam;
  {
    const float a = p.in[I_LQ1][lane] * p.in[I_LK1][lane], b2 = p.in[I_LQ2][lane] * p.in[I_LK2][lane];
    lam = __expf(wave_sum(a)) - __expf(wave_sum(b2)) + 0.2f;
  }
  int* cnt = (int*)(p.ws + WS_CNT);
  int* sitem = (int*)(smem + 73728);
  if (tid == 0) { sitem[1] = (int)((unsigned)__builtin_amdgcn_s_getreg((3 << 11) | 20) & 7u); sitem[2] = 0; }
  const int x15 = lr & 15, f3 = (lr >> 2) & 3;
  for (;;) {
    if (tid == 0) {
      int got = -1, tries = sitem[2];
      const int home = sitem[1];
      while (tries < 8) {
        const int it = atomicAdd(&cnt[(home + tries) & 7], 1);
        if (it < 260) { got = ((home + tries) & 7) | (it << 3); break; }
        ++tries;
      }
      sitem[2] = tries;
      *sitem = got;
    }
    __syncthreads();
    const int item = *sitem;
    if (item < 0) break;
    const int bh = item & 7, b = bh >> 2, h = bh & 3, qb = item >> 3;
    const bool isctx = qb >= 256;
    const int qrow0 = isctx ? b * CTXL + (qb - 256) * 64 : LAT0 + b * SEQ + qb * 64;
    const int ntile = isctx ? 8 : 2 * NCH;
    const int myq = qrow0 + qg * 32 + lr;
    bf16x8 qf[4];
#pragma unroll
    for (int ks = 0; ks < 4; ++ks) qf[ks] = ld8(qk + (size_t)myq * 1024 + h * 128 + mp * 64 + ks * 16 + lh * 8);
    f32x16 O[4];
#pragma unroll
    for (int dt = 0; dt < 4; ++dt) O[dt] = zero16();
    float l = 0.f;
    const u16* vsrc0 = vt + (size_t)(bh * 128) * SK;
#define DA_DMA(T) do { const int t_ = (T); const int st_ = t_ & 3; \
      int lq = lane; asm volatile("" : "+v"(lq)); \
      const int krl_ = lq >> 4, kpl_ = lq & 15, vrl_ = lq >> 2, vpl_ = lq & 3; \
      const int krow0 = t_ < 8 ? b * CTXL + t_ * 32 : LAT0 + b * SEQ + (t_ - 8) * 32; \
      const char* kbt = (const char*)(qk + (size_t)krow0 * 1024 + 512 + h * 128); \
      const char* vbt = (const char*)(vsrc0 + t_ * 32); \
      char* kd = sK + st_ * 8192 + wid * 2048; char* vd = sV + st_ * 8192 + wid * 2048; \
      const unsigned kob = (unsigned)((wid * 8 + krl_) * 2048), vob = (unsigned)(((wid * 32 + vrl_) * SK) * 2); \
      glds16(kbt + (kob + (unsigned)(0 * 2048 + ((kpl_ ^ ((wid * 8 + 0 + krl_) & 15)) << 4))), kd); \
      glds16(kbt + (kob + (unsigned)(4 * 2048 + ((kpl_ ^ ((wid * 8 + 4 + krl_) & 15)) << 4))), kd + 1024); \
      glds16(vbt + (vob + (unsigned)(0 * SK * 2 + ((vpl_ ^ (((0 + vrl_) >> 2) & 3)) << 4))), vd); \
      glds16(vbt + (vob + (unsigned)(16 * SK * 2 + ((vpl_ ^ (((16 + vrl_) >> 2) & 3)) << 4))), vd + 1024); } while (0)
    DA_DMA(0); DA_DMA(1); DA_DMA(2);
#pragma unroll 1
    for (int t = 0; t < ntile; ++t) {
      if (t + 2 < ntile) asm volatile("s_waitcnt vmcnt(8)" ::: "memory");
      else if (t + 1 < ntile) asm volatile("s_waitcnt vmcnt(4)" ::: "memory");
      else asm volatile("s_waitcnt vmcnt(0)" ::: "memory");
      RAW_BARRIER();
      if (t + 3 < ntile) DA_DMA(t + 3);
      const int st = t & 3;
      const unsigned kb = (unsigned)(size_t)(LDS_AS char*)(sK + st * 8192 + lr * 256);
      const unsigned vb = (unsigned)(size_t)(LDS_AS char*)(sV + st * 8192 + lr * 64);
      bf16x8 k0, k1, k2, k3, v0, v1, v2, v3, v4, v5, v6, v7;
      asm volatile("ds_read_b128 %0, %4\n\tds_read_b128 %1, %5\n\tds_read_b128 %2, %6\n\tds_read_b128 %3, %7"
                   : "=&v"(k0), "=&v"(k1), "=&v"(k2), "=&v"(k3)
                   : "v"(kb + (((mp * 8 + 0 + lh) ^ x15) << 4)), "v"(kb + (((mp * 8 + 2 + lh) ^ x15) << 4)),
                     "v"(kb + (((mp * 8 + 4 + lh) ^ x15) << 4)), "v"(kb + (((mp * 8 + 6 + lh) ^ x15) << 4)) : "memory");
      const unsigned va = vb + (((0 + lh) ^ f3) << 4), vc = vb + (((2 + lh) ^ f3) << 4);
      asm volatile("ds_read_b128 %0, %8\n\tds_read_b128 %1, %9\n\tds_read_b128 %2, %8 offset:2048\n\tds_read_b128 %3, %9 offset:2048\n\t"
                   "ds_read_b128 %4, %8 offset:4096\n\tds_read_b128 %5, %9 offset:4096\n\tds_read_b128 %6, %8 offset:6144\n\tds_read_b128 %7, %9 offset:6144"
                   : "=&v"(v0), "=&v"(v1), "=&v"(v2), "=&v"(v3), "=&v"(v4), "=&v"(v5), "=&v"(v6), "=&v"(v7)
                   : "v"(va), "v"(vc) : "memory");
      asm volatile("s_waitcnt lgkmcnt(8)" : "+v"(k0), "+v"(k1), "+v"(k2), "+v"(k3) :: "memory");
      f32x16 s = zero16();
      s = mfma32(k0, qf[0], s); s = mfma32(k1, qf[1], s); s = mfma32(k2, qf[2], s); s = mfma32(k3, qf[3], s);
      float rs = 0.f;
#pragma unroll
      for (int i = 0; i < 16; ++i) { s[i] = __builtin_amdgcn_exp2f(s[i]); rs += s[i]; }
      l += rs;
      const bf16x8 pb0 = pack_step(s, 0), pb1 = pack_step(s, 1);
      asm volatile("s_waitcnt lgkmcnt(0)" : "+v"(v0), "+v"(v1), "+v"(v2), "+v"(v3), "+v"(v4), "+v"(v5), "+v"(v6), "+v"(v7) :: "memory");
      O[0] = mfma32(v0, pb0, O[0]); O[1] = mfma32(v2, pb0, O[1]); O[2] = mfma32(v4, pb0, O[2]); O[3] = mfma32(v6, pb0, O[3]);
      O[0] = mfma32(v1, pb1, O[0]); O[1] = mfma32(v3, pb1, O[1]); O[2] = mfma32(v5, pb1, O[2]); O[3] = mfma32(v7, pb1, O[3]);
    }
    __syncthreads();
    l += __shfl_xor(l, 32);
    if (mp == 1) {
      const float sc = lam / l;
#pragma unroll
      for (int dt = 0; dt < 4; ++dt)
#pragma unroll
        for (int i = 0; i < 16; ++i) ex[((qg * 4 + dt) * 16 + i) * 64 + lane] = O[dt][i] * sc;
    }
    __syncthreads();
    if (mp == 0) {
      const float i0 = 1.f / l;
      float ss = 0.f;
#pragma unroll
      for (int dt = 0; dt < 4; ++dt)
#pragma unroll
        for (int i = 0; i < 16; ++i) {
          const float v = O[dt][i] * i0 - ex[((qg * 4 + dt) * 16 + i) * 64 + lane];
          O[dt][i] = v; ss += v * v;
        }
      ss += __shfl_xor(ss, 32);
      const float rinv = rsqrtf(ss * (1.f / 128.f) + EPSF) * 0.8f;
      const float* sn = p.in[I_SUBN];
#pragma unroll
      for (int dt = 0; dt < 4; ++dt)
#pragma unroll
        for (int g = 0; g < 4; ++g) {
          const int dv = dt * 32 + 8 * g + 4 * lh;
          const float4 gn = *reinterpret_cast<const float4*>(sn + dv);
          const u32 w0 = pk2(O[dt][4 * g] * rinv * gn.x, O[dt][4 * g + 1] * rinv * gn.y);
          const u32 w1 = pk2(O[dt][4 * g + 2] * rinv * gn.z, O[dt][4 * g + 3] * rinv * gn.w);
          *reinterpret_cast<uint2*>(mix + (size_t)myq * 1024 + h * 128 + dv) = make_uint2(w0, w1);
        }
    }
    __syncthreads();
  }
}

template <int DIR>
DI void gdn_solve(float (&X)[64], int c, const float* sAm, const float* gc, const float* bt, const u16* skn, const u16* svv) {
  if (c < 128) {
#pragma unroll
    for (int i = 0; i < 64; ++i) {
      const int tok = DIR ? 63 - i : i;
      X[i] = bt[i] * bf2f(svv[tok * 128 + c]);
    }
  } else {
#pragma unroll
    for (int i = 0; i < 64; ++i) {
      const int tok = DIR ? 63 - i : i;
      X[i] = bt[i] * __expf(gc[i]) * bf2f(skn[tok * 136 + c - 128]);
    }
  }
  __builtin_amdgcn_sched_barrier(0);
#pragma unroll
  for (int i = 1; i < 64; ++i) {
    float acc = X[i];
    const float4* arow = reinterpret_cast<const float4*>(sAm + i * 64);
#pragma unroll
    for (int j4 = 0; j4 < (i + 3) / 4; ++j4) {
      const float4 a4 = arow[j4];
      if (4 * j4 + 0 < i) acc = __builtin_fmaf(-a4.x, X[4 * j4 + 0], acc);
      if (4 * j4 + 1 < i) acc = __builtin_fmaf(-a4.y, X[4 * j4 + 1], acc);
      if (4 * j4 + 2 < i) acc = __builtin_fmaf(-a4.z, X[4 * j4 + 2], acc);
      if (4 * j4 + 3 < i) acc = __builtin_fmaf(-a4.w, X[4 * j4 + 3], acc);
    }
    X[i] = acc;
    __builtin_amdgcn_sched_barrier(0);
  }
}

constexpr int QS = 136;
DI void phase_gdn_prep(const Params& p, char* smem) {
  u16* sq = (u16*)smem;
  u16* skn = sq + 64 * QS;
  float* sAm = (float*)(skn + 64 * QS);
  u16* sat = (u16*)(sAm + 64 * 64);
  float* sgc = (float*)(sat + 64 * 72);
  float* sbt = sgc + 128;
  u16* svv = (u16*)(sbt + 128);
  const u16* u0g = (const u16*)(p.ws + WS_U0G);
  const float* g0 = (const float*)(p.ws + WS_G0);
  const float* cw = p.in[I_GCONV];
  for (int item = blockIdx.x; item < 2 * NCH * 4; item += gridDim.x) {
    int tid = opaque_tid();
    const int lane = tid & 63, wid = __builtin_amdgcn_readfirstlane(tid >> 6), lr = lane & 31, lh = lane >> 5;
    const int h = item & 3, n = (item >> 2) % NCH, b = item / (4 * NCH);
    const int row0 = n < 4 ? b * CTXL + n * 64 : LAT0 + b * SEQ + (n - 4) * 64;
    const int t0 = n < 4 ? n * 64 : (n - 4) * 64;
    const int slen = n < 4 ? CTXL : SEQ;
    {
      int t1 = tid; asm volatile("" : "+v"(t1));
      const int cgp = t1 & 15, rg = t1 >> 4;
#pragma unroll
      for (int qk_ = 0; qk_ < 3; ++qk_) {
        const int chb = qk_ * 512 + h * 128 + cgp * 8;
        float wv[4][8];
#pragma unroll
        for (int j = 0; j < 4; ++j)
#pragma unroll
          for (int e = 0; e < 8; ++e) wv[j][e] = cw[j * 1536 + chb + e];
        float xin[7][8];
#pragma unroll
        for (int r = 0; r < 7; ++r) {
          const int tt = rg * 4 + r - 2;
          const int pos = t0 + tt;
          if (pos >= 0 && pos < slen) {
            const uint4 v = *reinterpret_cast<const uint4*>(u0g + (size_t)(row0 + tt) * 1536 + chb);
            xin[r][0] = bflo(v.x); xin[r][1] = bfhi(v.x); xin[r][2] = bflo(v.y); xin[r][3] = bfhi(v.y);
            xin[r][4] = bflo(v.z); xin[r][5] = bfhi(v.z); xin[r][6] = bflo(v.w); xin[r][7] = bfhi(v.w);
          } else {
#pragma unroll
            for (int e = 0; e < 8; ++e) xin[r][e] = 0.f;
          }
        }
#pragma unroll
        for (int r = 0; r < 4; ++r) {
          float y[8]; float ss = 0.f;
#pragma unroll
          for (int e = 0; e < 8; ++e) {
            float a = 0.f;
#pragma unroll
            for (int j = 0; j < 4; ++j) a += wv[j][e] * xin[r + j][e];
            y[e] = siluf_fast(a); ss += y[e] * y[e];
          }
          ss += __shfl_xor(ss, 1); ss += __shfl_xor(ss, 2); ss += __shfl_xor(ss, 4); ss += __shfl_xor(ss, 8);
          const float rinv = qk_ == 2 ? 1.f : rsqrtf(ss + EPSF);
          u16* d = qk_ == 2 ? svv + (rg * 4 + r) * 128 + cgp * 8 : (qk_ ? skn : sq) + (rg * 4 + r) * QS + cgp * 8;
          *reinterpret_cast<uint4*>(d) = make_uint4(pk2(y[0] * rinv, y[1] * rinv), pk2(y[2] * rinv, y[3] * rinv),
                                                    pk2(y[4] * rinv, y[5] * rinv), pk2(y[6] * rinv, y[7] * rinv));
        }
      }
    }
    if (wid < 2) {
      const int d = wid, tok = d ? 63 - lane : lane;
      const float* gr = g0 + (size_t)(row0 + tok) * 16;
      const float beta = sigmoidf_(gr[d * 4 + h]);
      const float g = -__expf(p.in[I_ALOG][d * 4 + h]) * softplusf_(gr[8 + d * 4 + h] + p.in[I_DTB][d * 4 + h]);
      float cs = g;
#pragma unroll
      for (int o = 1; o < 64; o <<= 1) { const float v = __shfl_up(cs, o); if (lane >= o) cs += v; }
      sgc[d * 64 + lane] = cs; sbt[d * 64 + lane] = beta;
    }
    __syncthreads();
    for (int d = 0; d < 2; ++d) {
      char* fr = p.ws + WS_FRAGS + (size_t)(((b * 2 + d) * 4 + h) * NCH + n) * FRAG_ITEM;
      const float* gc = sgc + d * 64;
      const float* bt = sbt + d * 64;
      {
        int lr_ = lr; asm volatile("" : "+v"(lr_));
        const int ti = wid >> 1, tj = wid & 1;
        const int ri = d ? 63 - (ti * 32 + lr_) : ti * 32 + lr_;
        const int rj = d ? 63 - (tj * 32 + lr_) : tj * 32 + lr_;
        f32x16 kk = zero16(), qkk = zero16();
#pragma unroll
        for (int ks = 0; ks < 8; ++ks) {
          const bf16x8 bk = ld8(skn + rj * QS + ks * 16 + lh * 8);
          kk = mfma32(ld8(skn + ri * QS + ks * 16 + lh * 8), bk, kk);
          qkk = mfma32(ld8(sq + ri * QS + ks * 16 + lh * 8), bk, qkk);
        }
        const int j = tj * 32 + lr_;
        const float gcj = gc[j];
#pragma unroll
        for (int r = 0; r < 16; ++r) {
          const int i = ti * 32 + crow(r, lh);
          const float dec = __expf(fminf(gc[i] - gcj, 0.f));
          sAm[i * 64 + j] = (i > j) ? bt[i] * kk[r] * dec : 0.f;
          sat[i * 72 + j] = f2bf((i >= j) ? qkk[r] * dec * 0.08838834764831845f : 0.f);
        }
      }
      __syncthreads();
      float X[64];
      if (d == 0) gdn_solve<0>(X, tid, sAm, gc, bt, skn, svv);
      else gdn_solve<1>(X, tid, sAm, gc, bt, skn, svv);
      __syncthreads();
      u16* sW = (u16*)sAm;
      if (tid >= 128) {
#pragma unroll
        for (int i = 0; i < 64; ++i) sW[i * 128 + tid - 128] = f2bf(-X[i]);
      } else {
        int tu = tid; asm volatile("" : "+v"(tu));
        const int sl = tu >> 5, n_ = tu & 31;
        u16* ud = (u16*)(fr + FR_U);
#pragma unroll
        for (int mt = 0; mt < 2; ++mt)
#pragma unroll
          for (int hh = 0; hh < 2; ++hh) {
            u32 w[8];
#pragma unroll
            for (int r2 = 0; r2 < 8; ++r2) w[r2] = pk2(X[mt * 32 + crow(2 * r2, hh)], X[mt * 32 + crow(2 * r2 + 1, hh)]);
            uint4* dd = reinterpret_cast<uint4*>(ud + ((size_t)((sl * 2 + mt) * 64 + hh * 32 + n_)) * 16);
            dd[0] = make_uint4(w[0], w[1], w[2], w[3]); dd[1] = make_uint4(w[4], w[5], w[6], w[7]);
          }
      }
      __syncthreads();
      int tq = tid; asm volatile("" : "+v"(tq));
      const float glast = gc[63];
      if (tid == 0) ((float*)(p.ws + WS_GL))[((b * 2 + d) * 4 + h) * NCH + n] = __expf(glast);
#pragma unroll 1
      for (int idx = tq; idx < 16 * 64; idx += 256) {
        const int L = idx & 63, f = idx >> 6, mt = f >> 3, ks = f & 7, m = L & 31, hh = L >> 5;
        const int i = mt * 32 + m, tok = d ? 63 - i : i;
        const int dk0 = 32 * (ks >> 1) + 16 * (ks & 1) + 4 * hh;
        const uint2 wa = *reinterpret_cast<const uint2*>(sW + i * 128 + dk0);
        const uint2 wb = *reinterpret_cast<const uint2*>(sW + i * 128 + dk0 + 8);
        reinterpret_cast<uint4*>(fr + FR_W)[idx] = make_uint4(wa.x, wa.y, wb.x, wb.y);
        const float sc = __expf(gc[i]) * 0.08838834764831845f;
        const uint2 qa = *reinterpret_cast<const uint2*>(sq + tok * QS + dk0);
        const uint2 qb = *reinterpret_cast<const uint2*>(sq + tok * QS + dk0 + 8);
        reinterpret_cast<uint4*>(fr + FR_Q)[idx] = make_uint4(pk2(bflo(qa.x) * sc, bfhi(qa.x) * sc), pk2(bflo(qa.y) * sc, bfhi(qa.y) * sc),
                                                             pk2(bflo(qb.x) * sc, bfhi(qb.x) * sc), pk2(bflo(qb.y) * sc, bfhi(qb.y) * sc));
      }
#pragma unroll 1
      for (int idx = tq; idx < 16 * 64; idx += 256) {
        const int L = idx & 63, f = idx >> 6, kt = f >> 2, ks = f & 3, m = L & 31, hh = L >> 5;
        float v[8];
#pragma unroll
        for (int j = 0; j < 8; ++j) {
          const int i = 32 * (ks >> 1) + krow(ks & 1, hh, j), tok = d ? 63 - i : i;
          v[j] = bf2f(skn[tok * QS + kt * 32 + m]) * __expf(glast - gc[i]);
        }
        reinterpret_cast<uint4*>(fr + FR_KT)[idx] = make_uint4(pk2(v[0], v[1]), pk2(v[2], v[3]), pk2(v[4], v[5]), pk2(v[6], v[7]));
      }
#pragma unroll 1
      for (int idx = tq; idx < 8 * 64; idx += 256) {
        const int L = idx & 63, f = idx >> 6, it = f >> 2, ks = f & 3, m = L & 31, hh = L >> 5;
        const int j0 = 32 * (ks >> 1) + 16 * (ks & 1) + 4 * hh;
        const uint2 a = *reinterpret_cast<const uint2*>(sat + (it * 32 + m) * 72 + j0);
        const uint2 bq = *reinterpret_cast<const uint2*>(sat + (it * 32 + m) * 72 + j0 + 8);
        reinterpret_cast<uint4*>(fr + FR_AT)[idx] = make_uint4(a.x, a.y, bq.x, bq.y);
      }
      __syncthreads();
    }
  }
}

DI void gdn_scan_chain(const Params& p, char* smem, int chain) {
  const int tid = opaque_tid(), lane = tid & 63, sl = __builtin_amdgcn_readfirstlane(tid >> 6);
  const int d = (chain >> 2) & 1;
  const float* GL = (const float*)(p.ws + WS_GL) + chain * NCH;
  uint4* sfr = reinterpret_cast<uint4*>(smem);
  f32x16 S[4];
#pragma unroll
  for (int kt = 0; kt < 4; ++kt) S[kt] = zero16();
  uint4 pf0, pf1, pf2, pf3, pf4, pf5, pf6, pf7, pf8, pf9, pf10, pf11, pf12, pf13;
  {
    const int n0 = d ? 3 : 0;
    const char* fr = p.ws + WS_FRAGS + (size_t)(chain * NCH + n0) * FRAG_ITEM;
    const uint4* g = reinterpret_cast<const uint4*>(fr) + tid;
    pf0 = g[0 * 256]; pf1 = g[1 * 256]; pf2 = g[2 * 256]; pf3 = g[3 * 256]; pf4 = g[4 * 256]; pf5 = g[5 * 256]; pf6 = g[6 * 256]; pf7 = g[7 * 256]; pf8 = g[8 * 256]; pf9 = g[9 * 256]; pf10 = g[10 * 256]; pf11 = g[11 * 256]; pf12 = g[12 * 256]; pf13 = g[13 * 256];
  }
  for (int step = 0; step < NCH; ++step) {
    const int n = d ? (step < 4 ? 3 - step : 263 - step) : step;
    char* frc = p.ws + WS_FRAGS + (size_t)(chain * NCH + n) * FRAG_ITEM;
    __syncthreads();
    sfr[0 * 256 + tid] = pf0; sfr[1 * 256 + tid] = pf1; sfr[2 * 256 + tid] = pf2; sfr[3 * 256 + tid] = pf3; sfr[4 * 256 + tid] = pf4; sfr[5 * 256 + tid] = pf5; sfr[6 * 256 + tid] = pf6; sfr[7 * 256 + tid] = pf7; sfr[8 * 256 + tid] = pf8; sfr[9 * 256 + tid] = pf9; sfr[10 * 256 + tid] = pf10; sfr[11 * 256 + tid] = pf11; sfr[12 * 256 + tid] = pf12; sfr[13 * 256 + tid] = pf13;
    __syncthreads();
    f32x16 Vn[2], O[2];
    const uint4* fuc = reinterpret_cast<const uint4*>(frc + FR_U) + (size_t)(sl * 128 + lane) * 2;
    const uint4 un0 = fuc[0], un1 = fuc[1], un2 = fuc[128], un3 = fuc[129];
    Vn[0] = zero16(); Vn[1] = zero16();
    O[0] = zero16(); O[1] = zero16();
    {
      const int s1 = step + 1 < NCH ? step + 1 : step;
      const int n1 = d ? (s1 < 4 ? 3 - s1 : 263 - s1) : s1;
      const char* fr = p.ws + WS_FRAGS + (size_t)(chain * NCH + n1) * FRAG_ITEM;
      const uint4* g = reinterpret_cast<const uint4*>(fr) + tid;
      pf0 = g[0 * 256]; pf1 = g[1 * 256]; pf2 = g[2 * 256]; pf3 = g[3 * 256]; pf4 = g[4 * 256]; pf5 = g[5 * 256]; pf6 = g[6 * 256]; pf7 = g[7 * 256]; pf8 = g[8 * 256]; pf9 = g[9 * 256]; pf10 = g[10 * 256]; pf11 = g[11 * 256]; pf12 = g[12 * 256]; pf13 = g[13 * 256];
    }
    const uint4* lw = sfr + lane;
    const uint4* lq = sfr + 1024 + lane;
    const uint4* lk = sfr + 2048 + lane;
    const uint4* la = sfr + 3072 + lane;
#pragma unroll
    for (int ks = 0; ks < 8; ++ks) {
      const bf16x8 sb = pack_step(S[ks >> 1], ks & 1);
#pragma unroll
      for (int mt = 0; mt < 2; ++mt) {
        Vn[mt] = mfma32(__builtin_bit_cast(bf16x8, lw[(mt * 8 + ks) * 64]), sb, Vn[mt]);
        O[mt] = mfma32(__builtin_bit_cast(bf16x8, lq[(mt * 8 + ks) * 64]), sb, O[mt]);
      }
    }
    {
      const uint4 a = un0, b2 = un1;
      Vn[0][0] += bflo(a.x); Vn[0][1] += bfhi(a.x); Vn[0][2] += bflo(a.y); Vn[0][3] += bfhi(a.y);
      Vn[0][4] += bflo(a.z); Vn[0][5] += bfhi(a.z); Vn[0][6] += bflo(a.w); Vn[0][7] += bfhi(a.w);
      Vn[0][8] += bflo(b2.x); Vn[0][9] += bfhi(b2.x); Vn[0][10] += bflo(b2.y); Vn[0][11] += bfhi(b2.y);
      Vn[0][12] += bflo(b2.z); Vn[0][13] += bfhi(b2.z); Vn[0][14] += bflo(b2.w); Vn[0][15] += bfhi(b2.w);
    }
    {
      const uint4 a = un2, b2 = un3;
      Vn[1][0] += bflo(a.x); Vn[1][1] += bfhi(a.x); Vn[1][2] += bflo(a.y); Vn[1][3] += bfhi(a.y);
      Vn[1][4] += bflo(a.z); Vn[1][5] += bfhi(a.z); Vn[1][6] += bflo(a.w); Vn[1][7] += bfhi(a.w);
      Vn[1][8] += bflo(b2.x); Vn[1][9] += bfhi(b2.x); Vn[1][10] += bflo(b2.y); Vn[1][11] += bfhi(b2.y);
      Vn[1][12] += bflo(b2.z); Vn[1][13] += bfhi(b2.z); Vn[1][14] += bflo(b2.w); Vn[1][15] += bfhi(b2.w);
    }
    bf16x8 Vb[2][2];
#pragma unroll
    for (int mt = 0; mt < 2; ++mt) { Vb[mt][0] = pack_step(Vn[mt], 0); Vb[mt][1] = pack_step(Vn[mt], 1); }
#pragma unroll
    for (int it = 0; it < 2; ++it)
#pragma unroll
      for (int ks = 0; ks < 4; ++ks) O[it] = mfma32(__builtin_bit_cast(bf16x8, la[(it * 4 + ks) * 64]), Vb[ks >> 1][ks & 1], O[it]);
    const float gl = GL[n];
#pragma unroll
    for (int kt = 0; kt < 4; ++kt) {
#pragma unroll
      for (int i = 0; i < 16; ++i) S[kt][i] *= gl;
#pragma unroll
      for (int ks = 0; ks < 4; ++ks) S[kt] = mfma32(__builtin_bit_cast(bf16x8, lk[(kt * 4 + ks) * 64]), Vb[ks >> 1][ks & 1], S[kt]);
    }
    uint4* fo = reinterpret_cast<uint4*>(frc + FR_U) + (size_t)(sl * 128 + lane) * 2;
#pragma unroll
    for (int mt = 0; mt < 2; ++mt) {
      fo[mt * 128] = make_uint4(pk2(O[mt][0], O[mt][1]), pk2(O[mt][2], O[mt][3]), pk2(O[mt][4], O[mt][5]), pk2(O[mt][6], O[mt][7]));
      fo[mt * 128 + 1] = make_uint4(pk2(O[mt][8], O[mt][9]), pk2(O[mt][10], O[mt][11]), pk2(O[mt][12], O[mt][13]), pk2(O[mt][14], O[mt][15]));
    }
  }
  __syncthreads();
}

DI void phase_gdn_finish(const Params& p, char* smem) {
  u16* so = (u16*)smem;
  const u16* zb = (const u16*)(p.ws + WS_Z);
  u16* mix = (u16*)(p.ws + WS_MIX);
  const float* on = p.in[I_ONORM];
  const int tid = opaque_tid();
  for (int item = blockIdx.x; item < 2 * NCH * 4; item += gridDim.x) {
    const int h = item & 3, n = (item >> 2) % NCH, b = item / (4 * NCH);
    const int row0 = n < 4 ? b * CTXL + n * 64 : LAT0 + b * SEQ + (n - 4) * 64;
#pragma unroll
    for (int d = 0; d < 2; ++d) {
      const uint4* src = reinterpret_cast<const uint4*>(p.ws + WS_FRAGS + (size_t)(((b * 2 + d) * 4 + h) * NCH + n) * FRAG_ITEM + FR_U);
      uint4* dst = reinterpret_cast<uint4*>(so + d * 8192);
#pragma unroll
      for (int i = 0; i < 4; ++i) dst[tid + 256 * i] = src[tid + 256 * i];
    }
    __syncthreads();
    const int t = tid >> 2, sl = tid & 3;
    float v[32]; float ss = 0.f;
    {
      const int i0 = t, i1 = 63 - t;
      const int mt0 = i0 >> 5, m0 = i0 & 31, hh0 = (m0 >> 2) & 1, rg0 = (m0 & 3) + 4 * (m0 >> 3);
      const int mt1 = i1 >> 5, m1 = i1 & 31, hh1 = (m1 >> 2) & 1, rg1 = (m1 & 3) + 4 * (m1 >> 3);
#pragma unroll
      for (int e = 0; e < 32; ++e) {
        const float a = bf2f(so[((sl * 2 + mt0) * 64 + hh0 * 32 + e) * 16 + rg0]);
        const float c = bf2f(so[8192 + ((sl * 2 + mt1) * 64 + hh1 * 32 + e) * 16 + rg1]);
        v[e] = a + c; ss += v[e] * v[e];
      }
    }
    ss += __shfl_xor(ss, 1); ss += __shfl_xor(ss, 2);
    const float rinv = rsqrtf(ss * (1.f / 128.f) + EPSF);
    const u16* zr = zb + (size_t)(row0 + t) * 512 + h * 128 + sl * 32;
    u16* mr = mix + (size_t)(row0 + t) * 1024 + 512 + h * 128 + sl * 32;
    uint4 zq0 = *reinterpret_cast<const uint4*>(zr), zq1 = *reinterpret_cast<const uint4*>(zr + 8);
    uint4 zq2 = *reinterpret_cast<const uint4*>(zr + 16), zq3 = *reinterpret_cast<const uint4*>(zr + 24);
#pragma unroll
    for (int e8 = 0; e8 < 4; ++e8) {
      const uint4 zz = e8 == 0 ? zq0 : (e8 == 1 ? zq1 : (e8 == 2 ? zq2 : zq3));
      const u32 zw[4] = {zz.x, zz.y, zz.z, zz.w};
      u32 w[4];
#pragma unroll
      for (int q = 0; q < 4; ++q) {
        const int e = e8 * 8 + 2 * q;
        const float o0 = v[e] * rinv * on[sl * 32 + e] * siluf_fast(bflo(zw[q]));
        const float o1 = v[e + 1] * rinv * on[sl * 32 + e + 1] * siluf_fast(bfhi(zw[q]));
        w[q] = pk2(o0, o1);
      }
      *reinterpret_cast<uint4*>(mr + e8 * 8) = make_uint4(w[0], w[1], w[2], w[3]);
    }
    __syncthreads();
  }
}

DI void phase_lru_conv(const Params& p) {
  const u16* ur = (const u16*)(p.ws + WS_UR);
  u16* xc = (u16*)(p.ws + WS_XC);
  const float* cw = p.in[I_OCONVW];
  const float* cb = p.in[I_OCONVB];
  const size_t total = (size_t)MROWS * 128;
  for (size_t idx = (size_t)blockIdx.x * 256 + opaque_tid(); idx < total; idx += (size_t)gridDim.x * 256) {
    const int row = (int)(idx >> 7), c0 = (int)(idx & 127) * 8;
    int pos, slen;
    if (row < LAT0) { pos = row & (CTXL - 1); slen = CTXL; } else { pos = (row - LAT0) & (SEQ - 1); slen = SEQ; }
    float a[8];
#pragma unroll
    for (int e = 0; e < 8; ++e) a[e] = cb[c0 + e];
#pragma unroll
    for (int j = 0; j < 4; ++j) {
      const int pp = pos + j - 2;
      if (pp >= 0 && pp < slen) {
        const uint4 v = *reinterpret_cast<const uint4*>(ur + (size_t)(row + j - 2) * DM + c0);
        const float4 w0 = *reinterpret_cast<const float4*>(cw + j * 1024 + c0);
        const float4 w1 = *reinterpret_cast<const float4*>(cw + j * 1024 + c0 + 4);
        a[0] += w0.x * bflo(v.x); a[1] += w0.y * bfhi(v.x); a[2] += w0.z * bflo(v.y); a[3] += w0.w * bfhi(v.y);
        a[4] += w1.x * bflo(v.z); a[5] += w1.y * bfhi(v.z); a[6] += w1.z * bflo(v.w); a[7] += w1.w * bfhi(v.w);
      }
    }
    *reinterpret_cast<uint4*>(xc + (size_t)row * DM + c0) = make_uint4(pk2(a[0], a[1]), pk2(a[2], a[3]), pk2(a[4], a[5]), pk2(a[6], a[7]));
  }
}

DI int chunk_row0(int b, int n) { return n < 4 ? b * CTXL + n * 64 : LAT0 + b * SEQ + (n - 4) * 64; }
DI void phase_lru_pass1(const Params& p) {
  const u16* ab = (const u16*)(p.ws + WS_AB);
  float* ph = (float*)(p.ws + WS_PH);
  const int total = 2 * 2 * NCH * 512;
  for (int idx = blockIdx.x * 256 + opaque_tid(); idx < total; idx += gridDim.x * 256) {
    const int cp = idx & 511, n = (idx >> 9) % NCH, b = ((idx >> 9) / NCH) & 1, d = (idx >> 9) / (2 * NCH);
    const u16* la = ab + (size_t)d * 2 * MROWS * DM + (size_t)chunk_row0(b, n) * DM + 2 * cp;
    const u16* bb = la + (size_t)MROWS * DM;
    float P0 = 0.f, H0 = 0.f, P1 = 0.f, H1 = 0.f;
#pragma unroll 8
    for (int i = 0; i < 64; ++i) {
      const int t = d ? 63 - i : i;
      const u32 lg = *reinterpret_cast<const u32*>(la + (size_t)t * DM);
      const u32 bv = *reinterpret_cast<const u32*>(bb + (size_t)t * DM);
      const float l0 = bflo(lg), l1 = bfhi(lg);
      H0 = __expf(l0) * H0 + bflo(bv); P0 += l0;
      H1 = __expf(l1) * H1 + bfhi(bv); P1 += l1;
    }
    const size_t o = ((size_t)((d * 2 + b) * NCH + n) * 1024 + 2 * cp) * 2;
    *reinterpret_cast<float4*>(ph + o) = make_float4(P0, H0, P1, H1);
  }
}
DI void phase_lru_pass2(const Params& p) {
  const float2* __restrict__ ph = (const float2*)(p.ws + WS_PH);
  float* __restrict__ cin = (float*)(p.ws + WS_CIN);
  const int total = 2 * 2 * 1024;
  for (int idx = blockIdx.x * 256 + opaque_tid(); idx < total; idx += gridDim.x * 256) {
    const int ch = idx & 1023, b = (idx >> 10) & 1, d = idx >> 11;
    float hcar = 0.f;
    for (int s0 = 0; s0 < NCH; s0 += 20) {
      float2 v[20];
#pragma unroll
      for (int u = 0; u < 20; ++u) {
        const int step = s0 + u;
        const int n = d ? (step < 4 ? 3 - step : 263 - step) : step;
        v[u] = ph[(size_t)((d * 2 + b) * NCH + n) * 1024 + ch];
      }
#pragma unroll
      for (int u = 0; u < 20; ++u) {
        const int step = s0 + u;
        const int n = d ? (step < 4 ? 3 - step : 263 - step) : step;
        cin[(size_t)((d * 2 + b) * NCH + n) * 1024 + ch] = hcar;
        hcar = __expf(v[u].x) * hcar + v[u].y;
      }
    }
  }
}
DI float gelu_tanh(float x) {
  const float u = 0.7978845608028654f * (x + 0.044715f * x * x * x);
  const float t = 1.f - 2.f * __builtin_amdgcn_rcpf(1.f + __expf(2.f * u));
  return 0.5f * x * (1.f + t);
}
DI void phase_lru_pass3(const Params& p) {
  const u16* ab = (const u16*)(p.ws + WS_AB);
  const float* cin = (const float*)(p.ws + WS_CIN);
  u16* ug = (u16*)(p.ws + WS_UG);
  const int total = 2 * 256 * 1024;
  for (int idx = blockIdx.x * 256 + opaque_tid(); idx < total; idx += gridDim.x * 256) {
    const int ch = idx & 1023, nl = (idx >> 10) & 255, b = idx >> 18, n = nl + 4;
    const size_t rowoff = (size_t)chunk_row0(b, n) * DM + ch;
    float hf[64];
    {
      const u16* la = ab + rowoff;
      const u16* bb = la + (size_t)MROWS * DM;
      float hcur = cin[(size_t)((0 * 2 + b) * NCH + n) * 1024 + ch];
#pragma unroll
      for (int i = 0; i < 64; ++i) {
        hcur = __expf(bf2f(la[(size_t)i * DM])) * hcur + bf2f(bb[(size_t)i * DM]);
        hf[i] = hcur;
      }
    }
    {
      const u16* la = ab + (size_t)2 * MROWS * DM + rowoff;
      const u16* bb = la + (size_t)MROWS * DM;
      float hcur = cin[(size_t)((1 * 2 + b) * NCH + n) * 1024 + ch];
#pragma unroll
      for (int i = 63; i >= 0; --i) {
        hcur = __expf(bf2f(la[(size_t)i * DM])) * hcur + bf2f(bb[(size_t)i * DM]);
        hf[i] += hcur;
      }
      u16* y = ug + ((size_t)(b * SEQ + nl * 64)) * DM + ch;
#pragma unroll
      for (int g4 = 0; g4 < 4; ++g4) {
        float yv[16];
#pragma unroll
        for (int i = 0; i < 16; ++i) yv[i] = bf2f(y[(size_t)(g4 * 16 + i) * DM]);
#pragma unroll
        for (int i = 0; i < 16; ++i) y[(size_t)(g4 * 16 + i) * DM] = f2bf(gelu_tanh(yv[i]) * hf[g4 * 16 + i]);
      }
    }
  }
}

#define XB_TMO      128
#define XB_XCNT(j)  (256  + 64 * (j))
#define XB_XSUB(j)  (1280 + 64 * (j))
#define XB_XGEN(j)  (2304 + 64 * (j))
#define XB_TOP      3328
#define XB_TOPGEN   3392
#define XCD_BAR_WORDS 3456
#define XB_SPIN_CAP (1u << 18)
#define LAS __attribute__((address_space(3)))

__device__ __forceinline__ unsigned xb_ld(unsigned* p)              { return __hip_atomic_load(p, __ATOMIC_RELAXED, __HIP_MEMORY_SCOPE_AGENT); }
__device__ __forceinline__ unsigned xb_add(unsigned* p, unsigned v) { return __hip_atomic_fetch_add(p, v, __ATOMIC_RELAXED, __HIP_MEMORY_SCOPE_AGENT); }
__device__ __forceinline__ unsigned xb_xcc_id() { return (unsigned)__builtin_amdgcn_s_getreg((3 << 11) | 20) & 0xFu; }
#define XB_SPIN(cond, bar) do { unsigned _sp = 0; while (cond) { __builtin_amdgcn_s_sleep(1); \
    if ((++_sp & 255u) == 0u) { if (xb_ld(&(bar)[XB_TMO])) break; if (_sp > XB_SPIN_CAP) { atomicAdd(&(bar)[XB_TMO], 1u); break; } } } } while (0)

struct XcdBarrier {
    unsigned* bar; unsigned x;
    volatile LAS unsigned* st;
};

__device__ __forceinline__ XcdBarrier xcd_barrier_post(unsigned* bar, volatile LAS unsigned* st) {
    XcdBarrier b; b.bar = bar; b.x = xb_xcc_id(); b.st = st;
    if (threadIdx.x == 0) (void)xb_add(&bar[XB_XCNT(b.x)], 1u);
    return b;
}
__device__ __forceinline__ void xcd_barrier_complete(unsigned* bar, unsigned x, unsigned& nloc, unsigned& nx) {
    const unsigned G = gridDim.x * gridDim.y * gridDim.z;
    unsigned sum, cnt, mine, sp = 0u;
    for (;;) {
        sum = 0u; cnt = 0u; mine = 0u;
#pragma unroll
        for (unsigned j = 0; j < 16; ++j) { const unsigned c = xb_ld(&bar[XB_XCNT(j)]); sum += c; cnt += (c > 0u) ? 1u : 0u; mine = (j == x) ? c : mine; }
        if (sum == G) break;
        __builtin_amdgcn_s_sleep(1);
        if ((++sp & 255u) == 0u) { if (xb_ld(&bar[XB_TMO])) break; if (sp > XB_SPIN_CAP) { atomicAdd(&bar[XB_TMO], 1u); break; } }
    }
    nloc = mine > 0u ? mine : 1u; nx = cnt > 0u ? cnt : 1u;
}

__device__ __forceinline__ void xcd_barrier(const XcdBarrier& b) {
    asm volatile("s_waitcnt vmcnt(0)" ::: "memory");
    __syncthreads();
    if (opaque_tid() == 0) {
        unsigned* bar = b.bar;
        __builtin_amdgcn_s_waitcnt(0);
        unsigned nloc = b.st[0], nx = b.st[1];
        if (nloc == 0u) { xcd_barrier_complete(bar, b.x, nloc, nx); b.st[0] = nloc; b.st[1] = nx; }
        const unsigned old = xb_add(&bar[XB_XSUB(b.x)], 1u);
        const unsigned gen = old / nloc;
        if (old + 1u == (gen + 1u) * nloc) {
            __builtin_amdgcn_fence(__ATOMIC_RELEASE, "agent");
            asm volatile("s_waitcnt vmcnt(0)" ::: "memory");
            const unsigned og = xb_add(&bar[XB_TOP], 1u);
            const unsigned tg = og / nx;
            if (og + 1u == (tg + 1u) * nx) xb_add(&bar[XB_TOPGEN], 1u);
            else XB_SPIN(xb_ld(&bar[XB_TOPGEN]) == tg, bar);
            __builtin_amdgcn_fence(__ATOMIC_ACQUIRE, "agent");
            xb_add(&bar[XB_XGEN(b.x)], 1u);
            asm volatile("s_waitcnt vmcnt(0)" ::: "memory");
        } else {
            XB_SPIN(xb_ld(&bar[XB_XGEN(b.x)]) == gen, bar);
            __builtin_amdgcn_fence(__ATOMIC_ACQUIRE, "agent");
            asm volatile("s_waitcnt vmcnt(0)" ::: "memory");
        }
    }
    __syncthreads();
}


template <int PH>
DI void run_phase(const Params& p, char* smem) {
  char* ws = p.ws;
  const float* MOD = (const float*)(ws + WS_MOD);
  float* HC = (float*)(ws + WS_HCTX);
  if constexpr (PH == 0) { phase_convert(p, smem); phase_mod(p, smem); }
  else if constexpr (PH == 1) phase_modulate(p.in[I_CTX], p.in[I_X], p.in[I_EN1], MOD, 0, 0, (u16*)(ws + WS_A));
  else if constexpr (PH == 2) {
    EpiIn0 e{(u16*)((char*)p.out + DO_QK), (u16*)(ws + WS_VRAW), (u16*)(ws + WS_U0G), (u16*)(ws + WS_Z), (float*)(ws + WS_G0)};
    gemm_phase4((const u16*)(ws + WS_A), 1024, (const u16*)(ws + WS_WT0IN), 1024, 1024, 0, 130, 29, smem, e);
  }
  else if constexpr (PH == 3) phase_da_prep(p, smem);
  else if constexpr (PH == 4) phase_gdn_prep(p, smem);
  else if constexpr (PH == 5) { }
  else if constexpr (PH == 6) { if (blockIdx.x < 16) gdn_scan_chain(p, smem, blockIdx.x); phase_da_attn(p, smem); }
  else if constexpr (PH == 7) phase_gdn_finish(p, smem);
  else if constexpr (PH == 8) {
    EpiResid e{p.in[I_CTX], p.in[I_X], HC, p.out, MOD + 2 * 1024};
    gemm_phase((const u16*)(ws + WS_MIX), 1024, (const u16*)(ws + WS_WT0OUT), 1024, 1024, 0, 260, 8, 1 << 20, smem, e);
  }
  else if constexpr (PH == 9) phase_modulate(HC, p.out, p.in[I_EN2], MOD, 3, 0, (u16*)(ws + WS_A));
  else if constexpr (PH == 10) {
    EpiSwiglu e{(u16*)(ws + WS_ACT)};
    gemm_phase4((const u16*)(ws + WS_A), 1024, (const u16*)(ws + WS_WT0GU), 1024, 1024, 0, 130, 44, smem, e);
  }
  else if constexpr (PH == 11) {
    EpiResid e{HC, p.out, HC, p.out, MOD + 5 * 1024};
    gemm_phase((const u16*)(ws + WS_ACT), FFH, (const u16*)(ws + WS_WT0DN), FFH, FFH, 0, 260, 8, 1 << 20, smem, e);
  }
  else if constexpr (PH == 12) phase_modulate(HC, p.out, p.in[I_ON1], MOD + 3 * 6144, 0, 0, (u16*)(ws + WS_A));
  else if constexpr (PH == 13) {
    EpiIn1 e{(u16*)(ws + WS_UG), (u16*)(ws + WS_UR)};
    gemm_phase4((const u16*)(ws + WS_A), 1024, (const u16*)(ws + WS_WT1IN), 1024, 1024, 0, 130, 16, smem, e);
  }
  else if constexpr (PH == 14) phase_lru_conv(p);
  else if constexpr (PH == 15) {
    EpiGates e{(const u16*)(ws + WS_XC), (u16*)(ws + WS_AB), p.in[I_OBR], p.in[I_OBI], p.in[I_OLAM]};
    gemm_phase((const u16*)(ws + WS_XC), 1024, (const u16*)(ws + WS_WT1G), 128, 128, 0, 260, 32, 4, smem, e);
  }
  else if constexpr (PH == 16) phase_lru_pass1(p);
  else if constexpr (PH == 17) phase_lru_pass2(p);
  else if constexpr (PH == 18) phase_lru_pass3(p);
  else if constexpr (PH == 19) {
    EpiResid e{nullptr, p.out, nullptr, p.out, MOD + 3 * 6144 + 2 * 1024};
    gemm_phase((const u16*)(ws + WS_UG) - (size_t)LAT0 * DM, 1024, (const u16*)(ws + WS_WT1OUT), 1024, 1024, 4, 256, 8, 1 << 20, smem, e);
  }
  else if constexpr (PH == 20) phase_modulate(HC, p.out, p.in[I_ON2], MOD + 3 * 6144, 3, LAT0, (u16*)(ws + WS_A));
  else if constexpr (PH == 21) {
    EpiSwiglu e{(u16*)(ws + WS_ACT)};
    gemm_phase4((const u16*)(ws + WS_A), 1024, (const u16*)(ws + WS_WT1GU), 1024, 1024, 2, 128, 44, smem, e);
  }
  else if constexpr (PH == 22) {
    EpiResid e{nullptr, p.out, nullptr, p.out, MOD + 3 * 6144 + 5 * 1024};
    gemm_phase((const u16*)(ws + WS_ACT), FFH, (const u16*)(ws + WS_WT1DN), FFH, FFH, 4, 256, 8, 1 << 20, smem, e);
  }
}
constexpr int NPHASE = 23;

#if MULTI_LAUNCH
template <int PH>
__global__ void __launch_bounds__(256, 2) phase_kernel(Params p) {
  __shared__ __attribute__((aligned(16))) char smem[SMEM_BYTES];
  run_phase<PH>(p, smem);
}
template <int PH>
static void launch_all(const Params& p, int grid, hipStream_t stream) {
  if constexpr (PH < NPHASE) {
    hipLaunchKernelGGL(phase_kernel<PH>, dim3(grid), dim3(256), 0, stream, p);
    launch_all<PH + 1>(p, grid, stream);
  }
}
#else
template <int PH>
DI void run_all(const Params& p, char* smem, cg::grid_group& grid, const XcdBarrier& xb) {
  if constexpr (PH < NPHASE) {
    run_phase<PH>(p, smem);
    if constexpr (PH == PROBE_DUP || PH == PROBE_DUP2) { xcd_barrier(xb); run_phase<PH>(p, smem); }
    if constexpr (PH == 0) grid.sync();
    else if constexpr (PH + 1 < NPHASE && PH != 5) xcd_barrier(xb);
    run_all<PH + 1>(p, smem, grid, xb);
  }
}
__global__ void __launch_bounds__(256, 2) mega_kernel(Params p) {
  __shared__ __attribute__((aligned(16))) char smem[SMEM_BYTES];
  __shared__ uint4 xb_words;
  if (threadIdx.x == 0) xb_words = make_uint4(0u, 0u, 0u, 0u);
  if ((threadIdx.x & 63) == 0) g_wtab[hw_wave_slot()] = threadIdx.x >> 6;
  __syncthreads();
  cg::grid_group grid = cg::this_grid();
  XcdBarrier xb = xcd_barrier_post((unsigned*)(p.ws + WS_BAR), (volatile LAS unsigned*)&xb_words);
  for (int i = 0; i < PROBE_SYNCS; ++i) xcd_barrier(xb);
  run_all<0>(p, smem, grid, xb);
}
#endif

extern "C" void kernel_launch(void* const* d_in, const int* in_sizes, int n_in, void* d_out, int out_size, void* d_ws, size_t ws_size,
                              hipStream_t stream) {
  if (n_in != 38 || ws_size < WS_NEED || out_size != 2 * SEQ * DM) {
    fprintf(stderr, "kernel_launch: unexpected shapes (n_in %d, ws %zu, out %d)\n", n_in, ws_size, out_size);
    return;
  }
  Params p{};
  for (int i = 0; i < 38; ++i) p.in[i] = (const float*)d_in[i];
  p.out = (float*)d_out;
  p.ws = (char*)d_ws;
#if MULTI_LAUNCH
  launch_all<0>(p, 512, stream);
#else
  static int grid_blocks = 0;
  if (!grid_blocks) {
    int dev = 0, cus = 0, per_cu = 0;
    hipGetDevice(&dev);
    hipDeviceGetAttribute(&cus, hipDeviceAttributeMultiprocessorCount, dev);
    hipOccupancyMaxActiveBlocksPerMultiprocessor(&per_cu, mega_kernel, 256, 0);
    if (per_cu < 1) per_cu = 1;
    if (per_cu > 2) per_cu = 2;
    grid_blocks = cus * per_cu;
  }
  (void)hipMemsetAsync((char*)d_ws + WS_CNT, 0, 65536 + XCD_BAR_WORDS * 4, stream);
  void* args[] = {&p};
  hipError_t e = hipLaunchCooperativeKernel((void*)mega_kernel, dim3(grid_blocks), dim3(256), args, 0, stream);
  if (e != hipSuccess) fprintf(stderr, "cooperative launch failed: %s (grid %d)\n", hipGetErrorString(e), grid_blocks);
#endif
}
```

```cpp
#include <hip/hip_runtime.h>
#include <hip/hip_cooperative_groups.h>
#include <cstdio>
namespace cg = cooperative_groups;

#ifndef MULTI_LAUNCH
#define MULTI_LAUNCH 0
#endif
#ifndef PROBE_DUP
#define PROBE_DUP -1
#define PROBE_DUP2 -1
#define PROBE_SYNCS 0
#endif

#define DI __device__ __forceinline__
typedef unsigned short u16;
typedef unsigned int u32;
using bf16x8 = __attribute__((ext_vector_type(8))) short;
using f32x16 = __attribute__((ext_vector_type(16))) float;
typedef __bf16 bf2_t __attribute__((ext_vector_type(2)));
typedef float f2_t __attribute__((ext_vector_type(2)));

constexpr int SEQ = 16384, CTXL = 256, DM = 1024, MROWS = 33280, LAT0 = 512;
constexpr int SK = 16640;
constexpr int FFH = 2816;
constexpr int NCH = 260;
constexpr float EPSF = 1e-6f;

constexpr size_t MiB = 1048576;
constexpr size_t WS_WT0IN = 0, WS_WT0OUT = 8 * MiB, WS_WT0GU = 10 * MiB, WS_WT0DN = 21 * MiB;
constexpr size_t WS_WT1IN = 27 * MiB, WS_WT1G = 31 * MiB, WS_WT1OUT = 32 * MiB, WS_WT1GU = 34 * MiB, WS_WT1DN = 45 * MiB;
constexpr size_t WS_MOD = 51 * MiB, WS_G0 = 52 * MiB, WS_HCTX = 55 * MiB, WS_GL = 57 * MiB, WS_PH = 58 * MiB;
constexpr size_t WS_CNT = 67 * MiB;
constexpr size_t WS_BAR = 67 * MiB + 65536;
constexpr size_t WS_BIG = 68 * MiB;
constexpr size_t WS_FRAGS = WS_BIG;
constexpr size_t WS_A = WS_BIG;
constexpr size_t WS_VRAW = WS_BIG + 65 * MiB;
constexpr size_t WS_ACT = WS_BIG + 65 * MiB;
constexpr size_t WS_U0G = 361 * MiB;
constexpr size_t WS_MIX = 361 * MiB;
constexpr size_t WS_Z = 459 * MiB;
constexpr size_t WS_UR = WS_BIG + 65 * MiB;
constexpr size_t WS_AB = WS_BIG;
constexpr size_t WS_XC = 328 * MiB;
constexpr size_t WS_UG = 393 * MiB;
constexpr size_t WS_CIN = 459 * MiB;
constexpr size_t WS_NEED = 512 * MiB;
constexpr size_t FRAG_ITEM = 73728;
constexpr size_t FR_W = 0, FR_Q = 16384, FR_KT = 32768, FR_AT = 49152, FR_U = 57344;
constexpr size_t DO_QK = 0, DO_VT = 65 * MiB;

struct Params {
  const float* in[38];
  float* out;
  char* ws;
};
enum { I_X = 0, I_C, I_CTX, I_CCTX, I_EN1, I_EN2, I_EADAW, I_EADAB, I_EWIN, I_EWOUT, I_QN, I_KN, I_LQ1, I_LK1, I_LQ2, I_LK2,
       I_SUBN, I_GCONV, I_ALOG, I_DTB, I_ONORM, I_EWGU, I_EWDN, I_ON1, I_ON2, I_OADAW, I_OADAB, I_OWIN, I_OCONVW, I_OCONVB,
       I_OWR, I_OBR, I_OWI, I_OBI, I_OLAM, I_OWOUT, I_OWGU, I_OWDN };

DI u32 pk2(float a, float b) { f2_t v = {a, b}; bf2_t r = __builtin_convertvector(v, bf2_t); return __builtin_bit_cast(u32, r); }
DI u16 f2bf(float a) { return (u16)(pk2(a, 0.f) & 0xffffu); }
DI float bf2f(u16 v) { return __uint_as_float(((u32)v) << 16); }
DI float bflo(u32 v) { return __uint_as_float(v << 16); }
DI float bfhi(u32 v) { return __uint_as_float(v & 0xffff0000u); }
DI int crow(int reg, int h) { return (reg & 3) + 8 * (reg >> 2) + 4 * h; }
DI int krow(int s, int h, int j) { return 16 * s + 8 * (j >> 2) + 4 * h + (j & 3); }
DI float sigmoidf_(float x) { return 1.f / (1.f + __expf(-x)); }
DI float siluf_(float x) { return x / (1.f + __expf(-x)); }
DI float siluf_fast(float x) { return x * __builtin_amdgcn_rcpf(1.f + __expf(-x)); }
DI float sigmoidf_fast(float x) { return __builtin_amdgcn_rcpf(1.f + __expf(-x)); }
DI float softplusf_(float x) { return x > 20.f ? x : log1pf(__expf(x)); }
DI float wave_sum(float v) {
#pragma unroll
  for (int o = 32; o >= 1; o >>= 1) v += __shfl_xor(v, o);
  return v;
}
DI f32x16 mfma32(bf16x8 a, bf16x8 b, f32x16 c) { return __builtin_amdgcn_mfma_f32_32x32x16_bf16(a, b, c, 0, 0, 0); }
DI bf16x8 ld8(const u16* p) { return *reinterpret_cast<const bf16x8*>(p); }
DI bf16x8 pack_step(const f32x16& x, int s) {
  uint4 r;
  r.x = pk2(x[8 * s + 0], x[8 * s + 1]); r.y = pk2(x[8 * s + 2], x[8 * s + 3]);
  r.z = pk2(x[8 * s + 4], x[8 * s + 5]); r.w = pk2(x[8 * s + 6], x[8 * s + 7]);
  return __builtin_bit_cast(bf16x8, r);
}
DI int row_cond(int row) { return row < LAT0 ? 2 : ((row - LAT0) >> 14); }
DI f32x16 zero16() { f32x16 z; for (int i = 0; i < 16; ++i) z[i] = 0.f; return z; }

__shared__ int g_wtab[64];
DI int hw_wave_slot() { return (int)((unsigned)__builtin_amdgcn_s_getreg((5 << 11) | 4) & 63u); }
DI int opaque_tid() {
  const int w = __builtin_amdgcn_readfirstlane(g_wtab[hw_wave_slot()]);
  int t = w * 64 + (int)__builtin_amdgcn_mbcnt_hi(~0u, __builtin_amdgcn_mbcnt_lo(~0u, 0u));
  asm volatile("" : "+v"(t));
  return t;
}
constexpr int SMEM_BYTES = 77824;

template <class RowFn>
DI void convert_weight(u16* dst, int nrows, int K, RowFn rowfn, char* smem, int& job_base, int njobs_total) {
  float* tile = (float*)smem;
  const int ktiles = K / 64, rtiles = nrows / 64, ntile = ktiles * rtiles;
  const int tid = opaque_tid();
  int first = blockIdx.x - (job_base % gridDim.x);
  if (first < 0) first += gridDim.x;
  for (int t = first; t < ntile; t += gridDim.x) {
    const int rt = t / ktiles, kt = t % ktiles;
    const int tx = tid & 63, ty = tid >> 6;
    int ld = 0;
    const float* src = rowfn(rt * 64 + tx, ld);
#pragma unroll 4
    for (int i = 0; i < 16; ++i) {
      const int k = ty + 4 * i;
      tile[k * 65 + tx] = src ? src[(size_t)(kt * 64 + k) * ld] : 0.f;
    }
    __syncthreads();
    const int r = tid >> 2, kq = (tid & 3) * 16;
    u32 w[8];
#pragma unroll
    for (int i = 0; i < 8; ++i) w[i] = pk2(tile[(kq + 2 * i) * 65 + r], tile[(kq + 2 * i + 1) * 65 + r]);
    uint4* d = reinterpret_cast<uint4*>(dst + (size_t)(rt * 64 + r) * K + kt * 64 + kq);
    d[0] = make_uint4(w[0], w[1], w[2], w[3]);
    d[1] = make_uint4(w[4], w[5], w[6], w[7]);
    __syncthreads();
  }
  job_base += ntile;
}

DI void phase_convert(const Params& p, char* smem) {
  int jb = 0;
  u16* ws16 = (u16*)p.ws;
  {
    const float* w = p.in[I_EWIN];
    convert_weight((u16*)(p.ws + WS_WT0IN), 3712, 1024, [=](int n, int& ld) { ld = 3600; return n < 3600 ? w + n : (const float*)nullptr; }, smem, jb, 0);
  }
  {
    const float* w = p.in[I_EWOUT];
    convert_weight((u16*)(p.ws + WS_WT0OUT), 1024, 1024, [=](int n, int& ld) { ld = 1024; return w + n; }, smem, jb, 0);
  }
  auto gu_row = [](const float* w, int n, int& ld) {
    ld = 2 * FFH;
    const int j = n >> 7, wq = n & 127, wn = wq >> 6, sub = (wq & 63) >> 5, c = wq & 31;
    const int hid = 64 * j + 32 * wn + c;
    return w + (sub ? FFH + hid : hid);
  };
  {
    const float* w = p.in[I_EWGU];
    convert_weight((u16*)(p.ws + WS_WT0GU), 2 * FFH, 1024, [=](int n, int& ld) { return gu_row(w, n, ld); }, smem, jb, 0);
  }
  {
    const float* w = p.in[I_EWDN];
    convert_weight((u16*)(p.ws + WS_WT0DN), 1024, FFH, [=](int n, int& ld) { ld = 1024; return w + n; }, smem, jb, 0);
  }
  {
    const float* w = p.in[I_OWIN];
    convert_weight((u16*)(p.ws + WS_WT1IN), 2048, 1024, [=](int n, int& ld) { ld = 2048; return w + n; }, smem, jb, 0);
  }
  {
    const float* wr = p.in[I_OWR];
    const float* wi = p.in[I_OWI];
    convert_weight((u16*)(p.ws + WS_WT1G), 4096, 128, [=](int n, int& ld) {
      ld = 128;
      const int kb = n >> 9, w512 = n & 511, jt = w512 >> 7, z = jt >> 1, half = jt & 1;
      const int wq = w512 & 127, wn = wq >> 6, sub = (wq & 63) >> 5, c = wq & 31;
      const int dch = half * 64 + wn * 32 + c;
      return (sub ? wi : wr) + (size_t)(z * 8 + kb) * 16384 + dch;
    }, smem, jb, 0);
  }
  {
    const float* w = p.in[I_OWOUT];
    convert_weight((u16*)(p.ws + WS_WT1OUT), 1024, 1024, [=](int n, int& ld) { ld = 1024; return w + n; }, smem, jb, 0);
  }
  {
    const float* w = p.in[I_OWGU];
    convert_weight((u16*)(p.ws + WS_WT1GU), 2 * FFH, 1024, [=](int n, int& ld) { return gu_row(w, n, ld); }, smem, jb, 0);
  }
  {
    const float* w = p.in[I_OWDN];
    convert_weight((u16*)(p.ws + WS_WT1DN), 1024, FFH, [=](int n, int& ld) { ld = 1024; return w + n; }, smem, jb, 0);
  }
  (void)ws16;
}

DI void phase_mod(const Params& p, char* smem) {
  float* sc = (float*)smem;
  float* part = sc + 3 * 1024;
  const int tid = opaque_tid();
  bool loaded = false;
  for (int item = blockIdx.x; item < 192; item += gridDim.x) {
    if (!loaded) {
      for (int i = tid; i < 3072; i += 256) {
        const int cnd = i >> 10, k = i & 1023;
        const float v = cnd < 2 ? p.in[I_C][cnd * 1024 + k] : p.in[I_CCTX][k];
        sc[i] = siluf_(v);
      }
      loaded = true;
      __syncthreads();
    }
    const int l = item / 96, cgp = item % 96;
    const float* W = p.in[l ? I_OADAW : I_EADAW];
    const float* Bv = p.in[l ? I_OADAB : I_EADAB];
    const int col = cgp * 64 + (tid & 63), kq = tid >> 6;
    float a0 = 0.f, a1 = 0.f, a2 = 0.f;
#pragma unroll 8
    for (int k = kq * 256; k < kq * 256 + 256; ++k) {
      const float w = W[(size_t)k * 6144 + col];
      a0 += sc[k] * w; a1 += sc[1024 + k] * w; a2 += sc[2048 + k] * w;
    }
    part[(kq * 3 + 0) * 64 + (tid & 63)] = a0;
    part[(kq * 3 + 1) * 64 + (tid & 63)] = a1;
    part[(kq * 3 + 2) * 64 + (tid & 63)] = a2;
    __syncthreads();
    if (tid < 192) {
      const int cnd = tid >> 6, c = tid & 63;
      float s = Bv[cgp * 64 + c];
      for (int q = 0; q < 4; ++q) s += part[(q * 3 + cnd) * 64 + c];
      ((float*)(p.ws + WS_MOD))[(size_t)(l * 3 + cnd) * 6144 + cgp * 64 + c] = s;
    }
    __syncthreads();
  }
}

DI void phase_modulate(const float* hc, const float* hx, const float* gain, const float* mod, int shift_idx, int row_lo, u16* Aout) {
  const int tid0 = opaque_tid();
  const int lane = tid0 & 63, wid = tid0 >> 6;
  const int nw = gridDim.x * 4;
  for (int rowA = row_lo + blockIdx.x * 4 + wid; rowA < MROWS; rowA += 2 * nw) {
    const int rowB = rowA + nw;
    const bool hasB = rowB < MROWS;
    const int rB = hasB ? rowB : rowA;
    const float* srcA = rowA < LAT0 ? hc + (size_t)rowA * DM : hx + (size_t)(rowA - LAT0) * DM;
    const float* srcB = rB < LAT0 ? hc + (size_t)rB * DM : hx + (size_t)(rB - LAT0) * DM;
    float4 va[4], vb[4];
#pragma unroll
    for (int i = 0; i < 4; ++i) {
      va[i] = *reinterpret_cast<const float4*>(srcA + (i * 64 + lane) * 4);
      vb[i] = *reinterpret_cast<const float4*>(srcB + (i * 64 + lane) * 4);
    }
    float sa = 0.f, sb = 0.f;
#pragma unroll
    for (int i = 0; i < 4; ++i) {
      sa += va[i].x * va[i].x + va[i].y * va[i].y + va[i].z * va[i].z + va[i].w * va[i].w;
      sb += vb[i].x * vb[i].x + vb[i].y * vb[i].y + vb[i].z * vb[i].z + vb[i].w * vb[i].w;
    }
    sa = wave_sum(sa); sb = wave_sum(sb);
    const float ra = rsqrtf(sa * (1.f / 1024.f) + EPSF), rb = rsqrtf(sb * (1.f / 1024.f) + EPSF);
    const float* shA = mod + (size_t)row_cond(rowA) * 6144 + shift_idx * 1024;
    const float* shB = mod + (size_t)row_cond(rB) * 6144 + shift_idx * 1024;
    uint2 oa[4], ob[4];
#pragma unroll
    for (int i = 0; i < 4; ++i) {
      const int c = (i * 64 + lane) * 4;
      const float4 g = *reinterpret_cast<const float4*>(gain + c);
      const float4 s1 = *reinterpret_cast<const float4*>(shA + c), c1 = *reinterpret_cast<const float4*>(shA + 1024 + c);
      const float4 s2 = *reinterpret_cast<const float4*>(shB + c), c2 = *reinterpret_cast<const float4*>(shB + 1024 + c);
      oa[i] = make_uint2(pk2(va[i].x * ra * g.x * (1.f + c1.x) + s1.x, va[i].y * ra * g.y * (1.f + c1.y) + s1.y),
                         pk2(va[i].z * ra * g.z * (1.f + c1.z) + s1.z, va[i].w * ra * g.w * (1.f + c1.w) + s1.w));
      ob[i] = make_uint2(pk2(vb[i].x * rb * g.x * (1.f + c2.x) + s2.x, vb[i].y * rb * g.y * (1.f + c2.y) + s2.y),
                         pk2(vb[i].z * rb * g.z * (1.f + c2.z) + s2.z, vb[i].w * rb * g.w * (1.f + c2.w) + s2.w));
    }
#pragma unroll
    for (int i = 0; i < 4; ++i) {
      const int c = (i * 64 + lane) * 4;
      *reinterpret_cast<uint2*>(Aout + (size_t)rowA * DM + c) = oa[i];
      if (hasB) *reinterpret_cast<uint2*>(Aout + (size_t)rowB * DM + c) = ob[i];
    }
  }
}

constexpr int LDT = 72;
template <class Epi>
DI void gemm_phase(const u16* __restrict__ A, int lda, const u16* __restrict__ Bt, int ldb, int K, int mt_lo, int mtiles, int ntiles,
                   int nt_per_group, char* smem, Epi epi) {
  u16* sA = (u16*)smem;
  u16* sB = sA + 2 * 128 * LDT;
  const int tid = opaque_tid(), lane = tid & 63, wid = __builtin_amdgcn_readfirstlane(tid >> 6), wm = wid >> 1, wn = wid & 1;
  const int lr = lane & 31, lh = lane >> 5;
  const int ldrow = tid >> 3, ldc = (tid & 7) * 8;
  const int nk = K / 64;
  const int total = mtiles * ntiles;
  const int per_xcd = (total + 7) >> 3;
  const int xcd = blockIdx.x & 7, qx = blockIdx.x >> 3, nq = gridDim.x >> 3;
  for (int v = qx; v < per_xcd; v += nq) {
    const int u = xcd * per_xcd + v;
    if (u >= total) break;
    const int gsz_full = 8 * ntiles;
    const int g = u / gsz_full, r = u - g * gsz_full;
    const int gm = min(8, mtiles - g * 8);
    const int mt = mt_lo + g * 8 + r % gm, nt = r / gm;
    const unsigned oA = (unsigned)(((mt * 128 + ldrow) * lda + (nt / nt_per_group) * K + ldc) * 2);
    const unsigned oB = (unsigned)(((nt * 128 + ldrow) * ldb + ldc) * 2);
    const char* Ab = (const char*)A;
    const char* Bb = (const char*)Bt;
    f32x16 acc[2][2];
    acc[0][0] = zero16(); acc[0][1] = zero16(); acc[1][0] = zero16(); acc[1][1] = zero16();
    uint4 xa0, xa1, xa2, xa3, xb0, xb1, xb2, xb3, ya0, ya1, ya2, ya3, yb0, yb1, yb2, yb3;
#define G_LOADX(KT) do { const unsigned ka_ = oA + (unsigned)(KT) * 128u, kb_ = oB + (unsigned)(KT) * 128u; \
      xa0 = *reinterpret_cast<const uint4*>(Ab + (ka_ + 0u * (unsigned)lda * 2u)); \
      xa1 = *reinterpret_cast<const uint4*>(Ab + (ka_ + 32u * (unsigned)lda * 2u)); \
      xa2 = *reinterpret_cast<const uint4*>(Ab + (ka_ + 64u * (unsigned)lda * 2u)); \
      xa3 = *reinterpret_cast<const uint4*>(Ab + (ka_ + 96u * (unsigned)lda * 2u)); \
      xb0 = *reinterpret_cast<const uint4*>(Bb + (kb_ + 0u * (unsigned)ldb * 2u)); \
      xb1 = *reinterpret_cast<const uint4*>(Bb + (kb_ + 32u * (unsigned)ldb * 2u)); \
      xb2 = *reinterpret_cast<const uint4*>(Bb + (kb_ + 64u * (unsigned)ldb * 2u)); \
      xb3 = *reinterpret_cast<const uint4*>(Bb + (kb_ + 96u * (unsigned)ldb * 2u)); } while (0)
#define G_LOADY(KT) do { const unsigned ka_ = oA + (unsigned)(KT) * 128u, kb_ = oB + (unsigned)(KT) * 128u; \
      ya0 = *reinterpret_cast<const uint4*>(Ab + (ka_ + 0u * (unsigned)lda * 2u)); \
      ya1 = *reinterpret_cast<const uint4*>(Ab + (ka_ + 32u * (unsigned)lda * 2u)); \
      ya2 = *reinterpret_cast<const uint4*>(Ab + (ka_ + 64u * (unsigned)lda * 2u)); \
      ya3 = *reinterpret_cast<const uint4*>(Ab + (ka_ + 96u * (unsigned)lda * 2u)); \
      yb0 = *reinterpret_cast<const uint4*>(Bb + (kb_ + 0u * (unsigned)ldb * 2u)); \
      yb1 = *reinterpret_cast<const uint4*>(Bb + (kb_ + 32u * (unsigned)ldb * 2u)); \
      yb2 = *reinterpret_cast<const uint4*>(Bb + (kb_ + 64u * (unsigned)ldb * 2u)); \
      yb3 = *reinterpret_cast<const uint4*>(Bb + (kb_ + 96u * (unsigned)ldb * 2u)); } while (0)
#define G_STOREX(BUF) do { u16* wa_ = sA + (BUF) * 128 * LDT + ldrow * LDT + ldc; u16* wb_ = sB + (BUF) * 128 * LDT + ldrow * LDT + ldc; \
      *reinterpret_cast<uint4*>(wa_) = xa0; *reinterpret_cast<uint4*>(wa_ + 32 * LDT) = xa1; \
      *reinterpret_cast<uint4*>(wa_ + 64 * LDT) = xa2; *reinterpret_cast<uint4*>(wa_ + 96 * LDT) = xa3; \
      *reinterpret_cast<uint4*>(wb_) = xb0; *reinterpret_cast<uint4*>(wb_ + 32 * LDT) = xb1; \
      *reinterpret_cast<uint4*>(wb_ + 64 * LDT) = xb2; *reinterpret_cast<uint4*>(wb_ + 96 * LDT) = xb3; } while (0)
#define G_STOREY(BUF) do { u16* wa_ = sA + (BUF) * 128 * LDT + ldrow * LDT + ldc; u16* wb_ = sB + (BUF) * 128 * LDT + ldrow * LDT + ldc; \
      *reinterpret_cast<uint4*>(wa_) = ya0; *reinterpret_cast<uint4*>(wa_ + 32 * LDT) = ya1; \
      *reinterpret_cast<uint4*>(wa_ + 64 * LDT) = ya2; *reinterpret_cast<uint4*>(wa_ + 96 * LDT) = ya3; \
      *reinterpret_cast<uint4*>(wb_) = yb0; *reinterpret_cast<uint4*>(wb_ + 32 * LDT) = yb1; \
      *reinterpret_cast<uint4*>(wb_ + 64 * LDT) = yb2; *reinterpret_cast<uint4*>(wb_ + 96 * LDT) = yb3; } while (0)
#define G_COMPUTE(BUF) do { \
      const u16* a_ = sA + (BUF) * 128 * LDT + (wm * 64 + lr) * LDT + lh * 8; \
      const u16* b_ = sB + (BUF) * 128 * LDT + (wn * 64 + lr) * LDT + lh * 8; \
      _Pragma("unroll") for (int ks = 0; ks < 4; ++ks) { \
        const bf16x8 a0 = ld8(a_ + ks * 16), a1 = ld8(a_ + 32 * LDT + ks * 16); \
        const bf16x8 b0 = ld8(b_ + ks * 16), b1 = ld8(b_ + 32 * LDT + ks * 16); \
        acc[0][0] = mfma32(a0, b0, acc[0][0]); acc[0][1] = mfma32(a0, b1, acc[0][1]); \
        acc[1][0] = mfma32(a1, b0, acc[1][0]); acc[1][1] = mfma32(a1, b1, acc[1][1]); } } while (0)
    G_LOADX(0);
    G_STOREX(0);
    G_LOADX(1);
    if (nk > 2) G_LOADY(2);
    __syncthreads();
    for (int kt = 0; kt < nk; kt += 2) {
      G_COMPUTE(0);
      G_STOREX(1);
      if (kt + 3 < nk) G_LOADX(kt + 3);
      __syncthreads();
      G_COMPUTE(1);
      if (kt + 2 < nk) G_STOREY(0);
      if (kt + 4 < nk) G_LOADY(kt + 4);
      __syncthreads();
    }
    { int lr_ = lr, lh_ = lh; asm volatile("" : "+v"(lr_), "+v"(lh_));
      epi(acc, mt * 128 + wm * 64, nt * 128 + wn * 64, nt, wn, lr_, lh_); }
  }
}

struct EpiIn0 {
  u16 *qk, *vraw, *u0g, *z; float* g0;
  template <int MI>
  DI void operator()(f32x16 (&acc)[MI][2], int mb, int nb, int, int, int lr, int lh) const {
#pragma unroll
    for (int ni = 0; ni < 2; ++ni) {
      const int c0 = nb + ni * 32;
      u16* dst; int ld;
      if (c0 < 1024) { dst = qk + c0; ld = 1024; }
      else if (c0 < 1536) { dst = vraw + (c0 - 1024); ld = 512; }
      else if (c0 < 3072) { dst = u0g + (c0 - 1536); ld = 1536; }
      else if (c0 < 3584) { dst = z + (c0 - 3072); ld = 512; }
      else { dst = nullptr; ld = 0; }
#pragma unroll
      for (int mi = 0; mi < MI; ++mi) {
#pragma unroll
        for (int i = 0; i < 16; ++i) {
          const int row = mb + mi * 32 + crow(i, lh);
          if (dst) dst[(size_t)row * ld + lr] = f2bf(acc[mi][ni][i]);
          else if (c0 == 3584 && lr < 16) g0[(size_t)row * 16 + lr] = acc[mi][ni][i];
        }
      }
    }
  }
};
struct EpiResid {
  const float *hc_in, *hx_in; float *hc_out, *hx_out; const float* gate;
  DI void operator()(f32x16 (&acc)[2][2], int mb, int nb, int, int, int lr, int lh) const {
    const bool isc = mb < LAT0;
    if (isc && !hc_out) return;
    const float* in = isc ? hc_in + (size_t)mb * DM : hx_in + (size_t)(mb - LAT0) * DM;
    float* out = isc ? hc_out + (size_t)mb * DM : hx_out + (size_t)(mb - LAT0) * DM;
    const float* gt = gate + (size_t)row_cond(mb) * 6144;
#pragma unroll
    for (int ni = 0; ni < 2; ++ni) {
      const int col = nb + ni * 32 + lr;
      const float g = gt[col];
#pragma unroll
      for (int mi = 0; mi < 2; ++mi) {
#pragma unroll
        for (int i8 = 0; i8 < 16; i8 += 8) {
          float hv[8];
#pragma unroll
          for (int i = 0; i < 8; ++i) hv[i] = in[(size_t)(mi * 32 + crow(i8 + i, lh)) * DM + col];
#pragma unroll
          for (int i = 0; i < 8; ++i) out[(size_t)(mi * 32 + crow(i8 + i, lh)) * DM + col] = hv[i] + g * acc[mi][ni][i8 + i];
        }
      }
    }
  }
};
struct EpiSwiglu {
  u16* act;
  template <int MI>
  DI void operator()(f32x16 (&acc)[MI][2], int mb, int, int nt, int wn, int lr, int lh) const {
    const int hid = nt * 64 + wn * 32 + lr;
#pragma unroll
    for (int mi = 0; mi < MI; ++mi) {
#pragma unroll
      for (int i = 0; i < 16; ++i) {
        const int row = mb + mi * 32 + crow(i, lh);
        const float g = acc[mi][0][i], u = acc[mi][1][i];
        act[(size_t)row * FFH + hid] = f2bf(siluf_fast(g) * u);
      }
      __builtin_amdgcn_sched_barrier(0);
    }
  }
};
struct EpiIn1 {
  u16 *ug, *ur;
  template <int MI>
  DI void operator()(f32x16 (&acc)[MI][2], int mb, int nb, int, int, int lr, int lh) const {
#pragma unroll
    for (int mi = 0; mi < MI; ++mi)
#pragma unroll
      for (int ni = 0; ni < 2; ++ni) {
        const int col = nb + ni * 32 + lr;
#pragma unroll
        for (int i = 0; i < 16; ++i) {
          const int row = mb + mi * 32 + crow(i, lh);
          if (col < 1024) { if (row >= LAT0) ug[(size_t)(row - LAT0) * DM + col] = f2bf(acc[mi][ni][i]); }
          else ur[(size_t)row * DM + col - 1024] = f2bf(acc[mi][ni][i]);
        }
      }
  }
};
struct EpiGates {
  const u16* xc; u16* ab; const float *b_r, *b_i, *lam;
  DI void operator()(f32x16 (&acc)[2][2], int mb, int, int nt, int wn, int lr, int lh) const {
    const int kb = nt >> 2, jt = nt & 3, z = jt >> 1, half = jt & 1;
    const int ch = kb * 128 + half * 64 + wn * 32 + lr;
    const float br = b_r[z * 1024 + ch], bi = b_i[z * 1024 + ch];
    const float sp = softplusf_(-lam[z * 1024 + ch]);
    u16* la = ab + (size_t)z * 2 * MROWS * DM;
    u16* bb = la + (size_t)MROWS * DM;
#pragma unroll
    for (int mi = 0; mi < 2; ++mi) {
      float xv[16];
#pragma unroll
      for (int i = 0; i < 16; ++i) xv[i] = bf2f(xc[(size_t)(mb + mi * 32 + crow(i, lh)) * DM + ch]);
#pragma unroll
      for (int i = 0; i < 16; ++i) {
        const int row = mb + mi * 32 + crow(i, lh);
        const float r = sigmoidf_fast(acc[mi][0][i] + br), ig = sigmoidf_fast(acc[mi][1][i] + bi);
        const float loga = -8.f * r * sp;
        const float a2 = __expf(2.f * loga);
        const float bval = __builtin_amdgcn_sqrtf(fmaxf(1.f - a2, 0.f)) * (ig * xv[i]);
        la[(size_t)row * DM + ch] = f2bf(loga);
        bb[(size_t)row * DM + ch] = f2bf(bval);
      }
      __builtin_amdgcn_sched_barrier(0);
    }
  }
};


constexpr int LD4 = 40;
template <class Epi>
DI void gemm_phase4(const u16* __restrict__ A, int lda, const u16* __restrict__ Bt, int ldb, int K, int mt_lo, int mtiles, int ntiles,
                    char* smem, Epi epi) {
  u16* sA = (u16*)smem;
  u16* sB = sA + 2 * 256 * LD4;
  const int tid = opaque_tid(), lane = tid & 63, wid = __builtin_amdgcn_readfirstlane(tid >> 6), wm = wid >> 1, wn = wid & 1;
  const int lr = lane & 31, lh = lane >> 5;
  const int ldrow = tid >> 2, ldc = (tid & 3) * 8;
  const int nk = K / 32;
  const int total = mtiles * ntiles;
  const int per_xcd = (total + 7) >> 3;
  const int xcd = blockIdx.x & 7, qx = blockIdx.x >> 3, nq = gridDim.x >> 3;
  for (int v = qx; v < per_xcd; v += nq) {
    const int u = xcd * per_xcd + v;
    if (u >= total) break;
    const int gsz_full = 8 * ntiles;
    const int g = u / gsz_full, r = u - g * gsz_full;
    const int gm = min(8, mtiles - g * 8);
    const int mt = mt_lo + g * 8 + r % gm, nt = r / gm;
    const unsigned oA = (unsigned)(((mt * 256 + ldrow) * lda + ldc) * 2);
    const unsigned oB = (unsigned)(((nt * 128 + ldrow) * ldb + ldc) * 2);
    const char* Ab = (const char*)A;
    const char* Bb = (const char*)Bt;
    f32x16 acc[4][2];
#pragma unroll
    for (int mi = 0; mi < 4; ++mi) { acc[mi][0] = zero16(); acc[mi][1] = zero16(); }
    uint4 xa0, xa1, xa2, xa3, xb0, xb1, ya0, ya1, ya2, ya3, yb0, yb1;
#define G4_LOADX(KT) do { const unsigned ka_ = oA + (unsigned)(KT) * 64u, kb_ = oB + (unsigned)(KT) * 64u; \
      xa0 = *reinterpret_cast<const uint4*>(Ab + ka_); xa1 = *reinterpret_cast<const uint4*>(Ab + (ka_ + 64u * (unsigned)lda * 2u)); \
      xa2 = *reinterpret_cast<const uint4*>(Ab + (ka_ + 128u * (unsigned)lda * 2u)); xa3 = *reinterpret_cast<const uint4*>(Ab + (ka_ + 192u * (unsigned)lda * 2u)); \
      xb0 = *reinterpret_cast<const uint4*>(Bb + kb_); xb1 = *reinterpret_cast<const uint4*>(Bb + (kb_ + 64u * (unsigned)ldb * 2u)); } while (0)
#define G4_LOADY(KT) do { const unsigned ka_ = oA + (unsigned)(KT) * 64u, kb_ = oB + (unsigned)(KT) * 64u; \
      ya0 = *reinterpret_cast<const uint4*>(Ab + ka_); ya1 = *reinterpret_cast<const uint4*>(Ab + (ka_ + 64u * (unsigned)lda * 2u)); \
      ya2 = *reinterpret_cast<const uint4*>(Ab + (ka_ + 128u * (unsigned)lda * 2u)); ya3 = *reinterpret_cast<const uint4*>(Ab + (ka_ + 192u * (unsigned)lda * 2u)); \
      yb0 = *reinterpret_cast<const uint4*>(Bb + kb_); yb1 = *reinterpret_cast<const uint4*>(Bb + (kb_ + 64u * (unsigned)ldb * 2u)); } while (0)
#define G4_STOREX(BUF) do { u16* wa_ = sA + (BUF) * 256 * LD4 + ldrow * LD4 + ldc; u16* wb_ = sB + (BUF) * 128 * LD4 + ldrow * LD4 + ldc; \
      *reinterpret_cast<uint4*>(wa_) = xa0; *reinterpret_cast<uint4*>(wa_ + 64 * LD4) = xa1; \
      *reinterpret_cast<uint4*>(wa_ + 128 * LD4) = xa2; *reinterpret_cast<uint4*>(wa_ + 192 * LD4) = xa3; \
      *reinterpret_cast<uint4*>(wb_) = xb0; *reinterpret_cast<uint4*>(wb_ + 64 * LD4) = xb1; } while (0)
#define G4_STOREY(BUF) do { u16* wa_ = sA + (BUF) * 256 * LD4 + ldrow * LD4 + ldc; u16* wb_ = sB + (BUF) * 128 * LD4 + ldrow * LD4 + ldc; \
      *reinterpret_cast<uint4*>(wa_) = ya0; *reinterpret_cast<uint4*>(wa_ + 64 * LD4) = ya1; \
      *reinterpret_cast<uint4*>(wa_ + 128 * LD4) = ya2; *reinterpret_cast<uint4*>(wa_ + 192 * LD4) = ya3; \
      *reinterpret_cast<uint4*>(wb_) = yb0; *reinterpret_cast<uint4*>(wb_ + 64 * LD4) = yb1; } while (0)
#define G4_COMPUTE(BUF) do { \
      const u16* a_ = sA + (BUF) * 256 * LD4 + (wm * 128 + lr) * LD4 + lh * 8; \
      const u16* b_ = sB + (BUF) * 128 * LD4 + (wn * 64 + lr) * LD4 + lh * 8; \
      _Pragma("unroll") for (int ks = 0; ks < 2; ++ks) { \
        const bf16x8 b0 = ld8(b_ + ks * 16), b1 = ld8(b_ + 32 * LD4 + ks * 16); \
        _Pragma("unroll") for (int mi = 0; mi < 4; ++mi) { \
          const bf16x8 a0 = ld8(a_ + mi * 32 * LD4 + ks * 16); \
          acc[mi][0] = mfma32(a0, b0, acc[mi][0]); acc[mi][1] = mfma32(a0, b1, acc[mi][1]); } } } while (0)
    G4_LOADX(0);
    G4_STOREX(0);
    G4_LOADX(1);
    if (nk > 2) G4_LOADY(2);
    __syncthreads();
    for (int kt = 0; kt < nk; kt += 2) {
      G4_COMPUTE(0);
      G4_STOREX(1);
      if (kt + 3 < nk) G4_LOADX(kt + 3);
      __syncthreads();
      G4_COMPUTE(1);
      if (kt + 2 < nk) G4_STOREY(0);
      if (kt + 4 < nk) G4_LOADY(kt + 4);
      __syncthreads();
    }
    { int lr_ = lr, lh_ = lh; asm volatile("" : "+v"(lr_), "+v"(lh_));
      epi.template operator()<4>(acc, mt * 256 + wm * 128, nt * 128 + wn * 64, nt, wn, lr_, lh_); }
  }
}

DI void phase_da_prep(const Params& p, char* smem) {
  u16* qk = (u16*)((char*)p.out + DO_QK);
  const int tid0 = opaque_tid();
  const int lane = tid0 & 63, wid = tid0 >> 6;
  const int nw = gridDim.x * 4;
  const int qq = lane & 3;
  const bool isk = lane >= 32;
  const float* gain = p.in[isk ? I_KN : I_QN] + qq * 16;
  for (int row = blockIdx.x * 4 + wid; row < MROWS; row += nw) {
    uint4* ptr = reinterpret_cast<uint4*>(qk + (size_t)row * 1024 + lane * 16);
    const uint4 v0 = ptr[0], v1 = ptr[1];
    float x[16];
    x[0] = bflo(v0.x); x[1] = bfhi(v0.x); x[2] = bflo(v0.y); x[3] = bfhi(v0.y); x[4] = bflo(v0.z); x[5] = bfhi(v0.z); x[6] = bflo(v0.w); x[7] = bfhi(v0.w);
    x[8] = bflo(v1.x); x[9] = bfhi(v1.x); x[10] = bflo(v1.y); x[11] = bfhi(v1.y); x[12] = bflo(v1.z); x[13] = bfhi(v1.z); x[14] = bflo(v1.w); x[15] = bfhi(v1.w);
    float ss = 0.f;
#pragma unroll
    for (int i = 0; i < 16; ++i) ss += x[i] * x[i];
    ss += __shfl_xor(ss, 1); ss += __shfl_xor(ss, 2);
    const float rinv = rsqrtf(ss * (1.f / 64.f) + EPSF) * (isk ? 1.f : 0.125f * 1.4426950408889634f);
#pragma unroll
    for (int i = 0; i < 16; ++i) x[i] = x[i] * rinv * gain[i];
    if (row >= LAT0) {
      const int t = (row - LAT0) & (SEQ - 1);
      const float pos = (float)((qq >> 1) ? (t & 63) : (t >> 6));
#pragma unroll
      for (int i = 0; i < 16; ++i) {
        const float other = __shfl_xor(x[i], 1);
        const float inv = exp2f(-(float)i * (13.287712379549449f / 16.f));
        const float ang = pos * inv;
        float rev = ang * 0.15915494309189535f;
        rev -= floorf(rev);
        const float sn = __builtin_amdgcn_sinf(rev), cs = __builtin_amdgcn_cosf(rev);
        x[i] = (qq & 1) ? (x[i] * cs + other * sn) : (x[i] * cs - other * sn);
      }
    }
    ptr[0] = make_uint4(pk2(x[0], x[1]), pk2(x[2], x[3]), pk2(x[4], x[5]), pk2(x[6], x[7]));
    ptr[1] = make_uint4(pk2(x[8], x[9]), pk2(x[10], x[11]), pk2(x[12], x[13]), pk2(x[14], x[15]));
  }
  const u16* vraw = (const u16*)(p.ws + WS_VRAW);
  u16* vt = (u16*)((char*)p.out + DO_VT);
  u16* sv = (u16*)smem;
  const int tid = tid0;
  for (int item = blockIdx.x; item < 2 * 4 * NCH; item += gridDim.x) {
    const int t = item % NCH, bh = item / NCH, b = bh >> 2, h = bh & 3;
    const int row0 = t < 4 ? b * CTXL + t * 64 : LAT0 + b * SEQ + (t - 4) * 64;
    {
      const int key = tid >> 2, ec = (tid & 3) * 32;
      const uint4* s = reinterpret_cast<const uint4*>(vraw + (size_t)(row0 + key) * 512 + h * 128 + ec);
#pragma unroll
      for (int i = 0; i < 4; ++i) {
        const uint4 v = s[i];
        u32* d = reinterpret_cast<u32*>(sv + key * 130 + ec + i * 8);
        d[0] = v.x; d[1] = v.y; d[2] = v.z; d[3] = v.w;
      }
    }
    __syncthreads();
    {
      const int e = tid >> 1, half = tid & 1;
      u32 w[16];
#pragma unroll
      for (int i = 0; i < 16; ++i) {
        const int p0 = half * 32 + 2 * i, p1 = p0 + 1;
        const int k0 = (p0 & ~12) | ((p0 & 4) << 1) | ((p0 & 8) >> 1);
        const int k1 = (p1 & ~12) | ((p1 & 4) << 1) | ((p1 & 8) >> 1);
        w[i] = (u32)sv[k0 * 130 + e] | ((u32)sv[k1 * 130 + e] << 16);
      }
      uint4* d = reinterpret_cast<uint4*>(vt + ((size_t)(bh * 128 + e)) * SK + t * 64 + half * 32);
      d[0] = make_uint4(w[0], w[1], w[2], w[3]); d[1] = make_uint4(w[4], w[5], w[6], w[7]);
      d[2] = make_uint4(w[8], w[9], w[10], w[11]); d[3] = make_uint4(w[12], w[13], w[14], w[15]);
    }
    __syncthreads();
  }
}

#define LDS_AS __attribute__((address_space(3)))
DI void glds16(const void* g, char* lds_wave_base) {
  __builtin_amdgcn_global_load_lds((const unsigned*)g, (LDS_AS unsigned*)lds_wave_base, 16, 0, 0);
}
#define RAW_BARRIER() do { asm volatile("s_waitcnt lgkmcnt(0)" ::: "memory"); __builtin_amdgcn_s_barrier(); } while (0)
DI void phase_da_attn(const Params& p, char* smem) {
  const u16* qk = (const u16*)((const char*)p.out + DO_QK);
  const u16* vt = (const u16*)((const char*)p.out + DO_VT);
  u16* mix = (u16*)(p.ws + WS_MIX);
  char* sK = smem;
  char* sV = smem + 32768;
  float* ex = (float*)smem;
  const int tid = opaque_tid(), lane = tid & 63, wid = __builtin_amdgcn_readfirstlane(tid >> 6), lr = lane & 31, lh = lane >> 5;
  const int qg = wid >> 1, mp = wid & 1;
  float lam;
  {
    const float a = p.in[I_LQ1][lane] * p.in[I_LK1][lane], b2 = p.in[I_LQ2][lane] * p.in[I_LK2][lane];
    lam = __expf(wave_sum(a)) - __expf(wave_sum(b2)) + 0.2f;
  }
  int* cnt = (int*)(p.ws + WS_CNT);
  int* sitem = (int*)(smem + 73728);
  if (tid == 0) { sitem[1] = (int)((unsigned)__builtin_amdgcn_s_getreg((3 << 11) | 20) & 7u); sitem[2] = 0; }
  const int x15 = lr & 15, f3 = (lr >> 2) & 3;
  for (;;) {
    if (tid == 0) {
      int got = -1, tries = sitem[2];
      const int home = sitem[1];
      while (tries < 8) {
        const int it = atomicAdd(&cnt[(home + tries) & 7], 1);
        if (it < 260) { got = ((home + tries) & 7) | (it << 3); break; }
        ++tries;
      }
      sitem[2] = tries;
      *sitem = got;
    }
    __syncthreads();
    const int item = *sitem;
    if (item < 0) break;
    const int bh = item & 7, b = bh >> 2, h = bh & 3, qb = item >> 3;
    const bool isctx = qb >= 256;
    const int qrow0 = isctx ? b * CTXL + (qb - 256) * 64 : LAT0 + b * SEQ + qb * 64;
    const int ntile = isctx ? 8 : 2 * NCH;
    const int myq = qrow0 + qg * 32 + lr;
    bf16x8 qf[4];
#pragma unroll
    for (int ks = 0; ks < 4; ++ks) qf[ks] = ld8(qk + (size_t)myq * 1024 + h * 128 + mp * 64 + ks * 16 + lh * 8);
    f32x16 O[4];
#pragma unroll
    for (int dt = 0; dt < 4; ++dt) O[dt] = zero16();
    float l = 0.f;
    const u16* vsrc0 = vt + (size_t)(bh * 128) * SK;
#define DA_DMA(T) do { const int t_ = (T); const int st_ = t_ & 3; \
      int lq = lane; asm volatile("" : "+v"(lq)); \
      const int krl_ = lq >> 4, kpl_ = lq & 15, vrl_ = lq >> 2, vpl_ = lq & 3; \
      const int krow0 = t_ < 8 ? b * CTXL + t_ * 32 : LAT0 + b * SEQ + (t_ - 8) * 32; \
      const char* kbt = (const char*)(qk + (size_t)krow0 * 1024 + 512 + h * 128); \
      const char* vbt = (const char*)(vsrc0 + t_ * 32); \
      char* kd = sK + st_ * 8192 + wid * 2048; char* vd = sV + st_ * 8192 + wid * 2048; \
      const unsigned kob = (unsigned)((wid * 8 + krl_) * 2048), vob = (unsigned)(((wid * 32 + vrl_) * SK) * 2); \
      glds16(kbt + (kob + (unsigned)(0 * 2048 + ((kpl_ ^ ((wid * 8 + 0 + krl_) & 15)) << 4))), kd); \
      glds16(kbt + (kob + (unsigned)(4 * 2048 + ((kpl_ ^ ((wid * 8 + 4 + krl_) & 15)) << 4))), kd + 1024); \
      glds16(vbt + (vob + (unsigned)(0 * SK * 2 + ((vpl_ ^ (((0 + vrl_) >> 2) & 3)) << 4))), vd); \
      glds16(vbt + (vob + (unsigned)(16 * SK * 2 + ((vpl_ ^ (((16 + vrl_) >> 2) & 3)) << 4))), vd + 1024); } while (0)
    DA_DMA(0); DA_DMA(1); DA_DMA(2);
#pragma unroll 1
    for (int t = 0; t < ntile; ++t) {
      if (t + 2 < ntile) asm volatile("s_waitcnt vmcnt(8)" ::: "memory");
      else if (t + 1 < ntile) asm volatile("s_waitcnt vmcnt(4)" ::: "memory");
      else asm volatile("s_waitcnt vmcnt(0)" ::: "memory");
      RAW_BARRIER();
      if (t + 3 < ntile) DA_DMA(t + 3);
      const int st = t & 3;
      const unsigned kb = (unsigned)(size_t)(LDS_AS char*)(sK + st * 8192 + lr * 256);
      const unsigned vb = (unsigned)(size_t)(LDS_AS char*)(sV + st * 8192 + lr * 64);
      bf16x8 k0, k1, k2, k3, v0, v1, v2, v3, v4, v5, v6, v7;
      asm volatile("ds_read_b128 %0, %4\n\tds_read_b128 %1, %5\n\tds_read_b128 %2, %6\n\tds_read_b128 %3, %7"
                   : "=&v"(k0), "=&v"(k1), "=&v"(k2), "=&v"(k3)
                   : "v"(kb + (((mp * 8 + 0 + lh) ^ x15) << 4)), "v"(kb + (((mp * 8 + 2 + lh) ^ x15) << 4)),
                     "v"(kb + (((mp * 8 + 4 + lh) ^ x15) << 4)), "v"(kb + (((mp * 8 + 6 + lh) ^ x15) << 4)) : "memory");
      const unsigned va = vb + (((0 + lh) ^ f3) << 4), vc = vb + (((2 + lh) ^ f3) << 4);
      asm volatile("ds_read_b128 %0, %8\n\tds_read_b128 %1, %9\n\tds_read_b128 %2, %8 offset:2048\n\tds_read_b128 %3, %9 offset:2048\n\t"
                   "ds_read_b128 %4, %8 offset:4096\n\tds_read_b128 %5, %9 offset:4096\n\tds_read_b128 %6, %8 offset:6144\n\tds_read_b128 %7, %9 offset:6144"
                   : "=&v"(v0), "=&v"(v1), "=&v"(v2), "=&v"(v3), "=&v"(v4), "=&v"(v5), "=&v"(v6), "=&v"(v7)
                   : "v"(va), "v"(vc) : "memory");
      asm volatile("s_waitcnt lgkmcnt(8)" : "+v"(k0), "+v"(k1), "+v"(k2), "+v"(k3) :: "memory");
      f32x16 s = zero16();
      s = mfma32(k0, qf[0], s); s = mfma32(k1, qf[1], s); s = mfma32(k2, qf[2], s); s = mfma32(k3, qf[3], s);
      float rs = 0.f;
#pragma unroll
      for (int i = 0; i < 16; ++i) { s[i] = __builtin_amdgcn_exp2f(s[i]); rs += s[i]; }
      l += rs;
      const bf16x8 pb0 = pack_step(s, 0), pb1 = pack_step(s, 1);
      asm volatile("s_waitcnt lgkmcnt(0)" : "+v"(v0), "+v"(v1), "+v"(v2), "+v"(v3), "+v"(v4), "+v"(v5), "+v"(v6), "+v"(v7) :: "memory");
      O[0] = mfma32(v0, pb0, O[0]); O[1] = mfma32(v2, pb0, O[1]); O[2] = mfma32(v4, pb0, O[2]); O[3] = mfma32(v6, pb0, O[3]);
      O[0] = mfma32(v1, pb1, O[0]); O[1] = mfma32(v3, pb1, O[1]); O[2] = mfma32(v5, pb1, O[2]); O[3] = mfma32(v7, pb1, O[3]);
    }
    __syncthreads();
    l += __shfl_xor(l, 32);
    if (mp == 1) {
      const float sc = lam / l;
#pragma unroll
      for (int dt = 0; dt < 4; ++dt)
#pragma unroll
        for (int i = 0; i < 16; ++i) ex[((qg * 4 + dt) * 16 + i) * 64 + lane] = O[dt][i] * sc;
    }
    __syncthreads();
    if (mp == 0) {
      const float i0 = 1.f / l;
      float ss = 0.f;
#pragma unroll
      for (int dt = 0; dt < 4; ++dt)
#pragma unroll
        for (int i = 0; i < 16; ++i) {
          const float v = O[dt][i] * i0 - ex[((qg * 4 + dt) * 16 + i) * 64 + lane];
          O[dt][i] = v; ss += v * v;
        }
      ss += __shfl_xor(ss, 32);
      const float rinv = rsqrtf(ss * (1.f / 128.f) + EPSF) * 0.8f;
      const float* sn = p.in[I_SUBN];
#pragma unroll
      for (int dt = 0; dt < 4; ++dt)
#pragma unroll
        for (int g = 0; g < 4; ++g) {
          const int dv = dt * 32 + 8 * g + 4 * lh;
          const float4 gn = *reinterpret_cast<const float4*>(sn + dv);
          const u32 w0 = pk2(O[dt][4 * g] * rinv * gn.x, O[dt][4 * g + 1] * rinv * gn.y);
          const u32 w1 = pk2(O[dt][4 * g + 2] * rinv * gn.z, O[dt][4 * g + 3] * rinv * gn.w);
          *reinterpret_cast<uint2*>(mix + (size_t)myq * 1024 + h * 128 + dv) = make_uint2(w0, w1);
        }
    }
    __syncthreads();
  }
}

template <int DIR>
DI void gdn_solve(float (&X)[64], int c, const float* sAm, const float* gc, const float* bt, const u16* skn, const u16* svv) {
  if (c < 128) {
#pragma unroll
    for (int i = 0; i < 64; ++i) {
      const int tok = DIR ? 63 - i : i;
      X[i] = bt[i] * bf2f(svv[tok * 128 + c]);
    }
  } else {
#pragma unroll
    for (int i = 0; i < 64; ++i) {
      const int tok = DIR ? 63 - i : i;
      X[i] = bt[i] * __expf(gc[i]) * bf2f(skn[tok * 136 + c - 128]);
    }
  }
  __builtin_amdgcn_sched_barrier(0);
#pragma unroll
  for (int i = 1; i < 64; ++i) {
    float acc = X[i];
    const float4* arow = reinterpret_cast<const float4*>(sAm + i * 64);
#pragma unroll
    for (int j4 = 0; j4 < (i + 3) / 4; ++j4) {
      const float4 a4 = arow[j4];
      if (4 * j4 + 0 < i) acc = __builtin_fmaf(-a4.x, X[4 * j4 + 0], acc);
      if (4 * j4 + 1 < i) acc = __builtin_fmaf(-a4.y, X[4 * j4 + 1], acc);
      if (4 * j4 + 2 < i) acc = __builtin_fmaf(-a4.z, X[4 * j4 + 2], acc);
      if (4 * j4 + 3 < i) acc = __builtin_fmaf(-a4.w, X[4 * j4 + 3], acc);
    }
    X[i] = acc;
    __builtin_amdgcn_sched_barrier(0);
  }
}

constexpr int QS = 136;
DI void phase_gdn_prep(const Params& p, char* smem) {
  u16* sq = (u16*)smem;
  u16* skn = sq + 64 * QS;
  float* sAm = (float*)(skn + 64 * QS);
  u16* sat = (u16*)(sAm + 64 * 64);
  float* sgc = (float*)(sat + 64 * 72);
  float* sbt = sgc + 128;
  u16* svv = (u16*)(sbt + 128);
  const u16* u0g = (const u16*)(p.ws + WS_U0G);
  const float* g0 = (const float*)(p.ws + WS_G0);
  const float* cw = p.in[I_GCONV];
  for (int item = blockIdx.x; item < 2 * NCH * 4; item += gridDim.x) {
    int tid = opaque_tid();
    const int lane = tid & 63, wid = __builtin_amdgcn_readfirstlane(tid >> 6), lr = lane & 31, lh = lane >> 5;
    const int h = item & 3, n = (item >> 2) % NCH, b = item / (4 * NCH);
    const int row0 = n < 4 ? b * CTXL + n * 64 : LAT0 + b * SEQ + (n - 4) * 64;
    const int t0 = n < 4 ? n * 64 : (n - 4) * 64;
    const int slen = n < 4 ? CTXL : SEQ;
    {
      int t1 = tid; asm volatile("" : "+v"(t1));
      const int cgp = t1 & 15, rg = t1 >> 4;
#pragma unroll
      for (int qk_ = 0; qk_ < 3; ++qk_) {
        const int chb = qk_ * 512 + h * 128 + cgp * 8;
        float wv[4][8];
#pragma unroll
        for (int j = 0; j < 4; ++j)
#pragma unroll
          for (int e = 0; e < 8; ++e) wv[j][e] = cw[j * 1536 + chb + e];
        float xin[7][8];
#pragma unroll
        for (int r = 0; r < 7; ++r) {
          const int tt = rg * 4 + r - 2;
          const int pos = t0 + tt;
          if (pos >= 0 && pos < slen) {
            const uint4 v = *reinterpret_cast<const uint4*>(u0g + (size_t)(row0 + tt) * 1536 + chb);
            xin[r][0] = bflo(v.x); xin[r][1] = bfhi(v.x); xin[r][2] = bflo(v.y); xin[r][3] = bfhi(v.y);
            xin[r][4] = bflo(v.z); xin[r][5] = bfhi(v.z); xin[r][6] = bflo(v.w); xin[r][7] = bfhi(v.w);
          } else {
#pragma unroll
            for (int e = 0; e < 8; ++e) xin[r][e] = 0.f;
          }
        }
#pragma unroll
        for (int r = 0; r < 4; ++r) {
          float y[8]; float ss = 0.f;
#pragma unroll
          for (int e = 0; e < 8; ++e) {
            float a = 0.f;
#pragma unroll
            for (int j = 0; j < 4; ++j) a += wv[j][e] * xin[r + j][e];
            y[e] = siluf_fast(a); ss += y[e] * y[e];
          }
          ss += __shfl_xor(ss, 1); ss += __shfl_xor(ss, 2); ss += __shfl_xor(ss, 4); ss += __shfl_xor(ss, 8);
          const float rinv = qk_ == 2 ? 1.f : rsqrtf(ss + EPSF);
          u16* d = qk_ == 2 ? svv + (rg * 4 + r) * 128 + cgp * 8 : (qk_ ? skn : sq) + (rg * 4 + r) * QS + cgp * 8;
          *reinterpret_cast<uint4*>(d) = make_uint4(pk2(y[0] * rinv, y[1] * rinv), pk2(y[2] * rinv, y[3] * rinv),
                                                    pk2(y[4] * rinv, y[5] * rinv), pk2(y[6] * rinv, y[7] * rinv));
        }
      }
    }
    if (wid < 2) {
      const int d = wid, tok = d ? 63 - lane : lane;
      const float* gr = g0 + (size_t)(row0 + tok) * 16;
      const float beta = sigmoidf_(gr[d * 4 + h]);
      const float g = -__expf(p.in[I_ALOG][d * 4 + h]) * softplusf_(gr[8 + d * 4 + h] + p.in[I_DTB][d * 4 + h]);
      float cs = g;
#pragma unroll
      for (int o = 1; o < 64; o <<= 1) { const float v = __shfl_up(cs, o); if (lane >= o) cs += v; }
      sgc[d * 64 + lane] = cs; sbt[d * 64 + lane] = beta;
    }
    __syncthreads();
    for (int d = 0; d < 2; ++d) {
      char* fr = p.ws + WS_FRAGS + (size_t)(((b * 2 + d) * 4 + h) * NCH + n) * FRAG_ITEM;
      const float* gc = sgc + d * 64;
      const float* bt = sbt + d * 64;
      {
        int lr_ = lr; asm volatile("" : "+v"(lr_));
        const int ti = wid >> 1, tj = wid & 1;
        const int ri = d ? 63 - (ti * 32 + lr_) : ti * 32 + lr_;
        const int rj = d ? 63 - (tj * 32 + lr_) : tj * 32 + lr_;
        f32x16 kk = zero16(), qkk = zero16();
#pragma unroll
        for (int ks = 0; ks < 8; ++ks) {
          const bf16x8 bk = ld8(skn + rj * QS + ks * 16 + lh * 8);
          kk = mfma32(ld8(skn + ri * QS + ks * 16 + lh * 8), bk, kk);
          qkk = mfma32(ld8(sq + ri * QS + ks * 16 + lh * 8), bk, qkk);
        }
        const int j = tj * 32 + lr_;
        const float gcj = gc[j];
#pragma unroll
        for (int r = 0; r < 16; ++r) {
          const int i = ti * 32 + crow(r, lh);
          const float dec = __expf(fminf(gc[i] - gcj, 0.f));
          sAm[i * 64 + j] = (i > j) ? bt[i] * kk[r] * dec : 0.f;
          sat[i * 72 + j] = f2bf((i >= j) ? qkk[r] * dec * 0.08838834764831845f : 0.f);
        }
      }
      __syncthreads();
      float X[64];
      if (d == 0) gdn_solve<0>(X, tid, sAm, gc, bt, skn, svv);
      else gdn_solve<1>(X, tid, sAm, gc, bt, skn, svv);
      __syncthreads();
      u16* sW = (u16*)sAm;
      if (tid >= 128) {
#pragma unroll
        for (int i = 0; i < 64; ++i) sW[i * 128 + tid - 128] = f2bf(-X[i]);
      } else {
        int tu = tid; asm volatile("" : "+v"(tu));
        const int sl = tu >> 5, n_ = tu & 31;
        u16* ud = (u16*)(fr + FR_U);
#pragma unroll
        for (int mt = 0; mt < 2; ++mt)
#pragma unroll
          for (int hh = 0; hh < 2; ++hh) {
            u32 w[8];
#pragma unroll
            for (int r2 = 0; r2 < 8; ++r2) w[r2] = pk2(X[mt * 32 + crow(2 * r2, hh)], X[mt * 32 + crow(2 * r2 + 1, hh)]);
            uint4* dd = reinterpret_cast<uint4*>(ud + ((size_t)((sl * 2 + mt) * 64 + hh * 32 + n_)) * 16);
            dd[0] = make_uint4(w[0], w[1], w[2], w[3]); dd[1] = make_uint4(w[4], w[5], w[6], w[7]);
          }
      }
      __syncthreads();
      int tq = tid; asm volatile("" : "+v"(tq));
      const float glast = gc[63];
      if (tid == 0) ((float*)(p.ws + WS_GL))[((b * 2 + d) * 4 + h) * NCH + n] = __expf(glast);
#pragma unroll 1
      for (int idx = tq; idx < 16 * 64; idx += 256) {
        const int L = idx & 63, f = idx >> 6, mt = f >> 3, ks = f & 7, m = L & 31, hh = L >> 5;
        const int i = mt * 32 + m, tok = d ? 63 - i : i;
        const int dk0 = 32 * (ks >> 1) + 16 * (ks & 1) + 4 * hh;
        const uint2 wa = *reinterpret_cast<const uint2*>(sW + i * 128 + dk0);
        const uint2 wb = *reinterpret_cast<const uint2*>(sW + i * 128 + dk0 + 8);
        reinterpret_cast<uint4*>(fr + FR_W)[idx] = make_uint4(wa.x, wa.y, wb.x, wb.y);
        const float sc = __expf(gc[i]) * 0.08838834764831845f;
        const uint2 qa = *reinterpret_cast<const uint2*>(sq + tok * QS + dk0);
        const uint2 qb = *reinterpret_cast<const uint2*>(sq + tok * QS + dk0 + 8);
        reinterpret_cast<uint4*>(fr + FR_Q)[idx] = make_uint4(pk2(bflo(qa.x) * sc, bfhi(qa.x) * sc), pk2(bflo(qa.y) * sc, bfhi(qa.y) * sc),
                                                             pk2(bflo(qb.x) * sc, bfhi(qb.x) * sc), pk2(bflo(qb.y) * sc, bfhi(qb.y) * sc));
      }
#pragma unroll 1
      for (int idx = tq; idx < 16 * 64; idx += 256) {
        const int L = idx & 63, f = idx >> 6, kt = f >> 2, ks = f & 3, m = L & 31, hh = L >> 5;
        float v[8];
#pragma unroll
        for (int j = 0; j < 8; ++j) {
          const int i = 32 * (ks >> 1) + krow(ks & 1, hh, j), tok = d ? 63 - i : i;
          v[j] = bf2f(skn[tok * QS + kt * 32 + m]) * __expf(glast - gc[i]);
        }
        reinterpret_cast<uint4*>(fr + FR_KT)[idx] = make_uint4(pk2(v[0], v[1]), pk2(v[2], v[3]), pk2(v[4], v[5]), pk2(v[6], v[7]));
      }
#pragma unroll 1
      for (int idx = tq; idx < 8 * 64; idx += 256) {
        const int L = idx & 63, f = idx >> 6, it = f >> 2, ks = f & 3, m = L & 31, hh = L >> 5;
        const int j0 = 32 * (ks >> 1) + 16 * (ks & 1) + 4 * hh;
        const uint2 a = *reinterpret_cast<const uint2*>(sat + (it * 32 + m) * 72 + j0);
        const uint2 bq = *reinterpret_cast<const uint2*>(sat + (it * 32 + m) * 72 + j0 + 8);
        reinterpret_cast<uint4*>(fr + FR_AT)[idx] = make_uint4(a.x, a.y, bq.x, bq.y);
      }
      __syncthreads();
    }
  }
}

DI void gdn_scan_chain(const Params& p, char* smem, int chain) {
  const int tid = opaque_tid(), lane = tid & 63, sl = __builtin_amdgcn_readfirstlane(tid >> 6);
  const int d = (chain >> 2) & 1;
  const float* GL = (const float*)(p.ws + WS_GL) + chain * NCH;
  uint4* sfr = reinterpret_cast<uint4*>(smem);
  f32x16 S[4];
#pragma unroll
  for (int kt = 0; kt < 4; ++kt) S[kt] = zero16();
  uint4 pf0, pf1, pf2, pf3, pf4, pf5, pf6, pf7, pf8, pf9, pf10, pf11, pf12, pf13;
  {
    const int n0 = d ? 3 : 0;
    const char* fr = p.ws + WS_FRAGS + (size_t)(chain * NCH + n0) * FRAG_ITEM;
    const uint4* g = reinterpret_cast<const uint4*>(fr) + tid;
    pf0 = g[0 * 256]; pf1 = g[1 * 256]; pf2 = g[2 * 256]; pf3 = g[3 * 256]; pf4 = g[4 * 256]; pf5 = g[5 * 256]; pf6 = g[6 * 256]; pf7 = g[7 * 256]; pf8 = g[8 * 256]; pf9 = g[9 * 256]; pf10 = g[10 * 256]; pf11 = g[11 * 256]; pf12 = g[12 * 256]; pf13 = g[13 * 256];
  }
  for (int step = 0; step < NCH; ++step) {
    const int n = d ? (step < 4 ? 3 - step : 263 - step) : step;
    char* frc = p.ws + WS_FRAGS + (size_t)(chain * NCH + n) * FRAG_ITEM;
    __syncthreads();
    sfr[0 * 256 + tid] = pf0; sfr[1 * 256 + tid] = pf1; sfr[2 * 256 + tid] = pf2; sfr[3 * 256 + tid] = pf3; sfr[4 * 256 + tid] = pf4; sfr[5 * 256 + tid] = pf5; sfr[6 * 256 + tid] = pf6; sfr[7 * 256 + tid] = pf7; sfr[8 * 256 + tid] = pf8; sfr[9 * 256 + tid] = pf9; sfr[10 * 256 + tid] = pf10; sfr[11 * 256 + tid] = pf11; sfr[12 * 256 + tid] = pf12; sfr[13 * 256 + tid] = pf13;
    __syncthreads();
    f32x16 Vn[2], O[2];
    const uint4* fuc = reinterpret_cast<const uint4*>(frc + FR_U) + (size_t)(sl * 128 + lane) * 2;
    const uint4 un0 = fuc[0], un1 = fuc[1], un2 = fuc[128], un3 = fuc[129];
    Vn[0] = zero16(); Vn[1] = zero16();
    O[0] = zero16(); O[1] = zero16();
    {
      const int s1 = step + 1 < NCH ? step + 1 : step;
      const int n1 = d ? (s1 < 4 ? 3 - s1 : 263 - s1) : s1;
      const char* fr = p.ws + WS_FRAGS + (size_t)(chain * NCH + n1) * FRAG_ITEM;
      const uint4* g = reinterpret_cast<const uint4*>(fr) + tid;
      pf0 = g[0 * 256]; pf1 = g[1 * 256]; pf2 = g[2 * 256]; pf3 = g[3 * 256]; pf4 = g[4 * 256]; pf5 = g[5 * 256]; pf6 = g[6 * 256]; pf7 = g[7 * 256]; pf8 = g[8 * 256]; pf9 = g[9 * 256]; pf10 = g[10 * 256]; pf11 = g[11 * 256]; pf12 = g[12 * 256]; pf13 = g[13 * 256];
    }
    const uint4* lw = sfr + lane;
    const uint4* lq = sfr + 1024 + lane;
    const uint4* lk = sfr + 2048 + lane;
    const uint4* la = sfr + 3072 + lane;
#pragma unroll
    for (int ks = 0; ks < 8; ++ks) {
      const bf16x8 sb = pack_step(S[ks >> 1], ks & 1);
#pragma unroll
      for (int mt = 0; mt < 2; ++mt) {
        Vn[mt] = mfma32(__builtin_bit_cast(bf16x8, lw[(mt * 8 + ks) * 64]), sb, Vn[mt]);
        O[mt] = mfma32(__builtin_bit_cast(bf16x8, lq[(mt * 8 + ks) * 64]), sb, O[mt]);
      }
    }
    {
      const uint4 a = un0, b2 = un1;
      Vn[0][0] += bflo(a.x); Vn[0][1] += bfhi(a.x); Vn[0][2] += bflo(a.y); Vn[0][3] += bfhi(a.y);
      Vn[0][4] += bflo(a.z); Vn[0][5] += bfhi(a.z); Vn[0][6] += bflo(a.w); Vn[0][7] += bfhi(a.w);
      Vn[0][8] += bflo(b2.x); Vn[0][9] += bfhi(b2.x); Vn[0][10] += bflo(b2.y); Vn[0][11] += bfhi(b2.y);
      Vn[0][12] += bflo(b2.z); Vn[0][13] += bfhi(b2.z); Vn[0][14] += bflo(b2.w); Vn[0][15] += bfhi(b2.w);
    }
    {
      const uint4 a = un2, b2 = un3;
      Vn[1][0] += bflo(a.x); Vn[1][1] += bfhi(a.x); Vn[1][2] += bflo(a.y); Vn[1][3] += bfhi(a.y);
      Vn[1][4] += bflo(a.z); Vn[1][5] += bfhi(a.z); Vn[1][6] += bflo(a.w); Vn[1][7] += bfhi(a.w);
      Vn[1][8] += bflo(b2.x); Vn[1][9] += bfhi(b2.x); Vn[1][10] += bflo(b2.y); Vn[1][11] += bfhi(b2.y);
      Vn[1][12] += bflo(b2.z); Vn[1][13] += bfhi(b2.z); Vn[1][14] += bflo(b2.w); Vn[1][15] += bfhi(b2.w);
    }
    bf16x8 Vb[2][2];
#pragma unroll
    for (int mt = 0; mt < 2; ++mt) { Vb[mt][0] = pack_step(Vn[mt], 0); Vb[mt][1] = pack_step(Vn[mt], 1); }
#pragma unroll
    for (int it = 0; it < 2; ++it)
#pragma unroll
      for (int ks = 0; ks < 4; ++ks) O[it] = mfma32(__builtin_bit_cast(bf16x8, la[(it * 4 + ks) * 64]), Vb[ks >> 1][ks & 1], O[it]);
    const float gl = GL[n];
#pragma unroll
    for (int kt = 0; kt < 4; ++kt) {
#pragma unroll
      for (int i = 0; i < 16; ++i) S[kt][i] *= gl;
#pragma unroll
      for (int ks = 0; ks < 4; ++ks) S[kt] = mfma32(__builtin_bit_cast(bf16x8, lk[(kt * 4 + ks) * 64]), Vb[ks >> 1][ks & 1], S[kt]);
    }
    uint4* fo = reinterpret_cast<uint4*>(frc + FR_U) + (size_t)(sl * 128 + lane) * 2;
#pragma unroll
    for (int mt = 0; mt < 2; ++mt) {
      fo[mt * 128] = make_uint4(pk2(O[mt][0], O[mt][1]), pk2(O[mt][2], O[mt][3]), pk2(O[mt][4], O[mt][5]), pk2(O[mt][6], O[mt][7]));
      fo[mt * 128 + 1] = make_uint4(pk2(O[mt][8], O[mt][9]), pk2(O[mt][10], O[mt][11]), pk2(O[mt][12], O[mt][13]), pk2(O[mt][14], O[mt][15]));
    }
  }
  __syncthreads();
}

DI void phase_gdn_finish(const Params& p, char* smem) {
  u16* so = (u16*)smem;
  const u16* zb = (const u16*)(p.ws + WS_Z);
  u16* mix = (u16*)(p.ws + WS_MIX);
  const float* on = p.in[I_ONORM];
  const int tid = opaque_tid();
  for (int item = blockIdx.x; item < 2 * NCH * 4; item += gridDim.x) {
    const int h = item & 3, n = (item >> 2) % NCH, b = item / (4 * NCH);
    const int row0 = n < 4 ? b * CTXL + n * 64 : LAT0 + b * SEQ + (n - 4) * 64;
#pragma unroll
    for (int d = 0; d < 2; ++d) {
      const uint4* src = reinterpret_cast<const uint4*>(p.ws + WS_FRAGS + (size_t)(((b * 2 + d) * 4 + h) * NCH + n) * FRAG_ITEM + FR_U);
      uint4* dst = reinterpret_cast<uint4*>(so + d * 8192);
#pragma unroll
      for (int i = 0; i < 4; ++i) dst[tid + 256 * i] = src[tid + 256 * i];
    }
    __syncthreads();
    const int t = tid >> 2, sl = tid & 3;
    float v[32]; float ss = 0.f;
    {
      const int i0 = t, i1 = 63 - t;
      const int mt0 = i0 >> 5, m0 = i0 & 31, hh0 = (m0 >> 2) & 1, rg0 = (m0 & 3) + 4 * (m0 >> 3);
      const int mt1 = i1 >> 5, m1 = i1 & 31, hh1 = (m1 >> 2) & 1, rg1 = (m1 & 3) + 4 * (m1 >> 3);
#pragma unroll
      for (int e = 0; e < 32; ++e) {
        const float a = bf2f(so[((sl * 2 + mt0) * 64 + hh0 * 32 + e) * 16 + rg0]);
        const float c = bf2f(so[8192 + ((sl * 2 + mt1) * 64 + hh1 * 32 + e) * 16 + rg1]);
        v[e] = a + c; ss += v[e] * v[e];
      }
    }
    ss += __shfl_xor(ss, 1); ss += __shfl_xor(ss, 2);
    const float rinv = rsqrtf(ss * (1.f / 128.f) + EPSF);
    const u16* zr = zb + (size_t)(row0 + t) * 512 + h * 128 + sl * 32;
    u16* mr = mix + (size_t)(row0 + t) * 1024 + 512 + h * 128 + sl * 32;
    uint4 zq0 = *reinterpret_cast<const uint4*>(zr), zq1 = *reinterpret_cast<const uint4*>(zr + 8);
    uint4 zq2 = *reinterpret_cast<const uint4*>(zr + 16), zq3 = *reinterpret_cast<const uint4*>(zr + 24);
#pragma unroll
    for (int e8 = 0; e8 < 4; ++e8) {
      const uint4 zz = e8 == 0 ? zq0 : (e8 == 1 ? zq1 : (e8 == 2 ? zq2 : zq3));
      const u32 zw[4] = {zz.x, zz.y, zz.z, zz.w};
      u32 w[4];
#pragma unroll
      for (int q = 0; q < 4; ++q) {
        const int e = e8 * 8 + 2 * q;
        const float o0 = v[e] * rinv * on[sl * 32 + e] * siluf_fast(bflo(zw[q]));
        const float o1 = v[e + 1] * rinv * on[sl * 32 + e + 1] * siluf_fast(bfhi(zw[q]));
        w[q] = pk2(o0, o1);
      }
      *reinterpret_cast<uint4*>(mr + e8 * 8) = make_uint4(w[0], w[1], w[2], w[3]);
    }
    __syncthreads();
  }
}

DI void phase_lru_conv(const Params& p) {
  const u16* ur = (const u16*)(p.ws + WS_UR);
  u16* xc = (u16*)(p.ws + WS_XC);
  const float* cw = p.in[I_OCONVW];
  const float* cb = p.in[I_OCONVB];
  const size_t total = (size_t)MROWS * 128;
  for (size_t idx = (size_t)blockIdx.x * 256 + opaque_tid(); idx < total; idx += (size_t)gridDim.x * 256) {
    const int row = (int)(idx >> 7), c0 = (int)(idx & 127) * 8;
    int pos, slen;
    if (row < LAT0) { pos = row & (CTXL - 1); slen = CTXL; } else { pos = (row - LAT0) & (SEQ - 1); slen = SEQ; }
    float a[8];
#pragma unroll
    for (int e = 0; e < 8; ++e) a[e] = cb[c0 + e];
#pragma unroll
    for (int j = 0; j < 4; ++j) {
      const int pp = pos + j - 2;
      if (pp >= 0 && pp < slen) {
        const uint4 v = *reinterpret_cast<const uint4*>(ur + (size_t)(row + j - 2) * DM + c0);
        const float4 w0 = *reinterpret_cast<const float4*>(cw + j * 1024 + c0);
        const float4 w1 = *reinterpret_cast<const float4*>(cw + j * 1024 + c0 + 4);
        a[0] += w0.x * bflo(v.x); a[1] += w0.y * bfhi(v.x); a[2] += w0.z * bflo(v.y); a[3] += w0.w * bfhi(v.y);
        a[4] += w1.x * bflo(v.z); a[5] += w1.y * bfhi(v.z); a[6] += w1.z * bflo(v.w); a[7] += w1.w * bfhi(v.w);
      }
    }
    *reinterpret_cast<uint4*>(xc + (size_t)row * DM + c0) = make_uint4(pk2(a[0], a[1]), pk2(a[2], a[3]), pk2(a[4], a[5]), pk2(a[6], a[7]));
  }
}

DI int chunk_row0(int b, int n) { return n < 4 ? b * CTXL + n * 64 : LAT0 + b * SEQ + (n - 4) * 64; }
DI void phase_lru_pass1(const Params& p) {
  const u16* ab = (const u16*)(p.ws + WS_AB);
  float* ph = (float*)(p.ws + WS_PH);
  const int total = 2 * 2 * NCH * 512;
  for (int idx = blockIdx.x * 256 + opaque_tid(); idx < total; idx += gridDim.x * 256) {
    const int cp = idx & 511, n = (idx >> 9) % NCH, b = ((idx >> 9) / NCH) & 1, d = (idx >> 9) / (2 * NCH);
    const u16* la = ab + (size_t)d * 2 * MROWS * DM + (size_t)chunk_row0(b, n) * DM + 2 * cp;
    const u16* bb = la + (size_t)MROWS * DM;
    float P0 = 0.f, H0 = 0.f, P1 = 0.f, H1 = 0.f;
#pragma unroll 8
    for (int i = 0; i < 64; ++i) {
      const int t = d ? 63 - i : i;
      const u32 lg = *reinterpret_cast<const u32*>(la + (size_t)t * DM);
      const u32 bv = *reinterpret_cast<const u32*>(bb + (size_t)t * DM);
      const float l0 = bflo(lg), l1 = bfhi(lg);
      H0 = __expf(l0) * H0 + bflo(bv); P0 += l0;
      H1 = __expf(l1) * H1 + bfhi(bv); P1 += l1;
    }
    const size_t o = ((size_t)((d * 2 + b) * NCH + n) * 1024 + 2 * cp) * 2;
    *reinterpret_cast<float4*>(ph + o) = make_float4(P0, H0, P1, H1);
  }
}
DI void phase_lru_pass2(const Params& p) {
  const float2* __restrict__ ph = (const float2*)(p.ws + WS_PH);
  float* __restrict__ cin = (float*)(p.ws + WS_CIN);
  const int total = 2 * 2 * 1024;
  for (int idx = blockIdx.x * 256 + opaque_tid(); idx < total; idx += gridDim.x * 256) {
    const int ch = idx & 1023, b = (idx >> 10) & 1, d = idx >> 11;
    float hcar = 0.f;
    for (int s0 = 0; s0 < NCH; s0 += 20) {
      float2 v[20];
#pragma unroll
      for (int u = 0; u < 20; ++u) {
        const int step = s0 + u;
        const int n = d ? (step < 4 ? 3 - step : 263 - step) : step;
        v[u] = ph[(size_t)((d * 2 + b) * NCH + n) * 1024 + ch];
      }
#pragma unroll
      for (int u = 0; u < 20; ++u) {
        const int step = s0 + u;
        const int n = d ? (step < 4 ? 3 - step : 263 - step) : step;
        cin[(size_t)((d * 2 + b) * NCH + n) * 1024 + ch] = hcar;
        hcar = __expf(v[u].x) * hcar + v[u].y;
      }
    }
  }
}
DI float gelu_tanh(float x) {
  const float u = 0.7978845608028654f * (x + 0.044715f * x * x * x);
  const float t = 1.f - 2.f * __builtin_amdgcn_rcpf(1.f + __expf(2.f * u));
  return 0.5f * x * (1.f + t);
}
DI void phase_lru_pass3(const Params& p) {
  const u16* ab = (const u16*)(p.ws + WS_AB);
  const float* cin = (const float*)(p.ws + WS_CIN);
  u16* ug = (u16*)(p.ws + WS_UG);
  const int total = 2 * 256 * 512;
  for (int idx = blockIdx.x * 256 + opaque_tid(); idx < total; idx += gridDim.x * 256) {
    const int cp = idx & 511, nl = (idx >> 9) & 255, b = idx >> 17, n = nl + 4;
    const size_t rowoff = (size_t)chunk_row0(b, n) * DM + 2 * cp;
    u32 hf[64];
    {
      const u16* la = ab + rowoff;
      const u16* bb = la + (size_t)MROWS * DM;
      const float2 c2 = *reinterpret_cast<const float2*>(cin + (size_t)((0 * 2 + b) * NCH + n) * 1024 + 2 * cp);
      float h0 = c2.x, h1 = c2.y;
#pragma unroll
      for (int i = 0; i < 64; ++i) {
        const u32 lg = *reinterpret_cast<const u32*>(la + (size_t)i * DM);
        const u32 bv = *reinterpret_cast<const u32*>(bb + (size_t)i * DM);
        h0 = __expf(bflo(lg)) * h0 + bflo(bv);
        h1 = __expf(bfhi(lg)) * h1 + bfhi(bv);
        hf[i] = pk2(h0, h1);
      }
    }
    {
      const u16* la = ab + (size_t)2 * MROWS * DM + rowoff;
      const u16* bb = la + (size_t)MROWS * DM;
      const float2 c2 = *reinterpret_cast<const float2*>(cin + (size_t)((1 * 2 + b) * NCH + n) * 1024 + 2 * cp);
      float h0 = c2.x, h1 = c2.y;
      u16* y = ug + ((size_t)(b * SEQ + nl * 64)) * DM + 2 * cp;
#pragma unroll
      for (int g4 = 3; g4 >= 0; --g4) {
        u32 yv[16], lgv[16], bvv[16];
#pragma unroll
        for (int i = 0; i < 16; ++i) {
          yv[i] = *reinterpret_cast<const u32*>(y + (size_t)(g4 * 16 + i) * DM);
          lgv[i] = *reinterpret_cast<const u32*>(la + (size_t)(g4 * 16 + i) * DM);
          bvv[i] = *reinterpret_cast<const u32*>(bb + (size_t)(g4 * 16 + i) * DM);
        }
#pragma unroll
        for (int i = 15; i >= 0; --i) {
          h0 = __expf(bflo(lgv[i])) * h0 + bflo(bvv[i]);
          h1 = __expf(bfhi(lgv[i])) * h1 + bfhi(bvv[i]);
          const u32 f = hf[g4 * 16 + i];
          *reinterpret_cast<u32*>(y + (size_t)(g4 * 16 + i) * DM) =
              pk2(gelu_tanh(bflo(yv[i])) * (bflo(f) + h0), gelu_tanh(bfhi(yv[i])) * (bfhi(f) + h1));
        }
      }
    }
  }
}
#define XB_TMO      128
#define XB_XCNT(j)  (256  + 64 * (j))
#define XB_XSUB(j)  (1280 + 64 * (j))
#define XB_XGEN(j)  (2304 + 64 * (j))
#define XB_TOP      3328
#define XB_TOPGEN   3392
#define XCD_BAR_WORDS 3456
#define XB_SPIN_CAP (1u << 18)
#define LAS __attribute__((address_space(3)))

__device__ __forceinline__ unsigned xb_ld(unsigned* p)              { return __hip_atomic_load(p, __ATOMIC_RELAXED, __HIP_MEMORY_SCOPE_AGENT); }
__device__ __forceinline__ unsigned xb_add(unsigned* p, unsigned v) { return __hip_atomic_fetch_add(p, v, __ATOMIC_RELAXED, __HIP_MEMORY_SCOPE_AGENT); }
__device__ __forceinline__ unsigned xb_xcc_id() { return (unsigned)__builtin_amdgcn_s_getreg((3 << 11) | 20) & 0xFu; }
#define XB_SPIN(cond, bar) do { unsigned _sp = 0; while (cond) { __builtin_amdgcn_s_sleep(1); \
    if ((++_sp & 255u) == 0u) { if (xb_ld(&(bar)[XB_TMO])) break; if (_sp > XB_SPIN_CAP) { atomicAdd(&(bar)[XB_TMO], 1u); break; } } } } while (0)

struct XcdBarrier {
    unsigned* bar; unsigned x;
    volatile LAS unsigned* st;
};

__device__ __forceinline__ XcdBarrier xcd_barrier_post(unsigned* bar, volatile LAS unsigned* st) {
    XcdBarrier b; b.bar = bar; b.x = xb_xcc_id(); b.st = st;
    if (threadIdx.x == 0) (void)xb_add(&bar[XB_XCNT(b.x)], 1u);
    return b;
}
__device__ __forceinline__ void xcd_barrier_complete(unsigned* bar, unsigned x, unsigned& nloc, unsigned& nx) {
    const unsigned G = gridDim.x * gridDim.y * gridDim.z;
    unsigned sum, cnt, mine, sp = 0u;
    for (;;) {
        sum = 0u; cnt = 0u; mine = 0u;
#pragma unroll
        for (unsigned j = 0; j < 16; ++j) { const unsigned c = xb_ld(&bar[XB_XCNT(j)]); sum += c; cnt += (c > 0u) ? 1u : 0u; mine = (j == x) ? c : mine; }
        if (sum == G) break;
        __builtin_amdgcn_s_sleep(1);
        if ((++sp & 255u) == 0u) { if (xb_ld(&bar[XB_TMO])) break; if (sp > XB_SPIN_CAP) { atomicAdd(&bar[XB_TMO], 1u); break; } }
    }
    nloc = mine > 0u ? mine : 1u; nx = cnt > 0u ? cnt : 1u;
}

__device__ __forceinline__ void xcd_barrier(const XcdBarrier& b) {
    asm volatile("s_waitcnt vmcnt(0)" ::: "memory");
    __syncthreads();
    if (opaque_tid() == 0) {
        unsigned* bar = b.bar;
        __builtin_amdgcn_s_waitcnt(0);
        unsigned nloc = b.st[0], nx = b.st[1];
        if (nloc == 0u) { xcd_barrier_complete(bar, b.x, nloc, nx); b.st[0] = nloc; b.st[1] = nx; }
        const unsigned old = xb_add(&bar[XB_XSUB(b.x)], 1u);
        const unsigned gen = old / nloc;
        if (old + 1u == (gen + 1u) * nloc) {
            __builtin_amdgcn_fence(__ATOMIC_RELEASE, "agent");
            asm volatile("s_waitcnt vmcnt(0)" ::: "memory");
            const unsigned og = xb_add(&bar[XB_TOP], 1u);
            const unsigned tg = og / nx;
            if (og + 1u == (tg + 1u) * nx) xb_add(&bar[XB_TOPGEN], 1u);
            else XB_SPIN(xb_ld(&bar[XB_TOPGEN]) == tg, bar);
            __builtin_amdgcn_fence(__ATOMIC_ACQUIRE, "agent");
            xb_add(&bar[XB_XGEN(b.x)], 1u);
            asm volatile("s_waitcnt vmcnt(0)" ::: "memory");
        } else {
            XB_SPIN(xb_ld(&bar[XB_XGEN(b.x)]) == gen, bar);
            __builtin_amdgcn_fence(__ATOMIC_ACQUIRE, "agent");
            asm volatile("s_waitcnt vmcnt(0)" ::: "memory");
        }
    }
    __syncthreads();
}


template <int PH>
DI void run_phase(const Params& p, char* smem) {
  char* ws = p.ws;
  const float* MOD = (const float*)(ws + WS_MOD);
  float* HC = (float*)(ws + WS_HCTX);
  if constexpr (PH == 0) { phase_convert(p, smem); phase_mod(p, smem); }
  else if constexpr (PH == 1) phase_modulate(p.in[I_CTX], p.in[I_X], p.in[I_EN1], MOD, 0, 0, (u16*)(ws + WS_A));
  else if constexpr (PH == 2) {
    EpiIn0 e{(u16*)((char*)p.out + DO_QK), (u16*)(ws + WS_VRAW), (u16*)(ws + WS_U0G), (u16*)(ws + WS_Z), (float*)(ws + WS_G0)};
    gemm_phase4((const u16*)(ws + WS_A), 1024, (const u16*)(ws + WS_WT0IN), 1024, 1024, 0, 130, 29, smem, e);
  }
  else if constexpr (PH == 3) phase_da_prep(p, smem);
  else if constexpr (PH == 4) phase_gdn_prep(p, smem);
  else if constexpr (PH == 5) { }
  else if constexpr (PH == 6) { if (blockIdx.x < 16) gdn_scan_chain(p, smem, blockIdx.x); phase_da_attn(p, smem); }
  else if constexpr (PH == 7) phase_gdn_finish(p, smem);
  else if constexpr (PH == 8) {
    EpiResid e{p.in[I_CTX], p.in[I_X], HC, p.out, MOD + 2 * 1024};
    gemm_phase((const u16*)(ws + WS_MIX), 1024, (const u16*)(ws + WS_WT0OUT), 1024, 1024, 0, 260, 8, 1 << 20, smem, e);
  }
  else if constexpr (PH == 9) phase_modulate(HC, p.out, p.in[I_EN2], MOD, 3, 0, (u16*)(ws + WS_A));
  else if constexpr (PH == 10) {
    EpiSwiglu e{(u16*)(ws + WS_ACT)};
    gemm_phase4((const u16*)(ws + WS_A), 1024, (const u16*)(ws + WS_WT0GU), 1024, 1024, 0, 130, 44, smem, e);
  }
  else if constexpr (PH == 11) {
    EpiResid e{HC, p.out, HC, p.out, MOD + 5 * 1024};
    gemm_phase((const u16*)(ws + WS_ACT), FFH, (const u16*)(ws + WS_WT0DN), FFH, FFH, 0, 260, 8, 1 << 20, smem, e);
  }
  else if constexpr (PH == 12) phase_modulate(HC, p.out, p.in[I_ON1], MOD + 3 * 6144, 0, 0, (u16*)(ws + WS_A));
  else if constexpr (PH == 13) {
    EpiIn1 e{(u16*)(ws + WS_UG), (u16*)(ws + WS_UR)};
    gemm_phase4((const u16*)(ws + WS_A), 1024, (const u16*)(ws + WS_WT1IN), 1024, 1024, 0, 130, 16, smem, e);
  }
  else if constexpr (PH == 14) phase_lru_conv(p);
  else if constexpr (PH == 15) {
    EpiGates e{(const u16*)(ws + WS_XC), (u16*)(ws + WS_AB), p.in[I_OBR], p.in[I_OBI], p.in[I_OLAM]};
    gemm_phase((const u16*)(ws + WS_XC), 1024, (const u16*)(ws + WS_WT1G), 128, 128, 0, 260, 32, 4, smem, e);
  }
  else if constexpr (PH == 16) phase_lru_pass1(p);
  else if constexpr (PH == 17) phase_lru_pass2(p);
  else if constexpr (PH == 18) phase_lru_pass3(p);
  else if constexpr (PH == 19) {
    EpiResid e{nullptr, p.out, nullptr, p.out, MOD + 3 * 6144 + 2 * 1024};
    gemm_phase((const u16*)(ws + WS_UG) - (size_t)LAT0 * DM, 1024, (const u16*)(ws + WS_WT1OUT), 1024, 1024, 4, 256, 8, 1 << 20, smem, e);
  }
  else if constexpr (PH == 20) phase_modulate(HC, p.out, p.in[I_ON2], MOD + 3 * 6144, 3, LAT0, (u16*)(ws + WS_A));
  else if constexpr (PH == 21) {
    EpiSwiglu e{(u16*)(ws + WS_ACT)};
    gemm_phase4((const u16*)(ws + WS_A), 1024, (const u16*)(ws + WS_WT1GU), 1024, 1024, 2, 128, 44, smem, e);
  }
  else if constexpr (PH == 22) {
    EpiResid e{nullptr, p.out, nullptr, p.out, MOD + 3 * 6144 + 5 * 1024};
    gemm_phase((const u16*)(ws + WS_ACT), FFH, (const u16*)(ws + WS_WT1DN), FFH, FFH, 4, 256, 8, 1 << 20, smem, e);
  }
}
constexpr int NPHASE = 23;

#if MULTI_LAUNCH
template <int PH>
__global__ void __launch_bounds__(256, 2) phase_kernel(Params p) {
  __shared__ __attribute__((aligned(16))) char smem[SMEM_BYTES];
  run_phase<PH>(p, smem);
}
template <int PH>
static void launch_all(const Params& p, int grid, hipStream_t stream) {
  if constexpr (PH < NPHASE) {
    hipLaunchKernelGGL(phase_kernel<PH>, dim3(grid), dim3(256), 0, stream, p);
    launch_all<PH + 1>(p, grid, stream);
  }
}
#else
template <int PH>
DI void run_all(const Params& p, char* smem, cg::grid_group& grid, const XcdBarrier& xb) {
  if constexpr (PH < NPHASE) {
    run_phase<PH>(p, smem);
    if constexpr (PH == PROBE_DUP || PH == PROBE_DUP2) { xcd_barrier(xb); run_phase<PH>(p, smem); }
    if constexpr (PH == 0) grid.sync();
    else if constexpr (PH + 1 < NPHASE && PH != 5) xcd_barrier(xb);
    run_all<PH + 1>(p, smem, grid, xb);
  }
}
__global__ void __launch_bounds__(256, 2) mega_kernel(Params p) {
  __shared__ __attribute__((aligned(16))) char smem[SMEM_BYTES];
  __shared__ uint4 xb_words;
  if (threadIdx.x == 0) xb_words = make_uint4(0u, 0u, 0u, 0u);
  if ((threadIdx.x & 63) == 0) g_wtab[hw_wave_slot()] = threadIdx.x >> 6;
  __syncthreads();
  cg::grid_group grid = cg::this_grid();
  XcdBarrier xb = xcd_barrier_post((unsigned*)(p.ws + WS_BAR), (volatile LAS unsigned*)&xb_words);
  for (int i = 0; i < PROBE_SYNCS; ++i) xcd_barrier(xb);
  run_all<0>(p, smem, grid, xb);
}
#endif

extern "C" void kernel_launch(void* const* d_in, const int* in_sizes, int n_in, void* d_out, int out_size, void* d_ws, size_t ws_size,
                              hipStream_t stream) {
  if (n_in != 38 || ws_size < WS_NEED || out_size != 2 * SEQ * DM) {
    fprintf(stderr, "kernel_launch: unexpected shapes (n_in %d, ws %zu, out %d)\n", n_in, ws_size, out_size);
    return;
  }
  Params p{};
  for (int i = 0; i < 38; ++i) p.in[i] = (const float*)d_in[i];
  p.out = (float*)d_out;
  p.ws = (char*)d_ws;
#if MULTI_LAUNCH
  launch_all<0>(p, 512, stream);
#else
  static int grid_blocks = 0;
  if (!grid_blocks) {
    int dev = 0, cus = 0, per_cu = 0;
    hipGetDevice(&dev);
    hipDeviceGetAttribute(&cus, hipDeviceAttributeMultiprocessorCount, dev);
    hipOccupancyMaxActiveBlocksPerMultiprocessor(&per_cu, mega_kernel, 256, 0);
    if (per_cu < 1) per_cu = 1;
    if (per_cu > 2) per_cu = 2;
    grid_blocks = cus * per_cu;
  }
  (void)hipMemsetAsync((char*)d_ws + WS_CNT, 0, 65536 + XCD_BAR_WORDS * 4, stream);
  void* args[] = {&p};
  hipError_t e = hipLaunchCooperativeKernel((void*)mega_kernel, dim3(grid_blocks), dim3(256), args, 0, stream);
  if (e != hipSuccess) fprintf(stderr, "cooperative launch failed: %s (grid %d)\n", hipGetErrorString(e), grid_blocks);
#endif
}
```

```cpp
#include <hip/hip_runtime.h>
#include <hip/hip_cooperative_groups.h>
#include <cstdio>
namespace cg = cooperative_groups;

#ifndef MULTI_LAUNCH
#define MULTI_LAUNCH 0
#endif
#ifndef PROBE_DUP
#define PROBE_DUP -1
#define PROBE_DUP2 -1
#define PROBE_SYNCS 0
#endif

#define DI __device__ __forceinline__
typedef unsigned short u16;
typedef unsigned int u32;
using bf16x8 = __attribute__((ext_vector_type(8))) short;
using f32x16 = __attribute__((ext_vector_type(16))) float;
typedef __bf16 bf2_t __attribute__((ext_vector_type(2)));
typedef float f2_t __attribute__((ext_vector_type(2)));

constexpr int SEQ = 16384, CTXL = 256, DM = 1024, MROWS = 33280, LAT0 = 512;
constexpr int SK = 16640;
constexpr int FFH = 2816;
constexpr int NCH = 260;
constexpr float EPSF = 1e-6f;

constexpr size_t MiB = 1048576;
constexpr size_t WS_WT0IN = 0, WS_WT0OUT = 8 * MiB, WS_WT0GU = 10 * MiB, WS_WT0DN = 21 * MiB;
constexpr size_t WS_WT1IN = 27 * MiB, WS_WT1G = 31 * MiB, WS_WT1OUT = 32 * MiB, WS_WT1GU = 34 * MiB, WS_WT1DN = 45 * MiB;
constexpr size_t WS_MOD = 51 * MiB, WS_G0 = 52 * MiB, WS_HCTX = 55 * MiB, WS_GL = 57 * MiB, WS_PH = 58 * MiB;
constexpr size_t WS_CNT = 67 * MiB;
constexpr size_t WS_BAR = 67 * MiB + 65536;
constexpr size_t WS_BIG = 68 * MiB;
constexpr size_t WS_FRAGS = WS_BIG;
constexpr size_t WS_A = WS_BIG;
constexpr size_t WS_VRAW = WS_BIG + 65 * MiB;
constexpr size_t WS_ACT = WS_BIG + 65 * MiB;
constexpr size_t WS_U0G = 361 * MiB;
constexpr size_t WS_MIX = 361 * MiB;
constexpr size_t WS_Z = 459 * MiB;
constexpr size_t WS_UR = WS_BIG + 65 * MiB;
constexpr size_t WS_AB = WS_BIG;
constexpr size_t WS_XC = 328 * MiB;
constexpr size_t WS_UG = 393 * MiB;
constexpr size_t WS_CIN = 459 * MiB;
constexpr size_t WS_NEED = 512 * MiB;
constexpr size_t FRAG_ITEM = 73728;
constexpr size_t FR_W = 0, FR_Q = 16384, FR_KT = 32768, FR_AT = 49152, FR_U = 57344;
constexpr size_t DO_QK = 0, DO_VT = 65 * MiB;

struct Params {
  const float* in[38];
  float* out;
  char* ws;
};
enum { I_X = 0, I_C, I_CTX, I_CCTX, I_EN1, I_EN2, I_EADAW, I_EADAB, I_EWIN, I_EWOUT, I_QN, I_KN, I_LQ1, I_LK1, I_LQ2, I_LK2,
       I_SUBN, I_GCONV, I_ALOG, I_DTB, I_ONORM, I_EWGU, I_EWDN, I_ON1, I_ON2, I_OADAW, I_OADAB, I_OWIN, I_OCONVW, I_OCONVB,
       I_OWR, I_OBR, I_OWI, I_OBI, I_OLAM, I_OWOUT, I_OWGU, I_OWDN };

DI u32 pk2(float a, float b) { f2_t v = {a, b}; bf2_t r = __builtin_convertvector(v, bf2_t); return __builtin_bit_cast(u32, r); }
DI u16 f2bf(float a) { return (u16)(pk2(a, 0.f) & 0xffffu); }
DI float bf2f(u16 v) { return __uint_as_float(((u32)v) << 16); }
DI float bflo(u32 v) { return __uint_as_float(v << 16); }
DI float bfhi(u32 v) { return __uint_as_float(v & 0xffff0000u); }
DI int crow(int reg, int h) { return (reg & 3) + 8 * (reg >> 2) + 4 * h; }
DI int krow(int s, int h, int j) { return 16 * s + 8 * (j >> 2) + 4 * h + (j & 3); }
DI float sigmoidf_(float x) { return 1.f / (1.f + __expf(-x)); }
DI float siluf_(float x) { return x / (1.f + __expf(-x)); }
DI float siluf_fast(float x) { return x * __builtin_amdgcn_rcpf(1.f + __expf(-x)); }
DI float sigmoidf_fast(float x) { return __builtin_amdgcn_rcpf(1.f + __expf(-x)); }
DI float softplusf_(float x) { return x > 20.f ? x : log1pf(__expf(x)); }
DI float wave_sum(float v) {
#pragma unroll
  for (int o = 32; o >= 1; o >>= 1) v += __shfl_xor(v, o);
  return v;
}
DI f32x16 mfma32(bf16x8 a, bf16x8 b, f32x16 c) { return __builtin_amdgcn_mfma_f32_32x32x16_bf16(a, b, c, 0, 0, 0); }
DI bf16x8 ld8(const u16* p) { return *reinterpret_cast<const bf16x8*>(p); }
DI bf16x8 pack_step(const f32x16& x, int s) {
  uint4 r;
  r.x = pk2(x[8 * s + 0], x[8 * s + 1]); r.y = pk2(x[8 * s + 2], x[8 * s + 3]);
  r.z = pk2(x[8 * s + 4], x[8 * s + 5]); r.w = pk2(x[8 * s + 6], x[8 * s + 7]);
  return __builtin_bit_cast(bf16x8, r);
}
DI int row_cond(int row) { return row < LAT0 ? 2 : ((row - LAT0) >> 14); }
DI f32x16 zero16() { f32x16 z; for (int i = 0; i < 16; ++i) z[i] = 0.f; return z; }

__shared__ int g_wtab[64];
DI int hw_wave_slot() { return (int)((unsigned)__builtin_amdgcn_s_getreg((5 << 11) | 4) & 63u); }
DI int opaque_tid() {
  const int w = __builtin_amdgcn_readfirstlane(g_wtab[hw_wave_slot()]);
  int t = w * 64 + (int)__builtin_amdgcn_mbcnt_hi(~0u, __builtin_amdgcn_mbcnt_lo(~0u, 0u));
  asm volatile("" : "+v"(t));
  return t;
}
constexpr int SMEM_BYTES = 77824;

template <class RowFn>
DI void convert_weight(u16* dst, int nrows, int K, RowFn rowfn, char* smem, int& job_base, int njobs_total) {
  float* tile = (float*)smem;
  const int ktiles = K / 64, rtiles = nrows / 64, ntile = ktiles * rtiles;
  const int tid = opaque_tid();
  int first = blockIdx.x - (job_base % gridDim.x);
  if (first < 0) first += gridDim.x;
  for (int t = first; t < ntile; t += gridDim.x) {
    const int rt = t / ktiles, kt = t % ktiles;
    const int tx = tid & 63, ty = tid >> 6;
    int ld = 0;
    const float* src = rowfn(rt * 64 + tx, ld);
#pragma unroll 4
    for (int i = 0; i < 16; ++i) {
      const int k = ty + 4 * i;
      tile[k * 65 + tx] = src ? src[(size_t)(kt * 64 + k) * ld] : 0.f;
    }
    __syncthreads();
    const int r = tid >> 2, kq = (tid & 3) * 16;
    u32 w[8];
#pragma unroll
    for (int i = 0; i < 8; ++i) w[i] = pk2(tile[(kq + 2 * i) * 65 + r], tile[(kq + 2 * i + 1) * 65 + r]);
    uint4* d = reinterpret_cast<uint4*>(dst + (size_t)(rt * 64 + r) * K + kt * 64 + kq);
    d[0] = make_uint4(w[0], w[1], w[2], w[3]);
    d[1] = make_uint4(w[4], w[5], w[6], w[7]);
    __syncthreads();
  }
  job_base += ntile;
}

DI void phase_convert(const Params& p, char* smem) {
  int jb = 0;
  u16* ws16 = (u16*)p.ws;
  {
    const float* w = p.in[I_EWIN];
    convert_weight((u16*)(p.ws + WS_WT0IN), 3712, 1024, [=](int n, int& ld) { ld = 3600; return n < 3600 ? w + n : (const float*)nullptr; }, smem, jb, 0);
  }
  {
    const float* w = p.in[I_EWOUT];
    convert_weight((u16*)(p.ws + WS_WT0OUT), 1024, 1024, [=](int n, int& ld) { ld = 1024; return w + n; }, smem, jb, 0);
  }
  auto gu_row = [](const float* w, int n, int& ld) {
    ld = 2 * FFH;
    const int j = n >> 7, wq = n & 127, wn = wq >> 6, sub = (wq & 63) >> 5, c = wq & 31;
    const int hid = 64 * j + 32 * wn + c;
    return w + (sub ? FFH + hid : hid);
  };
  {
    const float* w = p.in[I_EWGU];
    convert_weight((u16*)(p.ws + WS_WT0GU), 2 * FFH, 1024, [=](int n, int& ld) { return gu_row(w, n, ld); }, smem, jb, 0);
  }
  {
    const float* w = p.in[I_EWDN];
    convert_weight((u16*)(p.ws + WS_WT0DN), 1024, FFH, [=](int n, int& ld) { ld = 1024; return w + n; }, smem, jb, 0);
  }
  {
    const float* w = p.in[I_OWIN];
    convert_weight((u16*)(p.ws + WS_WT1IN), 2048, 1024, [=](int n, int& ld) { ld = 2048; return w + n; }, smem, jb, 0);
  }
  {
    const float* wr = p.in[I_OWR];
    const float* wi = p.in[I_OWI];
    convert_weight((u16*)(p.ws + WS_WT1G), 4096, 128, [=](int n, int& ld) {
      ld = 128;
      const int kb = n >> 9, w512 = n & 511, jt = w512 >> 7, z = jt >> 1, half = jt & 1;
      const int wq = w512 & 127, wn = wq >> 6, sub = (wq & 63) >> 5, c = wq & 31;
      const int dch = half * 64 + wn * 32 + c;
      return (sub ? wi : wr) + (size_t)(z * 8 + kb) * 16384 + dch;
    }, smem, jb, 0);
  }
  {
    const float* w = p.in[I_OWOUT];
    convert_weight((u16*)(p.ws + WS_WT1OUT), 1024, 1024, [=](int n, int& ld) { ld = 1024; return w + n; }, smem, jb, 0);
  }
  {
    const float* w = p.in[I_OWGU];
    convert_weight((u16*)(p.ws + WS_WT1GU), 2 * FFH, 1024, [=](int n, int& ld) { return gu_row(w, n, ld); }, smem, jb, 0);
  }
  {
    const float* w = p.in[I_OWDN];
    convert_weight((u16*)(p.ws + WS_WT1DN), 1024, FFH, [=](int n, int& ld) { ld = 1024; return w + n; }, smem, jb, 0);
  }
  (void)ws16;
}

DI void phase_mod(const Params& p, char* smem) {
  float* sc = (float*)smem;
  float* part = sc + 3 * 1024;
  const int tid = opaque_tid();
  bool loaded = false;
  for (int item = blockIdx.x; item < 192; item += gridDim.x) {
    if (!loaded) {
      for (int i = tid; i < 3072; i += 256) {
        const int cnd = i >> 10, k = i & 1023;
        const float v = cnd < 2 ? p.in[I_C][cnd * 1024 + k] : p.in[I_CCTX][k];
        sc[i] = siluf_(v);
      }
      loaded = true;
      __syncthreads();
    }
    const int l = item / 96, cgp = item % 96;
    const float* W = p.in[l ? I_OADAW : I_EADAW];
    const float* Bv = p.in[l ? I_OADAB : I_EADAB];
    const int col = cgp * 64 + (tid & 63), kq = tid >> 6;
    float a0 = 0.f, a1 = 0.f, a2 = 0.f;
#pragma unroll 8
    for (int k = kq * 256; k < kq * 256 + 256; ++k) {
      const float w = W[(size_t)k * 6144 + col];
      a0 += sc[k] * w; a1 += sc[1024 + k] * w; a2 += sc[2048 + k] * w;
    }
    part[(kq * 3 + 0) * 64 + (tid & 63)] = a0;
    part[(kq * 3 + 1) * 64 + (tid & 63)] = a1;
    part[(kq * 3 + 2) * 64 + (tid & 63)] = a2;
    __syncthreads();
    if (tid < 192) {
      const int cnd = tid >> 6, c = tid & 63;
      float s = Bv[cgp * 64 + c];
      for (int q = 0; q < 4; ++q) s += part[(q * 3 + cnd) * 64 + c];
      ((float*)(p.ws + WS_MOD))[(size_t)(l * 3 + cnd) * 6144 + cgp * 64 + c] = s;
    }
    __syncthreads();
  }
}

DI void phase_modulate(const float* hc, const float* hx, const float* gain, const float* mod, int shift_idx, int row_lo, u16* Aout) {
  const int tid0 = opaque_tid();
  const int lane = tid0 & 63, wid = tid0 >> 6;
  const int nw = gridDim.x * 4;
  for (int rowA = row_lo + blockIdx.x * 4 + wid; rowA < MROWS; rowA += 2 * nw) {
    const int rowB = rowA + nw;
    const bool hasB = rowB < MROWS;
    const int rB = hasB ? rowB : rowA;
    const float* srcA = rowA < LAT0 ? hc + (size_t)rowA * DM : hx + (size_t)(rowA - LAT0) * DM;
    const float* srcB = rB < LAT0 ? hc + (size_t)rB * DM : hx + (size_t)(rB - LAT0) * DM;
    float4 va[4], vb[4];
#pragma unroll
    for (int i = 0; i < 4; ++i) {
      va[i] = *reinterpret_cast<const float4*>(srcA + (i * 64 + lane) * 4);
      vb[i] = *reinterpret_cast<const float4*>(srcB + (i * 64 + lane) * 4);
    }
    float sa = 0.f, sb = 0.f;
#pragma unroll
    for (int i = 0; i < 4; ++i) {
      sa += va[i].x * va[i].x + va[i].y * va[i].y + va[i].z * va[i].z + va[i].w * va[i].w;
      sb += vb[i].x * vb[i].x + vb[i].y * vb[i].y + vb[i].z * vb[i].z + vb[i].w * vb[i].w;
    }
    sa = wave_sum(sa); sb = wave_sum(sb);
    const float ra = rsqrtf(sa * (1.f / 1024.f) + EPSF), rb = rsqrtf(sb * (1.f / 1024.f) + EPSF);
    const float* shA = mod + (size_t)row_cond(rowA) * 6144 + shift_idx * 1024;
    const float* shB = mod + (size_t)row_cond(rB) * 6144 + shift_idx * 1024;
    uint2 oa[4], ob[4];
#pragma unroll
    for (int i = 0; i < 4; ++i) {
      const int c = (i * 64 + lane) * 4;
      const float4 g = *reinterpret_cast<const float4*>(gain + c);
      const float4 s1 = *reinterpret_cast<const float4*>(shA + c), c1 = *reinterpret_cast<const float4*>(shA + 1024 + c);
      const float4 s2 = *reinterpret_cast<const float4*>(shB + c), c2 = *reinterpret_cast<const float4*>(shB + 1024 + c);
      oa[i] = make_uint2(pk2(va[i].x * ra * g.x * (1.f + c1.x) + s1.x, va[i].y * ra * g.y * (1.f + c1.y) + s1.y),
                         pk2(va[i].z * ra * g.z * (1.f + c1.z) + s1.z, va[i].w * ra * g.w * (1.f + c1.w) + s1.w));
      ob[i] = make_uint2(pk2(vb[i].x * rb * g.x * (1.f + c2.x) + s2.x, vb[i].y * rb * g.y * (1.f + c2.y) + s2.y),
                         pk2(vb[i].z * rb * g.z * (1.f + c2.z) + s2.z, vb[i].w * rb * g.w * (1.f + c2.w) + s2.w));
    }
#pragma unroll
    for (int i = 0; i < 4; ++i) {
      const int c = (i * 64 + lane) * 4;
      *reinterpret_cast<uint2*>(Aout + (size_t)rowA * DM + c) = oa[i];
      if (hasB) *reinterpret_cast<uint2*>(Aout + (size_t)rowB * DM + c) = ob[i];
    }
  }
}

constexpr int LDT = 72;
template <class Epi>
DI void gemm_phase(const u16* __restrict__ A, int lda, const u16* __restrict__ Bt, int ldb, int K, int mt_lo, int mtiles, int ntiles,
                   int nt_per_group, char* smem, Epi epi) {
  u16* sA = (u16*)smem;
  u16* sB = sA + 2 * 128 * LDT;
  const int tid = opaque_tid(), lane = tid & 63, wid = __builtin_amdgcn_readfirstlane(tid >> 6), wm = wid >> 1, wn = wid & 1;
  const int lr = lane & 31, lh = lane >> 5;
  const int ldrow = tid >> 3, ldc = (tid & 7) * 8;
  const int nk = K / 64;
  const int total = mtiles * ntiles;
  const int per_xcd = (total + 7) >> 3;
  const int xcd = blockIdx.x & 7, qx = blockIdx.x >> 3, nq = gridDim.x >> 3;
  for (int v = qx; v < per_xcd; v += nq) {
    const int u = xcd * per_xcd + v;
    if (u >= total) break;
    const int gsz_full = 8 * ntiles;
    const int g = u / gsz_full, r = u - g * gsz_full;
    const int gm = min(8, mtiles - g * 8);
    const int mt = mt_lo + g * 8 + r % gm, nt = r / gm;
    const unsigned oA = (unsigned)(((mt * 128 + ldrow) * lda + (nt / nt_per_group) * K + ldc) * 2);
    const unsigned oB = (unsigned)(((nt * 128 + ldrow) * ldb + ldc) * 2);
    const char* Ab = (const char*)A;
    const char* Bb = (const char*)Bt;
    f32x16 acc[2][2];
    acc[0][0] = zero16(); acc[0][1] = zero16(); acc[1][0] = zero16(); acc[1][1] = zero16();
    uint4 xa0, xa1, xa2, xa3, xb0, xb1, xb2, xb3, ya0, ya1, ya2, ya3, yb0, yb1, yb2, yb3;
#define G_LOADX(KT) do { const unsigned ka_ = oA + (unsigned)(KT) * 128u, kb_ = oB + (unsigned)(KT) * 128u; \
      xa0 = *reinterpret_cast<const uint4*>(Ab + (ka_ + 0u * (unsigned)lda * 2u)); \
      xa1 = *reinterpret_cast<const uint4*>(Ab + (ka_ + 32u * (unsigned)lda * 2u)); \
      xa2 = *reinterpret_cast<const uint4*>(Ab + (ka_ + 64u * (unsigned)lda * 2u)); \
      xa3 = *reinterpret_cast<const uint4*>(Ab + (ka_ + 96u * (unsigned)lda * 2u)); \
      xb0 = *reinterpret_cast<const uint4*>(Bb + (kb_ + 0u * (unsigned)ldb * 2u)); \
      xb1 = *reinterpret_cast<const uint4*>(Bb + (kb_ + 32u * (unsigned)ldb * 2u)); \
      xb2 = *reinterpret_cast<const uint4*>(Bb + (kb_ + 64u * (unsigned)ldb * 2u)); \
      xb3 = *reinterpret_cast<const uint4*>(Bb + (kb_ + 96u * (unsigned)ldb * 2u)); } while (0)
#define G_LOADY(KT) do { const unsigned ka_ = oA + (unsigned)(KT) * 128u, kb_ = oB + (unsigned)(KT) * 128u; \
      ya0 = *reinterpret_cast<const uint4*>(Ab + (ka_ + 0u * (unsigned)lda * 2u)); \
      ya1 = *reinterpret_cast<const uint4*>(Ab + (ka_ + 32u * (unsigned)lda * 2u)); \
      ya2 = *reinterpret_cast<const uint4*>(Ab + (ka_ + 64u * (unsigned)lda * 2u)); \
      ya3 = *reinterpret_cast<const uint4*>(Ab + (ka_ + 96u * (unsigned)lda * 2u)); \
      yb0 = *reinterpret_cast<const uint4*>(Bb + (kb_ + 0u * (unsigned)ldb * 2u)); \
      yb1 = *reinterpret_cast<const uint4*>(Bb + (kb_ + 32u * (unsigned)ldb * 2u)); \
      yb2 = *reinterpret_cast<const uint4*>(Bb + (kb_ + 64u * (unsigned)ldb * 2u)); \
      yb3 = *reinterpret_cast<const uint4*>(Bb + (kb_ + 96u * (unsigned)ldb * 2u)); } while (0)
#define G_STOREX(BUF) do { u16* wa_ = sA + (BUF) * 128 * LDT + ldrow * LDT + ldc; u16* wb_ = sB + (BUF) * 128 * LDT + ldrow * LDT + ldc; \
      *reinterpret_cast<uint4*>(wa_) = xa0; *reinterpret_cast<uint4*>(wa_ + 32 * LDT) = xa1; \
      *reinterpret_cast<uint4*>(wa_ + 64 * LDT) = xa2; *reinterpret_cast<uint4*>(wa_ + 96 * LDT) = xa3; \
      *reinterpret_cast<uint4*>(wb_) = xb0; *reinterpret_cast<uint4*>(wb_ + 32 * LDT) = xb1; \
      *reinterpret_cast<uint4*>(wb_ + 64 * LDT) = xb2; *reinterpret_cast<uint4*>(wb_ + 96 * LDT) = xb3; } while (0)
#define G_STOREY(BUF) do { u16* wa_ = sA + (BUF) * 128 * LDT + ldrow * LDT + ldc; u16* wb_ = sB + (BUF) * 128 * LDT + ldrow * LDT + ldc; \
      *reinterpret_cast<uint4*>(wa_) = ya0; *reinterpret_cast<uint4*>(wa_ + 32 * LDT) = ya1; \
      *reinterpret_cast<uint4*>(wa_ + 64 * LDT) = ya2; *reinterpret_cast<uint4*>(wa_ + 96 * LDT) = ya3; \
      *reinterpret_cast<uint4*>(wb_) = yb0; *reinterpret_cast<uint4*>(wb_ + 32 * LDT) = yb1; \
      *reinterpret_cast<uint4*>(wb_ + 64 * LDT) = yb2; *reinterpret_cast<uint4*>(wb_ + 96 * LDT) = yb3; } while (0)
#define G_COMPUTE(BUF) do { \
      const u16* a_ = sA + (BUF) * 128 * LDT + (wm * 64 + lr) * LDT + lh * 8; \
      const u16* b_ = sB + (BUF) * 128 * LDT + (wn * 64 + lr) * LDT + lh * 8; \
      _Pragma("unroll") for (int ks = 0; ks < 4; ++ks) { \
        const bf16x8 a0 = ld8(a_ + ks * 16), a1 = ld8(a_ + 32 * LDT + ks * 16); \
        const bf16x8 b0 = ld8(b_ + ks * 16), b1 = ld8(b_ + 32 * LDT + ks * 16); \
        acc[0][0] = mfma32(a0, b0, acc[0][0]); acc[0][1] = mfma32(a0, b1, acc[0][1]); \
        acc[1][0] = mfma32(a1, b0, acc[1][0]); acc[1][1] = mfma32(a1, b1, acc[1][1]); } } while (0)
    G_LOADX(0);
    G_STOREX(0);
    G_LOADX(1);
    if (nk > 2) G_LOADY(2);
    __syncthreads();
    for (int kt = 0; kt < nk; kt += 2) {
      G_COMPUTE(0);
      G_STOREX(1);
      if (kt + 3 < nk) G_LOADX(kt + 3);
      __syncthreads();
      G_COMPUTE(1);
      if (kt + 2 < nk) G_STOREY(0);
      if (kt + 4 < nk) G_LOADY(kt + 4);
      __syncthreads();
    }
    { int lr_ = lr, lh_ = lh; asm volatile("" : "+v"(lr_), "+v"(lh_));
      epi(acc, mt * 128 + wm * 64, nt * 128 + wn * 64, nt, wn, lr_, lh_); }
  }
}


DI float dpp_xor1(float v) { return __builtin_bit_cast(float, __builtin_amdgcn_update_dpp(0, __builtin_bit_cast(int, v), 0xB1, 0xf, 0xf, true)); }
DI void store_bf16_pair(u16* dst, int ld, int row_e, int row_o, int col, float v_e, float v_o) {
  const bool odd = col & 1;
  const float recv = dpp_xor1(odd ? v_e : v_o);
  const u32 w = odd ? pk2(recv, v_o) : pk2(v_e, recv);
  *reinterpret_cast<u32*>(dst + (size_t)(odd ? row_o : row_e) * ld + (col & ~1)) = w;
}
struct EpiIn0 {
  u16 *qk, *vraw, *u0g, *z; float* g0;
  template <int MI>
  DI void operator()(f32x16 (&acc)[MI][2], int mb, int nb, int, int, int lr, int lh) const {
#pragma unroll
    for (int ni = 0; ni < 2; ++ni) {
      const int c0 = nb + ni * 32;
      u16* dst; int ld;
      if (c0 < 1024) { dst = qk + c0; ld = 1024; }
      else if (c0 < 1536) { dst = vraw + (c0 - 1024); ld = 512; }
      else if (c0 < 3072) { dst = u0g + (c0 - 1536); ld = 1536; }
      else if (c0 < 3584) { dst = z + (c0 - 3072); ld = 512; }
      else { dst = nullptr; ld = 0; }
#pragma unroll
      for (int mi = 0; mi < MI; ++mi) {
        if (dst) {
#pragma unroll
          for (int i = 0; i < 16; i += 2)
            store_bf16_pair(dst, ld, mb + mi * 32 + crow(i, lh), mb + mi * 32 + crow(i + 1, lh), lr, acc[mi][ni][i], acc[mi][ni][i + 1]);
        } else if (c0 == 3584 && lr < 16) {
#pragma unroll
          for (int i = 0; i < 16; ++i) g0[(size_t)(mb + mi * 32 + crow(i, lh)) * 16 + lr] = acc[mi][ni][i];
        }
      }
    }
  }
};
struct EpiResid {
  const float *hc_in, *hx_in; float *hc_out, *hx_out; const float* gate;
  DI void operator()(f32x16 (&acc)[2][2], int mb, int nb, int, int, int lr, int lh) const {
    const bool isc = mb < LAT0;
    if (isc && !hc_out) return;
    const float* in = isc ? hc_in + (size_t)mb * DM : hx_in + (size_t)(mb - LAT0) * DM;
    float* out = isc ? hc_out + (size_t)mb * DM : hx_out + (size_t)(mb - LAT0) * DM;
    const float* gt = gate + (size_t)row_cond(mb) * 6144;
#pragma unroll
    for (int ni = 0; ni < 2; ++ni) {
      const int col = nb + ni * 32 + lr;
      const float g = gt[col];
#pragma unroll
      for (int mi = 0; mi < 2; ++mi) {
#pragma unroll
        for (int i8 = 0; i8 < 16; i8 += 8) {
          float hv[8];
#pragma unroll
          for (int i = 0; i < 8; ++i) hv[i] = in[(size_t)(mi * 32 + crow(i8 + i, lh)) * DM + col];
#pragma unroll
          for (int i = 0; i < 8; ++i) out[(size_t)(mi * 32 + crow(i8 + i, lh)) * DM + col] = hv[i] + g * acc[mi][ni][i8 + i];
        }
      }
    }
  }
};
struct EpiSwiglu {
  u16* act;
  template <int MI>
  DI void operator()(f32x16 (&acc)[MI][2], int mb, int, int nt, int wn, int lr, int lh) const {
    const int hid = nt * 64 + wn * 32 + lr;
#pragma unroll
    for (int mi = 0; mi < MI; ++mi) {
#pragma unroll
      for (int i = 0; i < 16; i += 2) {
        const float a0 = siluf_fast(acc[mi][0][i]) * acc[mi][1][i], a1 = siluf_fast(acc[mi][0][i + 1]) * acc[mi][1][i + 1];
        store_bf16_pair(act, FFH, mb + mi * 32 + crow(i, lh), mb + mi * 32 + crow(i + 1, lh), hid, a0, a1);
      }
      __builtin_amdgcn_sched_barrier(0);
    }
  }
};
struct EpiIn1 {
  u16 *ug, *ur;
  template <int MI>
  DI void operator()(f32x16 (&acc)[MI][2], int mb, int nb, int, int, int lr, int lh) const {
#pragma unroll
    for (int mi = 0; mi < MI; ++mi)
#pragma unroll
      for (int ni = 0; ni < 2; ++ni) {
        const int col = nb + ni * 32 + lr;
#pragma unroll
        for (int i = 0; i < 16; ++i) {
          const int row = mb + mi * 32 + crow(i, lh);
          if (col < 1024) { if (row >= LAT0) ug[(size_t)(row - LAT0) * DM + col] = f2bf(acc[mi][ni][i]); }
          else ur[(size_t)row * DM + col - 1024] = f2bf(acc[mi][ni][i]);
        }
      }
  }
};
struct EpiGates {
  const u16* xc; u16* ab; const float *b_r, *b_i, *lam;
  DI void operator()(f32x16 (&acc)[2][2], int mb, int, int nt, int wn, int lr, int lh) const {
    const int kb = nt >> 2, jt = nt & 3, z = jt >> 1, half = jt & 1;
    const int ch = kb * 128 + half * 64 + wn * 32 + lr;
    const float br = b_r[z * 1024 + ch], bi = b_i[z * 1024 + ch];
    const float sp = softplusf_(-lam[z * 1024 + ch]);
    u16* la = ab + (size_t)z * 2 * MROWS * DM;
    u16* bb = la + (size_t)MROWS * DM;
#pragma unroll
    for (int mi = 0; mi < 2; ++mi) {
      float xv[16];
#pragma unroll
      for (int i = 0; i < 16; ++i) xv[i] = bf2f(xc[(size_t)(mb + mi * 32 + crow(i, lh)) * DM + ch]);
#pragma unroll
      for (int i = 0; i < 16; ++i) {
        const int row = mb + mi * 32 + crow(i, lh);
        const float r = sigmoidf_fast(acc[mi][0][i] + br), ig = sigmoidf_fast(acc[mi][1][i] + bi);
        const float loga = -8.f * r * sp;
        const float a2 = __expf(2.f * loga);
        const float bval = __builtin_amdgcn_sqrtf(fmaxf(1.f - a2, 0.f)) * (ig * xv[i]);
        la[(size_t)row * DM + ch] = f2bf(loga);
        bb[(size_t)row * DM + ch] = f2bf(bval);
      }
      __builtin_amdgcn_sched_barrier(0);
    }
  }
};


constexpr int LD4 = 40;
template <class Epi>
DI void gemm_phase4(const u16* __restrict__ A, int lda, const u16* __restrict__ Bt, int ldb, int K, int mt_lo, int mtiles, int ntiles,
                    char* smem, Epi epi) {
  u16* sA = (u16*)smem;
  u16* sB = sA + 2 * 256 * LD4;
  const int tid = opaque_tid(), lane = tid & 63, wid = __builtin_amdgcn_readfirstlane(tid >> 6), wm = wid >> 1, wn = wid & 1;
  const int lr = lane & 31, lh = lane >> 5;
  const int ldrow = tid >> 2, ldc = (tid & 3) * 8;
  const int nk = K / 32;
  const int total = mtiles * ntiles;
  const int per_xcd = (total + 7) >> 3;
  const int xcd = blockIdx.x & 7, qx = blockIdx.x >> 3, nq = gridDim.x >> 3;
  for (int v = qx; v < per_xcd; v += nq) {
    const int u = xcd * per_xcd + v;
    if (u >= total) break;
    const int gsz_full = 8 * ntiles;
    const int g = u / gsz_full, r = u - g * gsz_full;
    const int gm = min(8, mtiles - g * 8);
    const int mt = mt_lo + g * 8 + r % gm, nt = r / gm;
    const unsigned oA = (unsigned)(((mt * 256 + ldrow) * lda + ldc) * 2);
    const unsigned oB = (unsigned)(((nt * 128 + ldrow) * ldb + ldc) * 2);
    const char* Ab = (const char*)A;
    const char* Bb = (const char*)Bt;
    f32x16 acc[4][2];
#pragma unroll
    for (int mi = 0; mi < 4; ++mi) { acc[mi][0] = zero16(); acc[mi][1] = zero16(); }
    uint4 xa0, xa1, xa2, xa3, xb0, xb1, ya0, ya1, ya2, ya3, yb0, yb1;
#define G4_LOADX(KT) do { const unsigned ka_ = oA + (unsigned)(KT) * 64u, kb_ = oB + (unsigned)(KT) * 64u; \
      xa0 = *reinterpret_cast<const uint4*>(Ab + ka_); xa1 = *reinterpret_cast<const uint4*>(Ab + (ka_ + 64u * (unsigned)lda * 2u)); \
      xa2 = *reinterpret_cast<const uint4*>(Ab + (ka_ + 128u * (unsigned)lda * 2u)); xa3 = *reinterpret_cast<const uint4*>(Ab + (ka_ + 192u * (unsigned)lda * 2u)); \
      xb0 = *reinterpret_cast<const uint4*>(Bb + kb_); xb1 = *reinterpret_cast<const uint4*>(Bb + (kb_ + 64u * (unsigned)ldb * 2u)); } while (0)
#define G4_LOADY(KT) do { const unsigned ka_ = oA + (unsigned)(KT) * 64u, kb_ = oB + (unsigned)(KT) * 64u; \
      ya0 = *reinterpret_cast<const uint4*>(Ab + ka_); ya1 = *reinterpret_cast<const uint4*>(Ab + (ka_ + 64u * (unsigned)lda * 2u)); \
      ya2 = *reinterpret_cast<const uint4*>(Ab + (ka_ + 128u * (unsigned)lda * 2u)); ya3 = *reinterpret_cast<const uint4*>(Ab + (ka_ + 192u * (unsigned)lda * 2u)); \
      yb0 = *reinterpret_cast<const uint4*>(Bb + kb_); yb1 = *reinterpret_cast<const uint4*>(Bb + (kb_ + 64u * (unsigned)ldb * 2u)); } while (0)
#define G4_STOREX(BUF) do { u16* wa_ = sA + (BUF) * 256 * LD4 + ldrow * LD4 + ldc; u16* wb_ = sB + (BUF) * 128 * LD4 + ldrow * LD4 + ldc; \
      *reinterpret_cast<uint4*>(wa_) = xa0; *reinterpret_cast<uint4*>(wa_ + 64 * LD4) = xa1; \
      *reinterpret_cast<uint4*>(wa_ + 128 * LD4) = xa2; *reinterpret_cast<uint4*>(wa_ + 192 * LD4) = xa3; \
      *reinterpret_cast<uint4*>(wb_) = xb0; *reinterpret_cast<uint4*>(wb_ + 64 * LD4) = xb1; } while (0)
#define G4_STOREY(BUF) do { u16* wa_ = sA + (BUF) * 256 * LD4 + ldrow * LD4 + ldc; u16* wb_ = sB + (BUF) * 128 * LD4 + ldrow * LD4 + ldc; \
      *reinterpret_cast<uint4*>(wa_) = ya0; *reinterpret_cast<uint4*>(wa_ + 64 * LD4) = ya1; \
      *reinterpret_cast<uint4*>(wa_ + 128 * LD4) = ya2; *reinterpret_cast<uint4*>(wa_ + 192 * LD4) = ya3; \
      *reinterpret_cast<uint4*>(wb_) = yb0; *reinterpret_cast<uint4*>(wb_ + 64 * LD4) = yb1; } while (0)
#define G4_COMPUTE(BUF) do { \
      const u16* a_ = sA + (BUF) * 256 * LD4 + (wm * 128 + lr) * LD4 + lh * 8; \
      const u16* b_ = sB + (BUF) * 128 * LD4 + (wn * 64 + lr) * LD4 + lh * 8; \
      _Pragma("unroll") for (int ks = 0; ks < 2; ++ks) { \
        const bf16x8 b0 = ld8(b_ + ks * 16), b1 = ld8(b_ + 32 * LD4 + ks * 16); \
        _Pragma("unroll") for (int mi = 0; mi < 4; ++mi) { \
          const bf16x8 a0 = ld8(a_ + mi * 32 * LD4 + ks * 16); \
          acc[mi][0] = mfma32(a0, b0, acc[mi][0]); acc[mi][1] = mfma32(a0, b1, acc[mi][1]); } } } while (0)
    G4_LOADX(0);
    G4_STOREX(0);
    G4_LOADX(1);
    if (nk > 2) G4_LOADY(2);
    __syncthreads();
    for (int kt = 0; kt < nk; kt += 2) {
      G4_COMPUTE(0);
      G4_STOREX(1);
      if (kt + 3 < nk) G4_LOADX(kt + 3);
      __syncthreads();
      G4_COMPUTE(1);
      if (kt + 2 < nk) G4_STOREY(0);
      if (kt + 4 < nk) G4_LOADY(kt + 4);
      __syncthreads();
    }
    { int lr_ = lr, lh_ = lh; asm volatile("" : "+v"(lr_), "+v"(lh_));
      epi.template operator()<4>(acc, mt * 256 + wm * 128, nt * 128 + wn * 64, nt, wn, lr_, lh_); }
  }
}

DI void phase_da_prep(const Params& p, char* smem) {
  u16* qk = (u16*)((char*)p.out + DO_QK);
  const int tid0 = opaque_tid();
  const int lane = tid0 & 63, wid = tid0 >> 6;
  const int nw = gridDim.x * 4;
  const int qq = lane & 3;
  const bool isk = lane >= 32;
  const float* gain = p.in[isk ? I_KN : I_QN] + qq * 16;
  for (int row = blockIdx.x * 4 + wid; row < MROWS; row += nw) {
    uint4* ptr = reinterpret_cast<uint4*>(qk + (size_t)row * 1024 + lane * 16);
    const uint4 v0 = ptr[0], v1 = ptr[1];
    float x[16];
    x[0] = bflo(v0.x); x[1] = bfhi(v0.x); x[2] = bflo(v0.y); x[3] = bfhi(v0.y); x[4] = bflo(v0.z); x[5] = bfhi(v0.z); x[6] = bflo(v0.w); x[7] = bfhi(v0.w);
    x[8] = bflo(v1.x); x[9] = bfhi(v1.x); x[10] = bflo(v1.y); x[11] = bfhi(v1.y); x[12] = bflo(v1.z); x[13] = bfhi(v1.z); x[14] = bflo(v1.w); x[15] = bfhi(v1.w);
    float ss = 0.f;
#pragma unroll
    for (int i = 0; i < 16; ++i) ss += x[i] * x[i];
    ss += __shfl_xor(ss, 1); ss += __shfl_xor(ss, 2);
    const float rinv = rsqrtf(ss * (1.f / 64.f) + EPSF) * (isk ? 1.f : 0.125f * 1.4426950408889634f);
#pragma unroll
    for (int i = 0; i < 16; ++i) x[i] = x[i] * rinv * gain[i];
    if (row >= LAT0) {
      const int t = (row - LAT0) & (SEQ - 1);
      const float pos = (float)((qq >> 1) ? (t & 63) : (t >> 6));
#pragma unroll
      for (int i = 0; i < 16; ++i) {
        const float other = __shfl_xor(x[i], 1);
        const float inv = exp2f(-(float)i * (13.287712379549449f / 16.f));
        const float ang = pos * inv;
        float rev = ang * 0.15915494309189535f;
        rev -= floorf(rev);
        const float sn = __builtin_amdgcn_sinf(rev), cs = __builtin_amdgcn_cosf(rev);
        x[i] = (qq & 1) ? (x[i] * cs + other * sn) : (x[i] * cs - other * sn);
      }
    }
    ptr[0] = make_uint4(pk2(x[0], x[1]), pk2(x[2], x[3]), pk2(x[4], x[5]), pk2(x[6], x[7]));
    ptr[1] = make_uint4(pk2(x[8], x[9]), pk2(x[10], x[11]), pk2(x[12], x[13]), pk2(x[14], x[15]));
  }
  const u16* vraw = (const u16*)(p.ws + WS_VRAW);
  u16* vt = (u16*)((char*)p.out + DO_VT);
  u16* sv = (u16*)smem;
  const int tid = tid0;
  for (int item = blockIdx.x; item < 2 * 4 * NCH; item += gridDim.x) {
    const int t = item % NCH, bh = item / NCH, b = bh >> 2, h = bh & 3;
    const int row0 = t < 4 ? b * CTXL + t * 64 : LAT0 + b * SEQ + (t - 4) * 64;
    {
      const int key = tid >> 2, ec = (tid & 3) * 32;
      const uint4* s = reinterpret_cast<const uint4*>(vraw + (size_t)(row0 + key) * 512 + h * 128 + ec);
#pragma unroll
      for (int i = 0; i < 4; ++i) {
        const uint4 v = s[i];
        u32* d = reinterpret_cast<u32*>(sv + key * 130 + ec + i * 8);
        d[0] = v.x; d[1] = v.y; d[2] = v.z; d[3] = v.w;
      }
    }
    __syncthreads();
    {
      const int e = tid >> 1, half = tid & 1;
      u32 w[16];
#pragma unroll
      for (int i = 0; i < 16; ++i) {
        const int p0 = half * 32 + 2 * i, p1 = p0 + 1;
        const int k0 = (p0 & ~12) | ((p0 & 4) << 1) | ((p0 & 8) >> 1);
        const int k1 = (p1 & ~12) | ((p1 & 4) << 1) | ((p1 & 8) >> 1);
        w[i] = (u32)sv[k0 * 130 + e] | ((u32)sv[k1 * 130 + e] << 16);
      }
      uint4* d = reinterpret_cast<uint4*>(vt + ((size_t)(bh * 128 + e)) * SK + t * 64 + half * 32);
      d[0] = make_uint4(w[0], w[1], w[2], w[3]); d[1] = make_uint4(w[4], w[5], w[6], w[7]);
      d[2] = make_uint4(w[8], w[9], w[10], w[11]); d[3] = make_uint4(w[12], w[13], w[14], w[15]);
    }
    __syncthreads();
  }
}

#define LDS_AS __attribute__((address_space(3)))
DI void glds16(const void* g, char* lds_wave_base) {
  __builtin_amdgcn_global_load_lds((const unsigned*)g, (LDS_AS unsigned*)lds_wave_base, 16, 0, 0);
}
#define RAW_BARRIER() do { asm volatile("s_waitcnt lgkmcnt(0)" ::: "memory"); __builtin_amdgcn_s_barrier(); } while (0)
DI void phase_da_attn(const Params& p, char* smem) {
  const u16* qk = (const u16*)((const char*)p.out + DO_QK);
  const u16* vt = (const u16*)((const char*)p.out + DO_VT);
  u16* mix = (u16*)(p.ws + WS_MIX);
  char* sK = smem;
  char* sV = smem + 32768;
  float* ex = (float*)smem;
  const int tid = opaque_tid(), lane = tid & 63, wid = __builtin_amdgcn_readfirstlane(tid >> 6), lr = lane & 31, lh = lane >> 5;
  const int qg = wid >> 1, mp = wid & 1;
  float lam;
  {
    const float a = p.in[I_LQ1][lane] * p.in[I_LK1][lane], b2 = p.in[I_LQ2][lane] * p.in[I_LK2][lane];
    lam = __expf(wave_sum(a)) - __expf(wave_sum(b2)) + 0.2f;
  }
  int* cnt = (int*)(p.ws + WS_CNT);
  int* sitem = (int*)(smem + 73728);
  if (tid == 0) { sitem[1] = (int)((unsigned)__builtin_amdgcn_s_getreg((3 << 11) | 20) & 7u); sitem[2] = 0; }
  const int x15 = lr & 15, f3 = (lr >> 2) & 3;
  for (;;) {
    if (tid == 0) {
      int got = -1, tries = sitem[2];
      const int home = sitem[1];
      while (tries < 8) {
        const int it = atomicAdd(&cnt[(home + tries) & 7], 1);
        if (it < 260) { got = ((home + tries) & 7) | (it << 3); break; }
        ++tries;
      }
      sitem[2] = tries;
      *sitem = got;
    }
    __syncthreads();
    const int item = *sitem;
    if (item < 0) break;
    const int bh = item & 7, b = bh >> 2, h = bh & 3, qb = item >> 3;
    const bool isctx = qb >= 256;
    const int qrow0 = isctx ? b * CTXL + (qb - 256) * 64 : LAT0 + b * SEQ + qb * 64;
    const int ntile = isctx ? 8 : 2 * NCH;
    const int myq = qrow0 + qg * 32 + lr;
    bf16x8 qf[4];
#pragma unroll
    for (int ks = 0; ks < 4; ++ks) qf[ks] = ld8(qk + (size_t)myq * 1024 + h * 128 + mp * 64 + ks * 16 + lh * 8);
    f32x16 O[4];
#pragma unroll
    for (int dt = 0; dt < 4; ++dt) O[dt] = zero16();
    float l = 0.f;
    const u16* vsrc0 = vt + (size_t)(bh * 128) * SK;
#define DA_DMA(T) do { const int t_ = (T); const int st_ = t_ & 3; \
      int lq = lane; asm volatile("" : "+v"(lq)); \
      const int krl_ = lq >> 4, kpl_ = lq & 15, vrl_ = lq >> 2, vpl_ = lq & 3; \
      const int krow0 = t_ < 8 ? b * CTXL + t_ * 32 : LAT0 + b * SEQ + (t_ - 8) * 32; \
      const char* kbt = (const char*)(qk + (size_t)krow0 * 1024 + 512 + h * 128); \
      const char* vbt = (const char*)(vsrc0 + t_ * 32); \
      char* kd = sK + st_ * 8192 + wid * 2048; char* vd = sV + st_ * 8192 + wid * 2048; \
      const unsigned kob = (unsigned)((wid * 8 + krl_) * 2048), vob = (unsigned)(((wid * 32 + vrl_) * SK) * 2); \
      glds16(kbt + (kob + (unsigned)(0 * 2048 + ((kpl_ ^ ((wid * 8 + 0 + krl_) & 15)) << 4))), kd); \
      glds16(kbt + (kob + (unsigned)(4 * 2048 + ((kpl_ ^ ((wid * 8 + 4 + krl_) & 15)) << 4))), kd + 1024); \
      glds16(vbt + (vob + (unsigned)(0 * SK * 2 + ((vpl_ ^ (((0 + vrl_) >> 2) & 3)) << 4))), vd); \
      glds16(vbt + (vob + (unsigned)(16 * SK * 2 + ((vpl_ ^ (((16 + vrl_) >> 2) & 3)) << 4))), vd + 1024); } while (0)
    DA_DMA(0); DA_DMA(1); DA_DMA(2);
#pragma unroll 1
    for (int t = 0; t < ntile; ++t) {
      if (t + 2 < ntile) asm volatile("s_waitcnt vmcnt(8)" ::: "memory");
      else if (t + 1 < ntile) asm volatile("s_waitcnt vmcnt(4)" ::: "memory");
      else asm volatile("s_waitcnt vmcnt(0)" ::: "memory");
      RAW_BARRIER();
      if (t + 3 < ntile) DA_DMA(t + 3);
      const int st = t & 3;
      const unsigned kb = (unsigned)(size_t)(LDS_AS char*)(sK + st * 8192 + lr * 256);
      const unsigned vb = (unsigned)(size_t)(LDS_AS char*)(sV + st * 8192 + lr * 64);
      bf16x8 k0, k1, k2, k3, v0, v1, v2, v3, v4, v5, v6, v7;
      asm volatile("ds_read_b128 %0, %4\n\tds_read_b128 %1, %5\n\tds_read_b128 %2, %6\n\tds_read_b128 %3, %7"
                   : "=&v"(k0), "=&v"(k1), "=&v"(k2), "=&v"(k3)
                   : "v"(kb + (((mp * 8 + 0 + lh) ^ x15) << 4)), "v"(kb + (((mp * 8 + 2 + lh) ^ x15) << 4)),
                     "v"(kb + (((mp * 8 + 4 + lh) ^ x15) << 4)), "v"(kb + (((mp * 8 + 6 + lh) ^ x15) << 4)) : "memory");
      const unsigned va = vb + (((0 + lh) ^ f3) << 4), vc = vb + (((2 + lh) ^ f3) << 4);
      asm volatile("ds_read_b128 %0, %8\n\tds_read_b128 %1, %9\n\tds_read_b128 %2, %8 offset:2048\n\tds_read_b128 %3, %9 offset:2048\n\t"
                   "ds_read_b128 %4, %8 offset:4096\n\tds_read_b128 %5, %9 offset:4096\n\tds_read_b128 %6, %8 offset:6144\n\tds_read_b128 %7, %9 offset:6144"
                   : "=&v"(v0), "=&v"(v1), "=&v"(v2), "=&v"(v3), "=&v"(v4), "=&v"(v5), "=&v"(v6), "=&v"(v7)
                   : "v"(va), "v"(vc) : "memory");
      asm volatile("s_waitcnt lgkmcnt(8)" : "+v"(k0), "+v"(k1), "+v"(k2), "+v"(k3) :: "memory");
      f32x16 s = zero16();
      s = mfma32(k0, qf[0], s); s = mfma32(k1, qf[1], s); s = mfma32(k2, qf[2], s); s = mfma32(k3, qf[3], s);
      float rs = 0.f;
#pragma unroll
      for (int i = 0; i < 16; ++i) { s[i] = __builtin_amdgcn_exp2f(s[i]); rs += s[i]; }
      l += rs;
      const bf16x8 pb0 = pack_step(s, 0), pb1 = pack_step(s, 1);
      asm volatile("s_waitcnt lgkmcnt(0)" : "+v"(v0), "+v"(v1), "+v"(v2), "+v"(v3), "+v"(v4), "+v"(v5), "+v"(v6), "+v"(v7) :: "memory");
      O[0] = mfma32(v0, pb0, O[0]); O[1] = mfma32(v2, pb0, O[1]); O[2] = mfma32(v4, pb0, O[2]); O[3] = mfma32(v6, pb0, O[3]);
      O[0] = mfma32(v1, pb1, O[0]); O[1] = mfma32(v3, pb1, O[1]); O[2] = mfma32(v5, pb1, O[2]); O[3] = mfma32(v7, pb1, O[3]);
    }
    __syncthreads();
    l += __shfl_xor(l, 32);
    if (mp == 1) {
      const float sc = lam / l;
#pragma unroll
      for (int dt = 0; dt < 4; ++dt)
#pragma unroll
        for (int i = 0; i < 16; ++i) ex[((qg * 4 + dt) * 16 + i) * 64 + lane] = O[dt][i] * sc;
    }
    __syncthreads();
    if (mp == 0) {
      const float i0 = 1.f / l;
      float ss = 0.f;
#pragma unroll
      for (int dt = 0; dt < 4; ++dt)
#pragma unroll
        for (int i = 0; i < 16; ++i) {
          const float v = O[dt][i] * i0 - ex[((qg * 4 + dt) * 16 + i) * 64 + lane];
          O[dt][i] = v; ss += v * v;
        }
      ss += __shfl_xor(ss, 32);
      const float rinv = rsqrtf(ss * (1.f / 128.f) + EPSF) * 0.8f;
      const float* sn = p.in[I_SUBN];
#pragma unroll
      for (int dt = 0; dt < 4; ++dt)
#pragma unroll
        for (int g = 0; g < 4; ++g) {
          const int dv = dt * 32 + 8 * g + 4 * lh;
          const float4 gn = *reinterpret_cast<const float4*>(sn + dv);
          const u32 w0 = pk2(O[dt][4 * g] * rinv * gn.x, O[dt][4 * g + 1] * rinv * gn.y);
          const u32 w1 = pk2(O[dt][4 * g + 2] * rinv * gn.z, O[dt][4 * g + 3] * rinv * gn.w);
          *reinterpret_cast<uint2*>(mix + (size_t)myq * 1024 + h * 128 + dv) = make_uint2(w0, w1);
        }
    }
    __syncthreads();
  }
}

template <int DIR>
DI void gdn_solve(float (&X)[64], int c, const float* sAm, const float* gc, const float* bt, const u16* skn, const u16* svv) {
  if (c < 128) {
#pragma unroll
    for (int i = 0; i < 64; ++i) {
      const int tok = DIR ? 63 - i : i;
      X[i] = bt[i] * bf2f(svv[tok * 128 + c]);
    }
  } else {
#pragma unroll
    for (int i = 0; i < 64; ++i) {
      const int tok = DIR ? 63 - i : i;
      X[i] = bt[i] * __expf(gc[i]) * bf2f(skn[tok * 136 + c - 128]);
    }
  }
  __builtin_amdgcn_sched_barrier(0);
#pragma unroll
  for (int i = 1; i < 64; ++i) {
    float acc = X[i];
    const float4* arow = reinterpret_cast<const float4*>(sAm + i * 64);
#pragma unroll
    for (int j4 = 0; j4 < (i + 3) / 4; ++j4) {
      const float4 a4 = arow[j4];
      if (4 * j4 + 0 < i) acc = __builtin_fmaf(-a4.x, X[4 * j4 + 0], acc);
      if (4 * j4 + 1 < i) acc = __builtin_fmaf(-a4.y, X[4 * j4 + 1], acc);
      if (4 * j4 + 2 < i) acc = __builtin_fmaf(-a4.z, X[4 * j4 + 2], acc);
      if (4 * j4 + 3 < i) acc = __builtin_fmaf(-a4.w, X[4 * j4 + 3], acc);
    }
    X[i] = acc;
    __builtin_amdgcn_sched_barrier(0);
  }
}

constexpr int QS = 136;
DI void phase_gdn_prep(const Params& p, char* smem) {
  u16* sq = (u16*)smem;
  u16* skn = sq + 64 * QS;
  float* sAm = (float*)(skn + 64 * QS);
  u16* sat = (u16*)(sAm + 64 * 64);
  float* sgc = (float*)(sat + 64 * 72);
  float* sbt = sgc + 128;
  u16* svv = (u16*)(sbt + 128);
  const u16* u0g = (const u16*)(p.ws + WS_U0G);
  const float* g0 = (const float*)(p.ws + WS_G0);
  const float* cw = p.in[I_GCONV];
  for (int item = blockIdx.x; item < 2 * NCH * 4; item += gridDim.x) {
    int tid = opaque_tid();
    const int lane = tid & 63, wid = __builtin_amdgcn_readfirstlane(tid >> 6), lr = lane & 31, lh = lane >> 5;
    const int h = item & 3, n = (item >> 2) % NCH, b = item / (4 * NCH);
    const int row0 = n < 4 ? b * CTXL + n * 64 : LAT0 + b * SEQ + (n - 4) * 64;
    const int t0 = n < 4 ? n * 64 : (n - 4) * 64;
    const int slen = n < 4 ? CTXL : SEQ;
    {
      int t1 = tid; asm volatile("" : "+v"(t1));
      const int cgp = t1 & 15, rg = t1 >> 4;
#pragma unroll
      for (int qk_ = 0; qk_ < 3; ++qk_) {
        const int chb = qk_ * 512 + h * 128 + cgp * 8;
        float wv[4][8];
#pragma unroll
        for (int j = 0; j < 4; ++j)
#pragma unroll
          for (int e = 0; e < 8; ++e) wv[j][e] = cw[j * 1536 + chb + e];
        float xin[7][8];
#pragma unroll
        for (int r = 0; r < 7; ++r) {
          const int tt = rg * 4 + r - 2;
          const int pos = t0 + tt;
          if (pos >= 0 && pos < slen) {
            const uint4 v = *reinterpret_cast<const uint4*>(u0g + (size_t)(row0 + tt) * 1536 + chb);
            xin[r][0] = bflo(v.x); xin[r][1] = bfhi(v.x); xin[r][2] = bflo(v.y); xin[r][3] = bfhi(v.y);
            xin[r][4] = bflo(v.z); xin[r][5] = bfhi(v.z); xin[r][6] = bflo(v.w); xin[r][7] = bfhi(v.w);
          } else {
#pragma unroll
            for (int e = 0; e < 8; ++e) xin[r][e] = 0.f;
          }
        }
#pragma unroll
        for (int r = 0; r < 4; ++r) {
          float y[8]; float ss = 0.f;
#pragma unroll
          for (int e = 0; e < 8; ++e) {
            float a = 0.f;
#pragma unroll
            for (int j = 0; j < 4; ++j) a += wv[j][e] * xin[r + j][e];
            y[e] = siluf_fast(a); ss += y[e] * y[e];
          }
          ss += __shfl_xor(ss, 1); ss += __shfl_xor(ss, 2); ss += __shfl_xor(ss, 4); ss += __shfl_xor(ss, 8);
          const float rinv = qk_ == 2 ? 1.f : rsqrtf(ss + EPSF);
          u16* d = qk_ == 2 ? svv + (rg * 4 + r) * 128 + cgp * 8 : (qk_ ? skn : sq) + (rg * 4 + r) * QS + cgp * 8;
          *reinterpret_cast<uint4*>(d) = make_uint4(pk2(y[0] * rinv, y[1] * rinv), pk2(y[2] * rinv, y[3] * rinv),
                                                    pk2(y[4] * rinv, y[5] * rinv), pk2(y[6] * rinv, y[7] * rinv));
        }
      }
    }
    if (wid < 2) {
      const int d = wid, tok = d ? 63 - lane : lane;
      const float* gr = g0 + (size_t)(row0 + tok) * 16;
      const float beta = sigmoidf_(gr[d * 4 + h]);
      const float g = -__expf(p.in[I_ALOG][d * 4 + h]) * softplusf_(gr[8 + d * 4 + h] + p.in[I_DTB][d * 4 + h]);
      float cs = g;
#pragma unroll
      for (int o = 1; o < 64; o <<= 1) { const float v = __shfl_up(cs, o); if (lane >= o) cs += v; }
      sgc[d * 64 + lane] = cs; sbt[d * 64 + lane] = beta;
    }
    __syncthreads();
    for (int d = 0; d < 2; ++d) {
      char* fr = p.ws + WS_FRAGS + (size_t)(((b * 2 + d) * 4 + h) * NCH + n) * FRAG_ITEM;
      const float* gc = sgc + d * 64;
      const float* bt = sbt + d * 64;
      {
        int lr_ = lr; asm volatile("" : "+v"(lr_));
        const int ti = wid >> 1, tj = wid & 1;
        const int ri = d ? 63 - (ti * 32 + lr_) : ti * 32 + lr_;
        const int rj = d ? 63 - (tj * 32 + lr_) : tj * 32 + lr_;
        f32x16 kk = zero16(), qkk = zero16();
#pragma unroll
        for (int ks = 0; ks < 8; ++ks) {
          const bf16x8 bk = ld8(skn + rj * QS + ks * 16 + lh * 8);
          kk = mfma32(ld8(skn + ri * QS + ks * 16 + lh * 8), bk, kk);
          qkk = mfma32(ld8(sq + ri * QS + ks * 16 + lh * 8), bk, qkk);
        }
        const int j = tj * 32 + lr_;
        const float gcj = gc[j];
#pragma unroll
        for (int r = 0; r < 16; ++r) {
          const int i = ti * 32 + crow(r, lh);
          const float dec = __expf(fminf(gc[i] - gcj, 0.f));
          sAm[i * 64 + j] = (i > j) ? bt[i] * kk[r] * dec : 0.f;
          sat[i * 72 + j] = f2bf((i >= j) ? qkk[r] * dec * 0.08838834764831845f : 0.f);
        }
      }
      __syncthreads();
      float X[64];
      if (d == 0) gdn_solve<0>(X, tid, sAm, gc, bt, skn, svv);
      else gdn_solve<1>(X, tid, sAm, gc, bt, skn, svv);
      __syncthreads();
      u16* sW = (u16*)sAm;
      if (tid >= 128) {
#pragma unroll
        for (int i = 0; i < 64; ++i) sW[i * 128 + tid - 128] = f2bf(-X[i]);
      } else {
        int tu = tid; asm volatile("" : "+v"(tu));
        const int sl = tu >> 5, n_ = tu & 31;
        u16* ud = (u16*)(fr + FR_U);
#pragma unroll
        for (int mt = 0; mt < 2; ++mt)
#pragma unroll
          for (int hh = 0; hh < 2; ++hh) {
            u32 w[8];
#pragma unroll
            for (int r2 = 0; r2 < 8; ++r2) w[r2] = pk2(X[mt * 32 + crow(2 * r2, hh)], X[mt * 32 + crow(2 * r2 + 1, hh)]);
            uint4* dd = reinterpret_cast<uint4*>(ud + ((size_t)((sl * 2 + mt) * 64 + hh * 32 + n_)) * 16);
            dd[0] = make_uint4(w[0], w[1], w[2], w[3]); dd[1] = make_uint4(w[4], w[5], w[6], w[7]);
          }
      }
      __syncthreads();
      int tq = tid; asm volatile("" : "+v"(tq));
      const float glast = gc[63];
      if (tid == 0) ((float*)(p.ws + WS_GL))[((b * 2 + d) * 4 + h) * NCH + n] = __expf(glast);
#pragma unroll 1
      for (int idx = tq; idx < 16 * 64; idx += 256) {
        const int L = idx & 63, f = idx >> 6, mt = f >> 3, ks = f & 7, m = L & 31, hh = L >> 5;
        const int i = mt * 32 + m, tok = d ? 63 - i : i;
        const int dk0 = 32 * (ks >> 1) + 16 * (ks & 1) + 4 * hh;
        const uint2 wa = *reinterpret_cast<const uint2*>(sW + i * 128 + dk0);
        const uint2 wb = *reinterpret_cast<const uint2*>(sW + i * 128 + dk0 + 8);
        reinterpret_cast<uint4*>(fr + FR_W)[idx] = make_uint4(wa.x, wa.y, wb.x, wb.y);
        const float sc = __expf(gc[i]) * 0.08838834764831845f;
        const uint2 qa = *reinterpret_cast<const uint2*>(sq + tok * QS + dk0);
        const uint2 qb = *reinterpret_cast<const uint2*>(sq + tok * QS + dk0 + 8);
        reinterpret_cast<uint4*>(fr + FR_Q)[idx] = make_uint4(pk2(bflo(qa.x) * sc, bfhi(qa.x) * sc), pk2(bflo(qa.y) * sc, bfhi(qa.y) * sc),
                                                             pk2(bflo(qb.x) * sc, bfhi(qb.x) * sc), pk2(bflo(qb.y) * sc, bfhi(qb.y) * sc));
      }
#pragma unroll 1
      for (int idx = tq; idx < 16 * 64; idx += 256) {
        const int L = idx & 63, f = idx >> 6, kt = f >> 2, ks = f & 3, m = L & 31, hh = L >> 5;
        float v[8];
#pragma unroll
        for (int j = 0; j < 8; ++j) {
          const int i = 32 * (ks >> 1) + krow(ks & 1, hh, j), tok = d ? 63 - i : i;
          v[j] = bf2f(skn[tok * QS + kt * 32 + m]) * __expf(glast - gc[i]);
        }
        reinterpret_cast<uint4*>(fr + FR_KT)[idx] = make_uint4(pk2(v[0], v[1]), pk2(v[2], v[3]), pk2(v[4], v[5]), pk2(v[6], v[7]));
      }
#pragma unroll 1
      for (int idx = tq; idx < 8 * 64; idx += 256) {
        const int L = idx & 63, f = idx >> 6, it = f >> 2, ks = f & 3, m = L & 31, hh = L >> 5;
        const int j0 = 32 * (ks >> 1) + 16 * (ks & 1) + 4 * hh;
        const uint2 a = *reinterpret_cast<const uint2*>(sat + (it * 32 + m) * 72 + j0);
        const uint2 bq = *reinterpret_cast<const uint2*>(sat + (it * 32 + m) * 72 + j0 + 8);
        reinterpret_cast<uint4*>(fr + FR_AT)[idx] = make_uint4(a.x, a.y, bq.x, bq.y);
      }
      __syncthreads();
    }
  }
}

DI void gdn_scan_chain(const Params& p, char* smem, int chain) {
  const int tid = opaque_tid(), lane = tid & 63, sl = __builtin_amdgcn_readfirstlane(tid >> 6);
  const int d = (chain >> 2) & 1;
  const float* GL = (const float*)(p.ws + WS_GL) + chain * NCH;
  uint4* sfr = reinterpret_cast<uint4*>(smem);
  f32x16 S[4];
#pragma unroll
  for (int kt = 0; kt < 4; ++kt) S[kt] = zero16();
  uint4 pf0, pf1, pf2, pf3, pf4, pf5, pf6, pf7, pf8, pf9, pf10, pf11, pf12, pf13;
  {
    const int n0 = d ? 3 : 0;
    const char* fr = p.ws + WS_FRAGS + (size_t)(chain * NCH + n0) * FRAG_ITEM;
    const uint4* g = reinterpret_cast<const uint4*>(fr) + tid;
    pf0 = g[0 * 256]; pf1 = g[1 * 256]; pf2 = g[2 * 256]; pf3 = g[3 * 256]; pf4 = g[4 * 256]; pf5 = g[5 * 256]; pf6 = g[6 * 256]; pf7 = g[7 * 256]; pf8 = g[8 * 256]; pf9 = g[9 * 256]; pf10 = g[10 * 256]; pf11 = g[11 * 256]; pf12 = g[12 * 256]; pf13 = g[13 * 256];
  }
  for (int step = 0; step < NCH; ++step) {
    const int n = d ? (step < 4 ? 3 - step : 263 - step) : step;
    char* frc = p.ws + WS_FRAGS + (size_t)(chain * NCH + n) * FRAG_ITEM;
    __syncthreads();
    sfr[0 * 256 + tid] = pf0; sfr[1 * 256 + tid] = pf1; sfr[2 * 256 + tid] = pf2; sfr[3 * 256 + tid] = pf3; sfr[4 * 256 + tid] = pf4; sfr[5 * 256 + tid] = pf5; sfr[6 * 256 + tid] = pf6; sfr[7 * 256 + tid] = pf7; sfr[8 * 256 + tid] = pf8; sfr[9 * 256 + tid] = pf9; sfr[10 * 256 + tid] = pf10; sfr[11 * 256 + tid] = pf11; sfr[12 * 256 + tid] = pf12; sfr[13 * 256 + tid] = pf13;
    __syncthreads();
    f32x16 Vn[2], O[2];
    const uint4* fuc = reinterpret_cast<const uint4*>(frc + FR_U) + (size_t)(sl * 128 + lane) * 2;
    const uint4 un0 = fuc[0], un1 = fuc[1], un2 = fuc[128], un3 = fuc[129];
    Vn[0] = zero16(); Vn[1] = zero16();
    O[0] = zero16(); O[1] = zero16();
    {
      const int s1 = step + 1 < NCH ? step + 1 : step;
      const int n1 = d ? (s1 < 4 ? 3 - s1 : 263 - s1) : s1;
      const char* fr = p.ws + WS_FRAGS + (size_t)(chain * NCH + n1) * FRAG_ITEM;
      const uint4* g = reinterpret_cast<const uint4*>(fr) + tid;
      pf0 = g[0 * 256]; pf1 = g[1 * 256]; pf2 = g[2 * 256]; pf3 = g[3 * 256]; pf4 = g[4 * 256]; pf5 = g[5 * 256]; pf6 = g[6 * 256]; pf7 = g[7 * 256]; pf8 = g[8 * 256]; pf9 = g[9 * 256]; pf10 = g[10 * 256]; pf11 = g[11 * 256]; pf12 = g[12 * 256]; pf13 = g[13 * 256];
    }
    const uint4* lw = sfr + lane;
    const uint4* lq = sfr + 1024 + lane;
    const uint4* lk = sfr + 2048 + lane;
    const uint4* la = sfr + 3072 + lane;
#pragma unroll
    for (int ks = 0; ks < 8; ++ks) {
      const bf16x8 sb = pack_step(S[ks >> 1], ks & 1);
#pragma unroll
      for (int mt = 0; mt < 2; ++mt) {
        Vn[mt] = mfma32(__builtin_bit_cast(bf16x8, lw[(mt * 8 + ks) * 64]), sb, Vn[mt]);
        O[mt] = mfma32(__builtin_bit_cast(bf16x8, lq[(mt * 8 + ks) * 64]), sb, O[mt]);
      }
    }
    {
      const uint4 a = un0, b2 = un1;
      Vn[0][0] += bflo(a.x); Vn[0][1] += bfhi(a.x); Vn[0][2] += bflo(a.y); Vn[0][3] += bfhi(a.y);
      Vn[0][4] += bflo(a.z); Vn[0][5] += bfhi(a.z); Vn[0][6] += bflo(a.w); Vn[0][7] += bfhi(a.w);
      Vn[0][8] += bflo(b2.x); Vn[0][9] += bfhi(b2.x); Vn[0][10] += bflo(b2.y); Vn[0][11] += bfhi(b2.y);
      Vn[0][12] += bflo(b2.z); Vn[0][13] += bfhi(b2.z); Vn[0][14] += bflo(b2.w); Vn[0][15] += bfhi(b2.w);
    }
    {
      const uint4 a = un2, b2 = un3;
      Vn[1][0] += bflo(a.x); Vn[1][1] += bfhi(a.x); Vn[1][2] += bflo(a.y); Vn[1][3] += bfhi(a.y);
      Vn[1][4] += bflo(a.z); Vn[1][5] += bfhi(a.z); Vn[1][6] += bflo(a.w); Vn[1][7] += bfhi(a.w);
      Vn[1][8] += bflo(b2.x); Vn[1][9] += bfhi(b2.x); Vn[1][10] += bflo(b2.y); Vn[1][11] += bfhi(b2.y);
      Vn[1][12] += bflo(b2.z); Vn[1][13] += bfhi(b2.z); Vn[1][14] += bflo(b2.w); Vn[1][15] += bfhi(b2.w);
    }
    bf16x8 Vb[2][2];
#pragma unroll
    for (int mt = 0; mt < 2; ++mt) { Vb[mt][0] = pack_step(Vn[mt], 0); Vb[mt][1] = pack_step(Vn[mt], 1); }
#pragma unroll
    for (int it = 0; it < 2; ++it)
#pragma unroll
      for (int ks = 0; ks < 4; ++ks) O[it] = mfma32(__builtin_bit_cast(bf16x8, la[(it * 4 + ks) * 64]), Vb[ks >> 1][ks & 1], O[it]);
    const float gl = GL[n];
#pragma unroll
    for (int kt = 0; kt < 4; ++kt) {
#pragma unroll
      for (int i = 0; i < 16; ++i) S[kt][i] *= gl;
#pragma unroll
      for (int ks = 0; ks < 4; ++ks) S[kt] = mfma32(__builtin_bit_cast(bf16x8, lk[(kt * 4 + ks) * 64]), Vb[ks >> 1][ks & 1], S[kt]);
    }
    uint4* fo = reinterpret_cast<uint4*>(frc + FR_U) + (size_t)(sl * 128 + lane) * 2;
#pragma unroll
    for (int mt = 0; mt < 2; ++mt) {
      fo[mt * 128] = make_uint4(pk2(O[mt][0], O[mt][1]), pk2(O[mt][2], O[mt][3]), pk2(O[mt][4], O[mt][5]), pk2(O[mt][6], O[mt][7]));
      fo[mt * 128 + 1] = make_uint4(pk2(O[mt][8], O[mt][9]), pk2(O[mt][10], O[mt][11]), pk2(O[mt][12], O[mt][13]), pk2(O[mt][14], O[mt][15]));
    }
  }
  __syncthreads();
}

DI void phase_gdn_finish(const Params& p, char* smem) {
  u16* so = (u16*)smem;
  const u16* zb = (const u16*)(p.ws + WS_Z);
  u16* mix = (u16*)(p.ws + WS_MIX);
  const float* on = p.in[I_ONORM];
  const int tid = opaque_tid();
  for (int item = blockIdx.x; item < 2 * NCH * 4; item += gridDim.x) {
    const int h = item & 3, n = (item >> 2) % NCH, b = item / (4 * NCH);
    const int row0 = n < 4 ? b * CTXL + n * 64 : LAT0 + b * SEQ + (n - 4) * 64;
#pragma unroll
    for (int d = 0; d < 2; ++d) {
      const uint4* src = reinterpret_cast<const uint4*>(p.ws + WS_FRAGS + (size_t)(((b * 2 + d) * 4 + h) * NCH + n) * FRAG_ITEM + FR_U);
      uint4* dst = reinterpret_cast<uint4*>(so + d * 8192);
#pragma unroll
      for (int i = 0; i < 4; ++i) dst[tid + 256 * i] = src[tid + 256 * i];
    }
    __syncthreads();
    const int t = tid >> 2, sl = tid & 3;
    float v[32]; float ss = 0.f;
    {
      const int i0 = t, i1 = 63 - t;
      const int mt0 = i0 >> 5, m0 = i0 & 31, hh0 = (m0 >> 2) & 1, rg0 = (m0 & 3) + 4 * (m0 >> 3);
      const int mt1 = i1 >> 5, m1 = i1 & 31, hh1 = (m1 >> 2) & 1, rg1 = (m1 & 3) + 4 * (m1 >> 3);
#pragma unroll
      for (int e = 0; e < 32; ++e) {
        const float a = bf2f(so[((sl * 2 + mt0) * 64 + hh0 * 32 + e) * 16 + rg0]);
        const float c = bf2f(so[8192 + ((sl * 2 + mt1) * 64 + hh1 * 32 + e) * 16 + rg1]);
        v[e] = a + c; ss += v[e] * v[e];
      }
    }
    ss += __shfl_xor(ss, 1); ss += __shfl_xor(ss, 2);
    const float rinv = rsqrtf(ss * (1.f / 128.f) + EPSF);
    const u16* zr = zb + (size_t)(row0 + t) * 512 + h * 128 + sl * 32;
    u16* mr = mix + (size_t)(row0 + t) * 1024 + 512 + h * 128 + sl * 32;
    uint4 zq0 = *reinterpret_cast<const uint4*>(zr), zq1 = *reinterpret_cast<const uint4*>(zr + 8);
    uint4 zq2 = *reinterpret_cast<const uint4*>(zr + 16), zq3 = *reinterpret_cast<const uint4*>(zr + 24);
#pragma unroll
    for (int e8 = 0; e8 < 4; ++e8) {
      const uint4 zz = e8 == 0 ? zq0 : (e8 == 1 ? zq1 : (e8 == 2 ? zq2 : zq3));
      const u32 zw[4] = {zz.x, zz.y, zz.z, zz.w};
      u32 w[4];
#pragma unroll
      for (int q = 0; q < 4; ++q) {
        const int e = e8 * 8 + 2 * q;
        const float o0 = v[e] * rinv * on[sl * 32 + e] * siluf_fast(bflo(zw[q]));
        const float o1 = v[e + 1] * rinv * on[sl * 32 + e + 1] * siluf_fast(bfhi(zw[q]));
        w[q] = pk2(o0, o1);
      }
      *reinterpret_cast<uint4*>(mr + e8 * 8) = make_uint4(w[0], w[1], w[2], w[3]);
    }
    __syncthreads();
  }
}

DI void phase_lru_conv(const Params& p) {
  const u16* ur = (const u16*)(p.ws + WS_UR);
  u16* xc = (u16*)(p.ws + WS_XC);
  const float* cw = p.in[I_OCONVW];
  const float* cb = p.in[I_OCONVB];
  const size_t total = (size_t)MROWS * 128;
  for (size_t idx = (size_t)blockIdx.x * 256 + opaque_tid(); idx < total; idx += (size_t)gridDim.x * 256) {
    const int row = (int)(idx >> 7), c0 = (int)(idx & 127) * 8;
    int pos, slen;
    if (row < LAT0) { pos = row & (CTXL - 1); slen = CTXL; } else { pos = (row - LAT0) & (SEQ - 1); slen = SEQ; }
    float a[8];
#pragma unroll
    for (int e = 0; e < 8; ++e) a[e] = cb[c0 + e];
#pragma unroll
    for (int j = 0; j < 4; ++j) {
      const int pp = pos + j - 2;
      if (pp >= 0 && pp < slen) {
        const uint4 v = *reinterpret_cast<const uint4*>(ur + (size_t)(row + j - 2) * DM + c0);
        const float4 w0 = *reinterpret_cast<const float4*>(cw + j * 1024 + c0);
        const float4 w1 = *reinterpret_cast<const float4*>(cw + j * 1024 + c0 + 4);
        a[0] += w0.x * bflo(v.x); a[1] += w0.y * bfhi(v.x); a[2] += w0.z * bflo(v.y); a[3] += w0.w * bfhi(v.y);
        a[4] += w1.x * bflo(v.z); a[5] += w1.y * bfhi(v.z); a[6] += w1.z * bflo(v.w); a[7] += w1.w * bfhi(v.w);
      }
    }
    *reinterpret_cast<uint4*>(xc + (size_t)row * DM + c0) = make_uint4(pk2(a[0], a[1]), pk2(a[2], a[3]), pk2(a[4], a[5]), pk2(a[6], a[7]));
  }
}

DI int chunk_row0(int b, int n) { return n < 4 ? b * CTXL + n * 64 : LAT0 + b * SEQ + (n - 4) * 64; }
DI void phase_lru_pass1(const Params& p) {
  const u16* ab = (const u16*)(p.ws + WS_AB);
  float* ph = (float*)(p.ws + WS_PH);
  const int total = 2 * 2 * NCH * 512;
  for (int idx = blockIdx.x * 256 + opaque_tid(); idx < total; idx += gridDim.x * 256) {
    const int cp = idx & 511, n = (idx >> 9) % NCH, b = ((idx >> 9) / NCH) & 1, d = (idx >> 9) / (2 * NCH);
    const u16* la = ab + (size_t)d * 2 * MROWS * DM + (size_t)chunk_row0(b, n) * DM + 2 * cp;
    const u16* bb = la + (size_t)MROWS * DM;
    float P0 = 0.f, H0 = 0.f, P1 = 0.f, H1 = 0.f;
#pragma unroll 8
    for (int i = 0; i < 64; ++i) {
      const int t = d ? 63 - i : i;
      const u32 lg = *reinterpret_cast<const u32*>(la + (size_t)t * DM);
      const u32 bv = *reinterpret_cast<const u32*>(bb + (size_t)t * DM);
      const float l0 = bflo(lg), l1 = bfhi(lg);
      H0 = __expf(l0) * H0 + bflo(bv); P0 += l0;
      H1 = __expf(l1) * H1 + bfhi(bv); P1 += l1;
    }
    const size_t o = ((size_t)((d * 2 + b) * NCH + n) * 1024 + 2 * cp) * 2;
    *reinterpret_cast<float4*>(ph + o) = make_float4(P0, H0, P1, H1);
  }
}
DI void phase_lru_pass2(const Params& p) {
  const float2* __restrict__ ph = (const float2*)(p.ws + WS_PH);
  float* __restrict__ cin = (float*)(p.ws + WS_CIN);
  const int total = 2 * 2 * 1024;
  for (int idx = blockIdx.x * 256 + opaque_tid(); idx < total; idx += gridDim.x * 256) {
    const int ch = idx & 1023, b = (idx >> 10) & 1, d = idx >> 11;
    float hcar = 0.f;
    for (int s0 = 0; s0 < NCH; s0 += 20) {
      float2 v[20];
#pragma unroll
      for (int u = 0; u < 20; ++u) {
        const int step = s0 + u;
        const int n = d ? (step < 4 ? 3 - step : 263 - step) : step;
        v[u] = ph[(size_t)((d * 2 + b) * NCH + n) * 1024 + ch];
      }
#pragma unroll
      for (int u = 0; u < 20; ++u) {
        const int step = s0 + u;
        const int n = d ? (step < 4 ? 3 - step : 263 - step) : step;
        cin[(size_t)((d * 2 + b) * NCH + n) * 1024 + ch] = hcar;
        hcar = __expf(v[u].x) * hcar + v[u].y;
      }
    }
  }
}
DI float gelu_tanh(float x) {
  const float u = 0.7978845608028654f * (x + 0.044715f * x * x * x);
  const float t = 1.f - 2.f * __builtin_amdgcn_rcpf(1.f + __expf(2.f * u));
  return 0.5f * x * (1.f + t);
}
DI void phase_lru_pass3(const Params& p) {
  const u16* ab = (const u16*)(p.ws + WS_AB);
  const float* cin = (const float*)(p.ws + WS_CIN);
  u16* ug = (u16*)(p.ws + WS_UG);
  const int total = 2 * 256 * 512;
  for (int idx = blockIdx.x * 256 + opaque_tid(); idx < total; idx += gridDim.x * 256) {
    const int cp = idx & 511, nl = (idx >> 9) & 255, b = idx >> 17, n = nl + 4;
    const size_t rowoff = (size_t)chunk_row0(b, n) * DM + 2 * cp;
    u32 hf[64];
    {
      const u16* la = ab + rowoff;
      const u16* bb = la + (size_t)MROWS * DM;
      const float2 c2 = *reinterpret_cast<const float2*>(cin + (size_t)((0 * 2 + b) * NCH + n) * 1024 + 2 * cp);
      float h0 = c2.x, h1 = c2.y;
#pragma unroll
      for (int i = 0; i < 64; ++i) {
        const u32 lg = *reinterpret_cast<const u32*>(la + (size_t)i * DM);
        const u32 bv = *reinterpret_cast<const u32*>(bb + (size_t)i * DM);
        h0 = __expf(bflo(lg)) * h0 + bflo(bv);
        h1 = __expf(bfhi(lg)) * h1 + bfhi(bv);
        hf[i] = pk2(h0, h1);
      }
    }
    {
      const u16* la = ab + (size_t)2 * MROWS * DM + rowoff;
      const u16* bb = la + (size_t)MROWS * DM;
      const float2 c2 = *reinterpret_cast<const float2*>(cin + (size_t)((1 * 2 + b) * NCH + n) * 1024 + 2 * cp);
      float h0 = c2.x, h1 = c2.y;
      u16* y = ug + ((size_t)(b * SEQ + nl * 64)) * DM + 2 * cp;
#pragma unroll
      for (int g4 = 3; g4 >= 0; --g4) {
        u32 yv[16], lgv[16], bvv[16];
#pragma unroll
        for (int i = 0; i < 16; ++i) {
          yv[i] = *reinterpret_cast<const u32*>(y + (size_t)(g4 * 16 + i) * DM);
          lgv[i] = *reinterpret_cast<const u32*>(la + (size_t)(g4 * 16 + i) * DM);
          bvv[i] = *reinterpret_cast<const u32*>(bb + (size_t)(g4 * 16 + i) * DM);
        }
#pragma unroll
        for (int i = 15; i >= 0; --i) {
          h0 = __expf(bflo(lgv[i])) * h0 + bflo(bvv[i]);
          h1 = __expf(bfhi(lgv[i])) * h1 + bfhi(bvv[i]);
          const u32 f = hf[g4 * 16 + i];
          *reinterpret_cast<u32*>(y + (size_t)(g4 * 16 + i) * DM) =
              pk2(gelu_tanh(bflo(yv[i])) * (bflo(f) + h0), gelu_tanh(bfhi(yv[i])) * (bfhi(f) + h1));
        }
      }
    }
  }
}
#define XB_TMO      128
#define XB_XCNT(j)  (256  + 64 * (j))
#define XB_XSUB(j)  (1280 + 64 * (j))
#define XB_XGEN(j)  (2304 + 64 * (j))
#define XB_TOP      3328
#define XB_TOPGEN   3392
#define XCD_BAR_WORDS 3456
#define XB_SPIN_CAP (1u << 18)
#define LAS __attribute__((address_space(3)))

__device__ __forceinline__ unsigned xb_ld(unsigned* p)              { return __hip_atomic_load(p, __ATOMIC_RELAXED, __HIP_MEMORY_SCOPE_AGENT); }
__device__ __forceinline__ unsigned xb_add(unsigned* p, unsigned v) { return __hip_atomic_fetch_add(p, v, __ATOMIC_RELAXED, __HIP_MEMORY_SCOPE_AGENT); }
__device__ __forceinline__ unsigned xb_xcc_id() { return (unsigned)__builtin_amdgcn_s_getreg((3 << 11) | 20) & 0xFu; }
#define XB_SPIN(cond, bar) do { unsigned _sp = 0; while (cond) { __builtin_amdgcn_s_sleep(1); \
    if ((++_sp & 255u) == 0u) { if (xb_ld(&(bar)[XB_TMO])) break; if (_sp > XB_SPIN_CAP) { atomicAdd(&(bar)[XB_TMO], 1u); break; } } } } while (0)

struct XcdBarrier {
    unsigned* bar; unsigned x;
    volatile LAS unsigned* st;
};

__device__ __forceinline__ XcdBarrier xcd_barrier_post(unsigned* bar, volatile LAS unsigned* st) {
    XcdBarrier b; b.bar = bar; b.x = xb_xcc_id(); b.st = st;
    if (threadIdx.x == 0) (void)xb_add(&bar[XB_XCNT(b.x)], 1u);
    return b;
}
__device__ __forceinline__ void xcd_barrier_complete(unsigned* bar, unsigned x, unsigned& nloc, unsigned& nx) {
    const unsigned G = gridDim.x * gridDim.y * gridDim.z;
    unsigned sum, cnt, mine, sp = 0u;
    for (;;) {
        sum = 0u; cnt = 0u; mine = 0u;
#pragma unroll
        for (unsigned j = 0; j < 16; ++j) { const unsigned c = xb_ld(&bar[XB_XCNT(j)]); sum += c; cnt += (c > 0u) ? 1u : 0u; mine = (j == x) ? c : mine; }
        if (sum == G) break;
        __builtin_amdgcn_s_sleep(1);
        if ((++sp & 255u) == 0u) { if (xb_ld(&bar[XB_TMO])) break; if (sp > XB_SPIN_CAP) { atomicAdd(&bar[XB_TMO], 1u); break; } }
    }
    nloc = mine > 0u ? mine : 1u; nx = cnt > 0u ? cnt : 1u;
}

__device__ __forceinline__ void xcd_barrier(const XcdBarrier& b) {
    asm volatile("s_waitcnt vmcnt(0)" ::: "memory");
    __syncthreads();
    if (opaque_tid() == 0) {
        unsigned* bar = b.bar;
        __builtin_amdgcn_s_waitcnt(0);
        unsigned nloc = b.st[0], nx = b.st[1];
        if (nloc == 0u) { xcd_barrier_complete(bar, b.x, nloc, nx); b.st[0] = nloc; b.st[1] = nx; }
        const unsigned old = xb_add(&bar[XB_XSUB(b.x)], 1u);
        const unsigned gen = old / nloc;
        if (old + 1u == (gen + 1u) * nloc) {
            __builtin_amdgcn_fence(__ATOMIC_RELEASE, "agent");
            asm volatile("s_waitcnt vmcnt(0)" ::: "memory");
            const unsigned og = xb_add(&bar[XB_TOP], 1u);
            const unsigned tg = og / nx;
            if (og + 1u == (tg + 1u) * nx) xb_add(&bar[XB_TOPGEN], 1u);
            else XB_SPIN(xb_ld(&bar[XB_TOPGEN]) == tg, bar);
            __builtin_amdgcn_fence(__ATOMIC_ACQUIRE, "agent");
            xb_add(&bar[XB_XGEN(b.x)], 1u);
            asm volatile("s_waitcnt vmcnt(0)" ::: "memory");
        } else {
            XB_SPIN(xb_ld(&bar[XB_XGEN(b.x)]) == gen, bar);
            __builtin_amdgcn_fence(__ATOMIC_ACQUIRE, "agent");
            asm volatile("s_waitcnt vmcnt(0)" ::: "memory");
        }
    }
    __syncthreads();
}


template <int PH>
DI void run_phase(const Params& p, char* smem) {
  char* ws = p.ws;
  const float* MOD = (const float*)(ws + WS_MOD);
  float* HC = (float*)(ws + WS_HCTX);
  if constexpr (PH == 0) { phase_convert(p, smem); phase_mod(p, smem); }
  else if constexpr (PH == 1) phase_modulate(p.in[I_CTX], p.in[I_X], p.in[I_EN1], MOD, 0, 0, (u16*)(ws + WS_A));
  else if constexpr (PH == 2) {
    EpiIn0 e{(u16*)((char*)p.out + DO_QK), (u16*)(ws + WS_VRAW), (u16*)(ws + WS_U0G), (u16*)(ws + WS_Z), (float*)(ws + WS_G0)};
    gemm_phase4((const u16*)(ws + WS_A), 1024, (const u16*)(ws + WS_WT0IN), 1024, 1024, 0, 130, 29, smem, e);
  }
  else if constexpr (PH == 3) phase_da_prep(p, smem);
  else if constexpr (PH == 4) phase_gdn_prep(p, smem);
  else if constexpr (PH == 5) { }
  else if constexpr (PH == 6) { if (blockIdx.x < 16) gdn_scan_chain(p, smem, blockIdx.x); phase_da_attn(p, smem); }
  else if constexpr (PH == 7) phase_gdn_finish(p, smem);
  else if constexpr (PH == 8) {
    EpiResid e{p.in[I_CTX], p.in[I_X], HC, p.out, MOD + 2 * 1024};
    gemm_phase((const u16*)(ws + WS_MIX), 1024, (const u16*)(ws + WS_WT0OUT), 1024, 1024, 0, 260, 8, 1 << 20, smem, e);
  }
  else if constexpr (PH == 9) phase_modulate(HC, p.out, p.in[I_EN2], MOD, 3, 0, (u16*)(ws + WS_A));
  else if constexpr (PH == 10) {
    EpiSwiglu e{(u16*)(ws + WS_ACT)};
    gemm_phase4((const u16*)(ws + WS_A), 1024, (const u16*)(ws + WS_WT0GU), 1024, 1024, 0, 130, 44, smem, e);
  }
  else if constexpr (PH == 11) {
    EpiResid e{HC, p.out, HC, p.out, MOD + 5 * 1024};
    gemm_phase((const u16*)(ws + WS_ACT), FFH, (const u16*)(ws + WS_WT0DN), FFH, FFH, 0, 260, 8, 1 << 20, smem, e);
  }
  else if constexpr (PH == 12) phase_modulate(HC, p.out, p.in[I_ON1], MOD + 3 * 6144, 0, 0, (u16*)(ws + WS_A));
  else if constexpr (PH == 13) {
    EpiIn1 e{(u16*)(ws + WS_UG), (u16*)(ws + WS_UR)};
    gemm_phase4((const u16*)(ws + WS_A), 1024, (const u16*)(ws + WS_WT1IN), 1024, 1024, 0, 130, 16, smem, e);
  }
  else if constexpr (PH == 14) phase_lru_conv(p);
  else if constexpr (PH == 15) {
    EpiGates e{(const u16*)(ws + WS_XC), (u16*)(ws + WS_AB), p.in[I_OBR], p.in[I_OBI], p.in[I_OLAM]};
    gemm_phase((const u16*)(ws + WS_XC), 1024, (const u16*)(ws + WS_WT1G), 128, 128, 0, 260, 32, 4, smem, e);
  }
  else if constexpr (PH == 16) phase_lru_pass1(p);
  else if constexpr (PH == 17) phase_lru_pass2(p);
  else if constexpr (PH == 18) phase_lru_pass3(p);
  else if constexpr (PH == 19) {
    EpiResid e{nullptr, p.out, nullptr, p.out, MOD + 3 * 6144 + 2 * 1024};
    gemm_phase((const u16*)(ws + WS_UG) - (size_t)LAT0 * DM, 1024, (const u16*)(ws + WS_WT1OUT), 1024, 1024, 4, 256, 8, 1 << 20, smem, e);
  }
  else if constexpr (PH == 20) phase_modulate(HC, p.out, p.in[I_ON2], MOD + 3 * 6144, 3, LAT0, (u16*)(ws + WS_A));
  else if constexpr (PH == 21) {
    EpiSwiglu e{(u16*)(ws + WS_ACT)};
    gemm_phase4((const u16*)(ws + WS_A), 1024, (const u16*)(ws + WS_WT1GU), 1024, 1024, 2, 128, 44, smem, e);
  }
  else if constexpr (PH == 22) {
    EpiResid e{nullptr, p.out, nullptr, p.out, MOD + 3 * 6144 + 5 * 1024};
    gemm_phase((const u16*)(ws + WS_ACT), FFH, (const u16*)(ws + WS_WT1DN), FFH, FFH, 4, 256, 8, 1 << 20, smem, e);
  }
}
constexpr int NPHASE = 23;

#if MULTI_LAUNCH
template <int PH>
__global__ void __launch_bounds__(256, 2) phase_kernel(Params p) {
  __shared__ __attribute__((aligned(16))) char smem[SMEM_BYTES];
  run_phase<PH>(p, smem);
}
template <int PH>
static void launch_all(const Params& p, int grid, hipStream_t stream) {
  if constexpr (PH < NPHASE) {
    hipLaunchKernelGGL(phase_kernel<PH>, dim3(grid), dim3(256), 0, stream, p);
    launch_all<PH + 1>(p, grid, stream);
  }
}
#else
template <int PH>
DI void run_all(const Params& p, char* smem, cg::grid_group& grid, const XcdBarrier& xb) {
  if constexpr (PH < NPHASE) {
    run_phase<PH>(p, smem);
    if constexpr (PH == PROBE_DUP || PH == PROBE_DUP2) { xcd_barrier(xb); run_phase<PH>(p, smem); }
    if constexpr (PH == 0) grid.sync();
    else if constexpr (PH + 1 < NPHASE && PH != 5) xcd_barrier(xb);
    run_all<PH + 1>(p, smem, grid, xb);
  }
}
__global__ void __launch_bounds__(256, 2) mega_kernel(Params p) {
  __shared__ __attribute__((aligned(16))) char smem[SMEM_BYTES];
  __shared__ uint4 xb_words;
  if (threadIdx.x == 0) xb_words = make_uint4(0u, 0u, 0u, 0u);
  if ((threadIdx.x & 63) == 0) g_wtab[hw_wave_slot()] = threadIdx.x >> 6;
  __syncthreads();
  cg::grid_group grid = cg::this_grid();
  XcdBarrier xb = xcd_barrier_post((unsigned*)(p.ws + WS_BAR), (volatile LAS unsigned*)&xb_words);
  for (int i = 0; i < PROBE_SYNCS; ++i) xcd_barrier(xb);
  run_all<0>(p, smem, grid, xb);
}
#endif

extern "C" void kernel_launch(void* const* d_in, const int* in_sizes, int n_in, void* d_out, int out_size, void* d_ws, size_t ws_size,
                              hipStream_t stream) {
  if (n_in != 38 || ws_size < WS_NEED || out_size != 2 * SEQ * DM) {
    fprintf(stderr, "kernel_launch: unexpected shapes (n_in %d, ws %zu, out %d)\n", n_in, ws_size, out_size);
    return;
  }
  Params p{};
  for (int i = 0; i < 38; ++i) p.in[i] = (const float*)d_in[i];
  p.out = (float*)d_out;
  p.ws = (char*)d_ws;
#if MULTI_LAUNCH
  launch_all<0>(p, 512, stream);
#else
  static int grid_blocks = 0;
  if (!grid_blocks) {
    int dev = 0, cus = 0, per_cu = 0;
    hipGetDevice(&dev);
    hipDeviceGetAttribute(&cus, hipDeviceAttributeMultiprocessorCount, dev);
    hipOccupancyMaxActiveBlocksPerMultiprocessor(&per_cu, mega_kernel, 256, 0);
    if (per_cu < 1) per_cu = 1;
    if (per_cu > 2) per_cu = 2;
    grid_blocks = cus * per_cu;
  }
  (void)hipMemsetAsync((char*)d_ws + WS_CNT, 0, 65536 + XCD_BAR_WORDS * 4, stream);
  void* args[] = {&p};
  hipError_t e = hipLaunchCooperativeKernel((void*)mega_kernel, dim3(grid_blocks), dim3(256), args, 0, stream);
  if (e != hipSuccess) fprintf(stderr, "cooperative launch failed: %s (grid %d)\n", hipGetErrorString(e), grid_blocks);
#endif
}
```

```cpp
#include <hip/hip_runtime.h>
#include <hip/hip_cooperative_groups.h>
#include <cstdio>
namespace cg = cooperative_groups;

#ifndef MULTI_LAUNCH
#define MULTI_LAUNCH 0
#endif
#ifndef PROBE_DUP
#define PROBE_DUP -1
#define PROBE_DUP2 -1
#define PROBE_SYNCS 0
#endif

#define DI __device__ __forceinline__
typedef unsigned short u16;
typedef unsigned int u32;
using bf16x8 = __attribute__((ext_vector_type(8))) short;
using f32x16 = __attribute__((ext_vector_type(16))) float;
typedef __bf16 bf2_t __attribute__((ext_vector_type(2)));
typedef float f2_t __attribute__((ext_vector_type(2)));

constexpr int SEQ = 16384, CTXL = 256, DM = 1024, MROWS = 33280, LAT0 = 512;
constexpr int SK = 16640;
constexpr int FFH = 2816;
constexpr int NCH = 260;
constexpr float EPSF = 1e-6f;

constexpr size_t MiB = 1048576;
constexpr size_t WS_WT0IN = 0, WS_WT0OUT = 8 * MiB, WS_WT0GU = 10 * MiB, WS_WT0DN = 21 * MiB;
constexpr size_t WS_WT1IN = 27 * MiB, WS_WT1G = 31 * MiB, WS_WT1OUT = 32 * MiB, WS_WT1GU = 34 * MiB, WS_WT1DN = 45 * MiB;
constexpr size_t WS_MOD = 51 * MiB, WS_G0 = 52 * MiB, WS_HCTX = 55 * MiB, WS_GL = 57 * MiB, WS_PH = 58 * MiB;
constexpr size_t WS_CNT = 67 * MiB;
constexpr size_t WS_BAR = 67 * MiB + 65536;
constexpr size_t WS_BIG = 68 * MiB;
constexpr size_t WS_FRAGS = WS_BIG;
constexpr size_t WS_A = WS_BIG;
constexpr size_t WS_VRAW = WS_BIG + 65 * MiB;
constexpr size_t WS_ACT = WS_BIG + 65 * MiB;
constexpr size_t WS_U0G = 361 * MiB;
constexpr size_t WS_MIX = 361 * MiB;
constexpr size_t WS_Z = 459 * MiB;
constexpr size_t WS_UR = WS_BIG + 65 * MiB;
constexpr size_t WS_AB = WS_BIG;
constexpr size_t WS_XC = 328 * MiB;
constexpr size_t WS_UG = 393 * MiB;
constexpr size_t WS_CIN = 459 * MiB;
constexpr size_t WS_NEED = 512 * MiB;
constexpr size_t FRAG_ITEM = 73728;
constexpr size_t FR_W = 0, FR_Q = 16384, FR_KT = 32768, FR_AT = 49152, FR_U = 57344;
constexpr size_t DO_QK = 0, DO_VT = 65 * MiB;

struct Params {
  const float* in[38];
  float* out;
  char* ws;
};
enum { I_X = 0, I_C, I_CTX, I_CCTX, I_EN1, I_EN2, I_EADAW, I_EADAB, I_EWIN, I_EWOUT, I_QN, I_KN, I_LQ1, I_LK1, I_LQ2, I_LK2,
       I_SUBN, I_GCONV, I_ALOG, I_DTB, I_ONORM, I_EWGU, I_EWDN, I_ON1, I_ON2, I_OADAW, I_OADAB, I_OWIN, I_OCONVW, I_OCONVB,
       I_OWR, I_OBR, I_OWI, I_OBI, I_OLAM, I_OWOUT, I_OWGU, I_OWDN };

DI u32 pk2(float a, float b) { f2_t v = {a, b}; bf2_t r = __builtin_convertvector(v, bf2_t); return __builtin_bit_cast(u32, r); }
DI u16 f2bf(float a) { return (u16)(pk2(a, 0.f) & 0xffffu); }
DI float bf2f(u16 v) { return __uint_as_float(((u32)v) << 16); }
DI float bflo(u32 v) { return __uint_as_float(v << 16); }
DI float bfhi(u32 v) { return __uint_as_float(v & 0xffff0000u); }
DI int crow(int reg, int h) { return (reg & 3) + 8 * (reg >> 2) + 4 * h; }
DI int krow(int s, int h, int j) { return 16 * s + 8 * (j >> 2) + 4 * h + (j & 3); }
DI float sigmoidf_(float x) { return 1.f / (1.f + __expf(-x)); }
DI float siluf_(float x) { return x / (1.f + __expf(-x)); }
DI float siluf_fast(float x) { return x * __builtin_amdgcn_rcpf(1.f + __expf(-x)); }
DI float sigmoidf_fast(float x) { return __builtin_amdgcn_rcpf(1.f + __expf(-x)); }
DI float softplusf_(float x) { return x > 20.f ? x : log1pf(__expf(x)); }
DI float wave_sum(float v) {
#pragma unroll
  for (int o = 32; o >= 1; o >>= 1) v += __shfl_xor(v, o);
  return v;
}
DI f32x16 mfma32(bf16x8 a, bf16x8 b, f32x16 c) { return __builtin_amdgcn_mfma_f32_32x32x16_bf16(a, b, c, 0, 0, 0); }
DI bf16x8 ld8(const u16* p) { return *reinterpret_cast<const bf16x8*>(p); }
DI bf16x8 pack_step(const f32x16& x, int s) {
  uint4 r;
  r.x = pk2(x[8 * s + 0], x[8 * s + 1]); r.y = pk2(x[8 * s + 2], x[8 * s + 3]);
  r.z = pk2(x[8 * s + 4], x[8 * s + 5]); r.w = pk2(x[8 * s + 6], x[8 * s + 7]);
  return __builtin_bit_cast(bf16x8, r);
}
DI int row_cond(int row) { return row < LAT0 ? 2 : ((row - LAT0) >> 14); }
DI f32x16 zero16() { f32x16 z; for (int i = 0; i < 16; ++i) z[i] = 0.f; return z; }

__shared__ int g_wtab[64];
DI int hw_wave_slot() { return (int)((unsigned)__builtin_amdgcn_s_getreg((5 << 11) | 4) & 63u); }
DI int opaque_tid() {
  const int w = __builtin_amdgcn_readfirstlane(g_wtab[hw_wave_slot()]);
  int t = w * 64 + (int)__builtin_amdgcn_mbcnt_hi(~0u, __builtin_amdgcn_mbcnt_lo(~0u, 0u));
  asm volatile("" : "+v"(t));
  return t;
}
constexpr int SMEM_BYTES = 77824;

template <class RowFn>
DI void convert_weight(u16* dst, int nrows, int K, RowFn rowfn, char* smem, int& job_base, int njobs_total) {
  float* tile = (float*)smem;
  const int ktiles = K / 64, rtiles = nrows / 64, ntile = ktiles * rtiles;
  const int tid = opaque_tid();
  int first = blockIdx.x - (job_base % gridDim.x);
  if (first < 0) first += gridDim.x;
  for (int t = first; t < ntile; t += gridDim.x) {
    const int rt = t / ktiles, kt = t % ktiles;
    const int tx = tid & 63, ty = tid >> 6;
    int ld = 0;
    const float* src = rowfn(rt * 64 + tx, ld);
#pragma unroll 4
    for (int i = 0; i < 16; ++i) {
      const int k = ty + 4 * i;
      tile[k * 65 + tx] = src ? src[(size_t)(kt * 64 + k) * ld] : 0.f;
    }
    __syncthreads();
    const int r = tid >> 2, kq = (tid & 3) * 16;
    u32 w[8];
#pragma unroll
    for (int i = 0; i < 8; ++i) w[i] = pk2(tile[(kq + 2 * i) * 65 + r], tile[(kq + 2 * i + 1) * 65 + r]);
    uint4* d = reinterpret_cast<uint4*>(dst + (size_t)(rt * 64 + r) * K + kt * 64 + kq);
    d[0] = make_uint4(w[0], w[1], w[2], w[3]);
    d[1] = make_uint4(w[4], w[5], w[6], w[7]);
    __syncthreads();
  }
  job_base += ntile;
}

DI void phase_convert(const Params& p, char* smem) {
  int jb = 0;
  u16* ws16 = (u16*)p.ws;
  {
    const float* w = p.in[I_EWIN];
    convert_weight((u16*)(p.ws + WS_WT0IN), 3712, 1024, [=](int n, int& ld) { ld = 3600; return n < 3600 ? w + n : (const float*)nullptr; }, smem, jb, 0);
  }
  {
    const float* w = p.in[I_EWOUT];
    convert_weight((u16*)(p.ws + WS_WT0OUT), 1024, 1024, [=](int n, int& ld) { ld = 1024; return w + n; }, smem, jb, 0);
  }
  auto gu_row = [](const float* w, int n, int& ld) {
    ld = 2 * FFH;
    const int j = n >> 7, wq = n & 127, wn = wq >> 6, sub = (wq & 63) >> 5, c = wq & 31;
    const int hid = 64 * j + 32 * wn + c;
    return w + (sub ? FFH + hid : hid);
  };
  {
    const float* w = p.in[I_EWGU];
    convert_weight((u16*)(p.ws + WS_WT0GU), 2 * FFH, 1024, [=](int n, int& ld) { return gu_row(w, n, ld); }, smem, jb, 0);
  }
  {
    const float* w = p.in[I_EWDN];
    convert_weight((u16*)(p.ws + WS_WT0DN), 1024, FFH, [=](int n, int& ld) { ld = 1024; return w + n; }, smem, jb, 0);
  }
  {
    const float* w = p.in[I_OWIN];
    convert_weight((u16*)(p.ws + WS_WT1IN), 2048, 1024, [=](int n, int& ld) { ld = 2048; return w + n; }, smem, jb, 0);
  }
  {
    const float* wr = p.in[I_OWR];
    const float* wi = p.in[I_OWI];
    convert_weight((u16*)(p.ws + WS_WT1G), 4096, 128, [=](int n, int& ld) {
      ld = 128;
      const int kb = n >> 9, w512 = n & 511, jt = w512 >> 7, z = jt >> 1, half = jt & 1;
      const int wq = w512 & 127, wn = wq >> 6, sub = (wq & 63) >> 5, c = wq & 31;
      const int dch = half * 64 + wn * 32 + c;
      return (sub ? wi : wr) + (size_t)(z * 8 + kb) * 16384 + dch;
    }, smem, jb, 0);
  }
  {
    const float* w = p.in[I_OWOUT];
    convert_weight((u16*)(p.ws + WS_WT1OUT), 1024, 1024, [=](int n, int& ld) { ld = 1024; return w + n; }, smem, jb, 0);
  }
  {
    const float* w = p.in[I_OWGU];
    convert_weight((u16*)(p.ws + WS_WT1GU), 2 * FFH, 1024, [=](int n, int& ld) { return gu_row(w, n, ld); }, smem, jb, 0);
  }
  {
    const float* w = p.in[I_OWDN];
    convert_weight((u16*)(p.ws + WS_WT1DN), 1024, FFH, [=](int n, int& ld) { ld = 1024; return w + n; }, smem, jb, 0);
  }
  (void)ws16;
}

DI void phase_mod(const Params& p, char* smem) {
  float* sc = (float*)smem;
  float* part = sc + 3 * 1024;
  const int tid = opaque_tid();
  bool loaded = false;
  for (int item = blockIdx.x; item < 192; item += gridDim.x) {
    if (!loaded) {
      for (int i = tid; i < 3072; i += 256) {
        const int cnd = i >> 10, k = i & 1023;
        const float v = cnd < 2 ? p.in[I_C][cnd * 1024 + k] : p.in[I_CCTX][k];
        sc[i] = siluf_(v);
      }
      loaded = true;
      __syncthreads();
    }
    const int l = item / 96, cgp = item % 96;
    const float* W = p.in[l ? I_OADAW : I_EADAW];
    const float* Bv = p.in[l ? I_OADAB : I_EADAB];
    const int col = cgp * 64 + (tid & 63), kq = tid >> 6;
    float a0 = 0.f, a1 = 0.f, a2 = 0.f;
#pragma unroll 8
    for (int k = kq * 256; k < kq * 256 + 256; ++k) {
      const float w = W[(size_t)k * 6144 + col];
      a0 += sc[k] * w; a1 += sc[1024 + k] * w; a2 += sc[2048 + k] * w;
    }
    part[(kq * 3 + 0) * 64 + (tid & 63)] = a0;
    part[(kq * 3 + 1) * 64 + (tid & 63)] = a1;
    part[(kq * 3 + 2) * 64 + (tid & 63)] = a2;
    __syncthreads();
    if (tid < 192) {
      const int cnd = tid >> 6, c = tid & 63;
      float s = Bv[cgp * 64 + c];
      for (int q = 0; q < 4; ++q) s += part[(q * 3 + cnd) * 64 + c];
      ((float*)(p.ws + WS_MOD))[(size_t)(l * 3 + cnd) * 6144 + cgp * 64 + c] = s;
    }
    __syncthreads();
  }
}

DI void phase_modulate(const float* hc, const float* hx, const float* gain, const float* mod, int shift_idx, int row_lo, u16* Aout) {
  const int tid0 = opaque_tid();
  const int lane = tid0 & 63, wid = tid0 >> 6;
  const int nw = gridDim.x * 4;
  for (int rowA = row_lo + blockIdx.x * 4 + wid; rowA < MROWS; rowA += 2 * nw) {
    const int rowB = rowA + nw;
    const bool hasB = rowB < MROWS;
    const int rB = hasB ? rowB : rowA;
    const float* srcA = rowA < LAT0 ? hc + (size_t)rowA * DM : hx + (size_t)(rowA - LAT0) * DM;
    const float* srcB = rB < LAT0 ? hc + (size_t)rB * DM : hx + (size_t)(rB - LAT0) * DM;
    float4 va[4], vb[4];
#pragma unroll
    for (int i = 0; i < 4; ++i) {
      va[i] = *reinterpret_cast<const float4*>(srcA + (i * 64 + lane) * 4);
      vb[i] = *reinterpret_cast<const float4*>(srcB + (i * 64 + lane) * 4);
    }
    float sa = 0.f, sb = 0.f;
#pragma unroll
    for (int i = 0; i < 4; ++i) {
      sa += va[i].x * va[i].x + va[i].y * va[i].y + va[i].z * va[i].z + va[i].w * va[i].w;
      sb += vb[i].x * vb[i].x + vb[i].y * vb[i].y + vb[i].z * vb[i].z + vb[i].w * vb[i].w;
    }
    sa = wave_sum(sa); sb = wave_sum(sb);
    const float ra = rsqrtf(sa * (1.f / 1024.f) + EPSF), rb = rsqrtf(sb * (1.f / 1024.f) + EPSF);
    const float* shA = mod + (size_t)row_cond(rowA) * 6144 + shift_idx * 1024;
    const float* shB = mod + (size_t)row_cond(rB) * 6144 + shift_idx * 1024;
    uint2 oa[4], ob[4];
#pragma unroll
    for (int i = 0; i < 4; ++i) {
      const int c = (i * 64 + lane) * 4;
      const float4 g = *reinterpret_cast<const float4*>(gain + c);
      const float4 s1 = *reinterpret_cast<const float4*>(shA + c), c1 = *reinterpret_cast<const float4*>(shA + 1024 + c);
      const float4 s2 = *reinterpret_cast<const float4*>(shB + c), c2 = *reinterpret_cast<const float4*>(shB + 1024 + c);
      oa[i] = make_uint2(pk2(va[i].x * ra * g.x * (1.f + c1.x) + s1.x, va[i].y * ra * g.y * (1.f + c1.y) + s1.y),
                         pk2(va[i].z * ra * g.z * (1.f + c1.z) + s1.z, va[i].w * ra * g.w * (1.f + c1.w) + s1.w));
      ob[i] = make_uint2(pk2(vb[i].x * rb * g.x * (1.f + c2.x) + s2.x, vb[i].y * rb * g.y * (1.f + c2.y) + s2.y),
                         pk2(vb[i].z * rb * g.z * (1.f + c2.z) + s2.z, vb[i].w * rb * g.w * (1.f + c2.w) + s2.w));
    }
#pragma unroll
    for (int i = 0; i < 4; ++i) {
      const int c = (i * 64 + lane) * 4;
      *reinterpret_cast<uint2*>(Aout + (size_t)rowA * DM + c) = oa[i];
      if (hasB) *reinterpret_cast<uint2*>(Aout + (size_t)rowB * DM + c) = ob[i];
    }
  }
}

constexpr int LDT = 72;
template <class Epi>
DI void gemm_phase(const u16* __restrict__ A, int lda, const u16* __restrict__ Bt, int ldb, int K, int mt_lo, int mtiles, int ntiles,
                   int nt_per_group, char* smem, Epi epi) {
  u16* sA = (u16*)smem;
  u16* sB = sA + 2 * 128 * LDT;
  const int tid = opaque_tid(), lane = tid & 63, wid = __builtin_amdgcn_readfirstlane(tid >> 6), wm = wid >> 1, wn = wid & 1;
  const int lr = lane & 31, lh = lane >> 5;
  const int ldrow = tid >> 3, ldc = (tid & 7) * 8;
  const int nk = K / 64;
  const int total = mtiles * ntiles;
  const int per_xcd = (total + 7) >> 3;
  const int xcd = blockIdx.x & 7, qx = blockIdx.x >> 3, nq = gridDim.x >> 3;
  for (int v = qx; v < per_xcd; v += nq) {
    const int u = xcd * per_xcd + v;
    if (u >= total) break;
    const int gsz_full = 8 * ntiles;
    const int g = u / gsz_full, r = u - g * gsz_full;
    const int gm = min(8, mtiles - g * 8);
    const int mt = mt_lo + g * 8 + r % gm, nt = r / gm;
    const unsigned oA = (unsigned)(((mt * 128 + ldrow) * lda + (nt / nt_per_group) * K + ldc) * 2);
    const unsigned oB = (unsigned)(((nt * 128 + ldrow) * ldb + ldc) * 2);
    const char* Ab = (const char*)A;
    const char* Bb = (const char*)Bt;
    f32x16 acc[2][2];
    acc[0][0] = zero16(); acc[0][1] = zero16(); acc[1][0] = zero16(); acc[1][1] = zero16();
    uint4 xa0, xa1, xa2, xa3, xb0, xb1, xb2, xb3, ya0, ya1, ya2, ya3, yb0, yb1, yb2, yb3;
#define G_LOADX(KT) do { const unsigned ka_ = oA + (unsigned)(KT) * 128u, kb_ = oB + (unsigned)(KT) * 128u; \
      xa0 = *reinterpret_cast<const uint4*>(Ab + (ka_ + 0u * (unsigned)lda * 2u)); \
      xa1 = *reinterpret_cast<const uint4*>(Ab + (ka_ + 32u * (unsigned)lda * 2u)); \
      xa2 = *reinterpret_cast<const uint4*>(Ab + (ka_ + 64u * (unsigned)lda * 2u)); \
      xa3 = *reinterpret_cast<const uint4*>(Ab + (ka_ + 96u * (unsigned)lda * 2u)); \
      xb0 = *reinterpret_cast<const uint4*>(Bb + (kb_ + 0u * (unsigned)ldb * 2u)); \
      xb1 = *reinterpret_cast<const uint4*>(Bb + (kb_ + 32u * (unsigned)ldb * 2u)); \
      xb2 = *reinterpret_cast<const uint4*>(Bb + (kb_ + 64u * (unsigned)ldb * 2u)); \
      xb3 = *reinterpret_cast<const uint4*>(Bb + (kb_ + 96u * (unsigned)ldb * 2u)); } while (0)
#define G_LOADY(KT) do { const unsigned ka_ = oA + (unsigned)(KT) * 128u, kb_ = oB + (unsigned)(KT) * 128u; \
      ya0 = *reinterpret_cast<const uint4*>(Ab + (ka_ + 0u * (unsigned)lda * 2u)); \
      ya1 = *reinterpret_cast<const uint4*>(Ab + (ka_ + 32u * (unsigned)lda * 2u)); \
      ya2 = *reinterpret_cast<const uint4*>(Ab + (ka_ + 64u * (unsigned)lda * 2u)); \
      ya3 = *reinterpret_cast<const uint4*>(Ab + (ka_ + 96u * (unsigned)lda * 2u)); \
      yb0 = *reinterpret_cast<const uint4*>(Bb + (kb_ + 0u * (unsigned)ldb * 2u)); \
      yb1 = *reinterpret_cast<const uint4*>(Bb + (kb_ + 32u * (unsigned)ldb * 2u)); \
      yb2 = *reinterpret_cast<const uint4*>(Bb + (kb_ + 64u * (unsigned)ldb * 2u)); \
      yb3 = *reinterpret_cast<const uint4*>(Bb + (kb_ + 96u * (unsigned)ldb * 2u)); } while (0)
#define G_STOREX(BUF) do { u16* wa_ = sA + (BUF) * 128 * LDT + ldrow * LDT + ldc; u16* wb_ = sB + (BUF) * 128 * LDT + ldrow * LDT + ldc; \
      *reinterpret_cast<uint4*>(wa_) = xa0; *reinterpret_cast<uint4*>(wa_ + 32 * LDT) = xa1; \
      *reinterpret_cast<uint4*>(wa_ + 64 * LDT) = xa2; *reinterpret_cast<uint4*>(wa_ + 96 * LDT) = xa3; \
      *reinterpret_cast<uint4*>(wb_) = xb0; *reinterpret_cast<uint4*>(wb_ + 32 * LDT) = xb1; \
      *reinterpret_cast<uint4*>(wb_ + 64 * LDT) = xb2; *reinterpret_cast<uint4*>(wb_ + 96 * LDT) = xb3; } while (0)
#define G_STOREY(BUF) do { u16* wa_ = sA + (BUF) * 128 * LDT + ldrow * LDT + ldc; u16* wb_ = sB + (BUF) * 128 * LDT + ldrow * LDT + ldc; \
      *reinterpret_cast<uint4*>(wa_) = ya0; *reinterpret_cast<uint4*>(wa_ + 32 * LDT) = ya1; \
      *reinterpret_cast<uint4*>(wa_ + 64 * LDT) = ya2; *reinterpret_cast<uint4*>(wa_ + 96 * LDT) = ya3; \
      *reinterpret_cast<uint4*>(wb_) = yb0; *reinterpret_cast<uint4*>(wb_ + 32 * LDT) = yb1; \
      *reinterpret_cast<uint4*>(wb_ + 64 * LDT) = yb2; *reinterpret_cast<uint4*>(wb_ + 96 * LDT) = yb3; } while (0)
#define G_COMPUTE(BUF) do { \
      const u16* a_ = sA + (BUF) * 128 * LDT + (wm * 64 + lr) * LDT + lh * 8; \
      const u16* b_ = sB + (BUF) * 128 * LDT + (wn * 64 + lr) * LDT + lh * 8; \
      _Pragma("unroll") for (int ks = 0; ks < 4; ++ks) { \
        const bf16x8 a0 = ld8(a_ + ks * 16), a1 = ld8(a_ + 32 * LDT + ks * 16); \
        const bf16x8 b0 = ld8(b_ + ks * 16), b1 = ld8(b_ + 32 * LDT + ks * 16); \
        acc[0][0] = mfma32(a0, b0, acc[0][0]); acc[0][1] = mfma32(a0, b1, acc[0][1]); \
        acc[1][0] = mfma32(a1, b0, acc[1][0]); acc[1][1] = mfma32(a1, b1, acc[1][1]); } } while (0)
    G_LOADX(0);
    G_STOREX(0);
    G_LOADX(1);
    if (nk > 2) G_LOADY(2);
    __syncthreads();
    for (int kt = 0; kt < nk; kt += 2) {
      G_COMPUTE(0);
      G_STOREX(1);
      if (kt + 3 < nk) G_LOADX(kt + 3);
      __syncthreads();
      G_COMPUTE(1);
      if (kt + 2 < nk) G_STOREY(0);
      if (kt + 4 < nk) G_LOADY(kt + 4);
      __syncthreads();
    }
    { int lr_ = lr, lh_ = lh; asm volatile("" : "+v"(lr_), "+v"(lh_));
      epi(acc, mt * 128 + wm * 64, nt * 128 + wn * 64, nt, wn, lr_, lh_); }
  }
}


DI float dpp_xor1(float v) { return __builtin_bit_cast(float, __builtin_amdgcn_update_dpp(0, __builtin_bit_cast(int, v), 0xB1, 0xf, 0xf, true)); }
DI void store_bf16_pair(u16* dst, int ld, int row_e, int row_o, int col, float v_e, float v_o) {
  const bool odd = col & 1;
  const float recv = dpp_xor1(odd ? v_e : v_o);
  const u32 w = odd ? pk2(recv, v_o) : pk2(v_e, recv);
  *reinterpret_cast<u32*>(dst + (size_t)(odd ? row_o : row_e) * ld + (col & ~1)) = w;
}
struct EpiIn0 {
  u16 *qk, *vraw, *u0g, *z; float* g0;
  template <int MI>
  DI void operator()(f32x16 (&acc)[MI][2], int mb, int nb, int, int, int lr, int lh) const {
#pragma unroll
    for (int ni = 0; ni < 2; ++ni) {
      const int c0 = nb + ni * 32;
      u16* dst; int ld;
      if (c0 < 1024) { dst = qk + c0; ld = 1024; }
      else if (c0 < 1536) { dst = vraw + (c0 - 1024); ld = 512; }
      else if (c0 < 3072) { dst = u0g + (c0 - 1536); ld = 1536; }
      else if (c0 < 3584) { dst = z + (c0 - 3072); ld = 512; }
      else { dst = nullptr; ld = 0; }
#pragma unroll
      for (int mi = 0; mi < MI; ++mi) {
        if (dst) {
#pragma unroll
          for (int i = 0; i < 16; i += 2)
            store_bf16_pair(dst, ld, mb + mi * 32 + crow(i, lh), mb + mi * 32 + crow(i + 1, lh), lr, acc[mi][ni][i], acc[mi][ni][i + 1]);
        } else if (c0 == 3584 && lr < 16) {
#pragma unroll
          for (int i = 0; i < 16; ++i) g0[(size_t)(mb + mi * 32 + crow(i, lh)) * 16 + lr] = acc[mi][ni][i];
        }
      }
    }
  }
};
struct EpiResid {
  const float *hc_in, *hx_in; float *hc_out, *hx_out; const float* gate;
  DI void operator()(f32x16 (&acc)[2][2], int mb, int nb, int, int, int lr, int lh) const {
    const bool isc = mb < LAT0;
    if (isc && !hc_out) return;
    const float* in = isc ? hc_in + (size_t)mb * DM : hx_in + (size_t)(mb - LAT0) * DM;
    float* out = isc ? hc_out + (size_t)mb * DM : hx_out + (size_t)(mb - LAT0) * DM;
    const float* gt = gate + (size_t)row_cond(mb) * 6144;
#pragma unroll
    for (int ni = 0; ni < 2; ++ni) {
      const int col = nb + ni * 32 + lr;
      const float g = gt[col];
#pragma unroll
      for (int mi = 0; mi < 2; ++mi) {
#pragma unroll
        for (int i8 = 0; i8 < 16; i8 += 8) {
          float hv[8];
#pragma unroll
          for (int i = 0; i < 8; ++i) hv[i] = in[(size_t)(mi * 32 + crow(i8 + i, lh)) * DM + col];
#pragma unroll
          for (int i = 0; i < 8; ++i) out[(size_t)(mi * 32 + crow(i8 + i, lh)) * DM + col] = hv[i] + g * acc[mi][ni][i8 + i];
        }
      }
    }
  }
};
struct EpiSwiglu {
  u16* act;
  template <int MI>
  DI void operator()(f32x16 (&acc)[MI][2], int mb, int, int nt, int wn, int lr, int lh) const {
    const int hid = nt * 64 + wn * 32 + lr;
#pragma unroll
    for (int mi = 0; mi < MI; ++mi) {
#pragma unroll
      for (int i = 0; i < 16; i += 2) {
        const float a0 = siluf_fast(acc[mi][0][i]) * acc[mi][1][i], a1 = siluf_fast(acc[mi][0][i + 1]) * acc[mi][1][i + 1];
        store_bf16_pair(act, FFH, mb + mi * 32 + crow(i, lh), mb + mi * 32 + crow(i + 1, lh), hid, a0, a1);
      }
      __builtin_amdgcn_sched_barrier(0);
    }
  }
};
struct EpiIn1 {
  u16 *ug, *ur;
  template <int MI>
  DI void operator()(f32x16 (&acc)[MI][2], int mb, int nb, int, int, int lr, int lh) const {
#pragma unroll
    for (int mi = 0; mi < MI; ++mi)
#pragma unroll
      for (int ni = 0; ni < 2; ++ni) {
        const int col = nb + ni * 32 + lr;
#pragma unroll
        for (int i = 0; i < 16; ++i) {
          const int row = mb + mi * 32 + crow(i, lh);
          if (col < 1024) { if (row >= LAT0) ug[(size_t)(row - LAT0) * DM + col] = f2bf(acc[mi][ni][i]); }
          else ur[(size_t)row * DM + col - 1024] = f2bf(acc[mi][ni][i]);
        }
      }
  }
};
struct EpiGates {
  const u16* xc; u16* ab; const float *b_r, *b_i, *lam;
  DI void operator()(f32x16 (&acc)[2][2], int mb, int, int nt, int wn, int lr, int lh) const {
    const int kb = nt >> 2, jt = nt & 3, z = jt >> 1, half = jt & 1;
    const int ch = kb * 128 + half * 64 + wn * 32 + lr;
    const float br = b_r[z * 1024 + ch], bi = b_i[z * 1024 + ch];
    const float sp = softplusf_(-lam[z * 1024 + ch]);
    u16* la = ab + (size_t)z * 2 * MROWS * DM;
    u16* bb = la + (size_t)MROWS * DM;
#pragma unroll
    for (int mi = 0; mi < 2; ++mi) {
      float xv[16];
#pragma unroll
      for (int i = 0; i < 16; ++i) xv[i] = bf2f(xc[(size_t)(mb + mi * 32 + crow(i, lh)) * DM + ch]);
#pragma unroll
      for (int i = 0; i < 16; i += 2) {
        float lg[2], bv[2];
#pragma unroll
        for (int e = 0; e < 2; ++e) {
          const float r = sigmoidf_fast(acc[mi][0][i + e] + br), ig = sigmoidf_fast(acc[mi][1][i + e] + bi);
          lg[e] = -8.f * r * sp;
          const float a2 = __expf(2.f * lg[e]);
          bv[e] = __builtin_amdgcn_sqrtf(fmaxf(1.f - a2, 0.f)) * (ig * xv[i + e]);
        }
        const int re = mb + mi * 32 + crow(i, lh), ro = mb + mi * 32 + crow(i + 1, lh);
        store_bf16_pair(la, DM, re, ro, ch, lg[0], lg[1]);
        store_bf16_pair(bb, DM, re, ro, ch, bv[0], bv[1]);
      }
      __builtin_amdgcn_sched_barrier(0);
    }
  }
};


constexpr int LD4 = 40;
template <class Epi>
DI void gemm_phase4(const u16* __restrict__ A, int lda, const u16* __restrict__ Bt, int ldb, int K, int mt_lo, int mtiles, int ntiles,
                    char* smem, Epi epi) {
  u16* sA = (u16*)smem;
  u16* sB = sA + 2 * 256 * LD4;
  const int tid = opaque_tid(), lane = tid & 63, wid = __builtin_amdgcn_readfirstlane(tid >> 6), wm = wid >> 1, wn = wid & 1;
  const int lr = lane & 31, lh = lane >> 5;
  const int ldrow = tid >> 2, ldc = (tid & 3) * 8;
  const int nk = K / 32;
  const int total = mtiles * ntiles;
  const int per_xcd = (total + 7) >> 3;
  const int xcd = blockIdx.x & 7, qx = blockIdx.x >> 3, nq = gridDim.x >> 3;
  for (int v = qx; v < per_xcd; v += nq) {
    const int u = xcd * per_xcd + v;
    if (u >= total) break;
    const int gsz_full = 8 * ntiles;
    const int g = u / gsz_full, r = u - g * gsz_full;
    const int gm = min(8, mtiles - g * 8);
    const int mt = mt_lo + g * 8 + r % gm, nt = r / gm;
    const unsigned oA = (unsigned)(((mt * 256 + ldrow) * lda + ldc) * 2);
    const unsigned oB = (unsigned)(((nt * 128 + ldrow) * ldb + ldc) * 2);
    const char* Ab = (const char*)A;
    const char* Bb = (const char*)Bt;
    f32x16 acc[4][2];
#pragma unroll
    for (int mi = 0; mi < 4; ++mi) { acc[mi][0] = zero16(); acc[mi][1] = zero16(); }
    uint4 xa0, xa1, xa2, xa3, xb0, xb1, ya0, ya1, ya2, ya3, yb0, yb1;
#define G4_LOADX(KT) do { const unsigned ka_ = oA + (unsigned)(KT) * 64u, kb_ = oB + (unsigned)(KT) * 64u; \
      xa0 = *reinterpret_cast<const uint4*>(Ab + ka_); xa1 = *reinterpret_cast<const uint4*>(Ab + (ka_ + 64u * (unsigned)lda * 2u)); \
      xa2 = *reinterpret_cast<const uint4*>(Ab + (ka_ + 128u * (unsigned)lda * 2u)); xa3 = *reinterpret_cast<const uint4*>(Ab + (ka_ + 192u * (unsigned)lda * 2u)); \
      xb0 = *reinterpret_cast<const uint4*>(Bb + kb_); xb1 = *reinterpret_cast<const uint4*>(Bb + (kb_ + 64u * (unsigned)ldb * 2u)); } while (0)
#define G4_LOADY(KT) do { const unsigned ka_ = oA + (unsigned)(KT) * 64u, kb_ = oB + (unsigned)(KT) * 64u; \
      ya0 = *reinterpret_cast<const uint4*>(Ab + ka_); ya1 = *reinterpret_cast<const uint4*>(Ab + (ka_ + 64u * (unsigned)lda * 2u)); \
      ya2 = *reinterpret_cast<const uint4*>(Ab + (ka_ + 128u * (unsigned)lda * 2u)); ya3 = *reinterpret_cast<const uint4*>(Ab + (ka_ + 192u * (unsigned)lda * 2u)); \
      yb0 = *reinterpret_cast<const uint4*>(Bb + kb_); yb1 = *reinterpret_cast<const uint4*>(Bb + (kb_ + 64u * (unsigned)ldb * 2u)); } while (0)
#define G4_STOREX(BUF) do { u16* wa_ = sA + (BUF) * 256 * LD4 + ldrow * LD4 + ldc; u16* wb_ = sB + (BUF) * 128 * LD4 + ldrow * LD4 + ldc; \
      *reinterpret_cast<uint4*>(wa_) = xa0; *reinterpret_cast<uint4*>(wa_ + 64 * LD4) = xa1; \
      *reinterpret_cast<uint4*>(wa_ + 128 * LD4) = xa2; *reinterpret_cast<uint4*>(wa_ + 192 * LD4) = xa3; \
      *reinterpret_cast<uint4*>(wb_) = xb0; *reinterpret_cast<uint4*>(wb_ + 64 * LD4) = xb1; } while (0)
#define G4_STOREY(BUF) do { u16* wa_ = sA + (BUF) * 256 * LD4 + ldrow * LD4 + ldc; u16* wb_ = sB + (BUF) * 128 * LD4 + ldrow * LD4 + ldc; \
      *reinterpret_cast<uint4*>(wa_) = ya0; *reinterpret_cast<uint4*>(wa_ + 64 * LD4) = ya1; \
      *reinterpret_cast<uint4*>(wa_ + 128 * LD4) = ya2; *reinterpret_cast<uint4*>(wa_ + 192 * LD4) = ya3; \
      *reinterpret_cast<uint4*>(wb_) = yb0; *reinterpret_cast<uint4*>(wb_ + 64 * LD4) = yb1; } while (0)
#define G4_COMPUTE(BUF) do { \
      const u16* a_ = sA + (BUF) * 256 * LD4 + (wm * 128 + lr) * LD4 + lh * 8; \
      const u16* b_ = sB + (BUF) * 128 * LD4 + (wn * 64 + lr) * LD4 + lh * 8; \
      _Pragma("unroll") for (int ks = 0; ks < 2; ++ks) { \
        const bf16x8 b0 = ld8(b_ + ks * 16), b1 = ld8(b_ + 32 * LD4 + ks * 16); \
        _Pragma("unroll") for (int mi = 0; mi < 4; ++mi) { \
          const bf16x8 a0 = ld8(a_ + mi * 32 * LD4 + ks * 16); \
          acc[mi][0] = mfma32(a0, b0, acc[mi][0]); acc[mi][1] = mfma32(a0, b1, acc[mi][1]); } } } while (0)
    G4_LOADX(0);
    G4_STOREX(0);
    G4_LOADX(1);
    if (nk > 2) G4_LOADY(2);
    __syncthreads();
    for (int kt = 0; kt < nk; kt += 2) {
      G4_COMPUTE(0);
      G4_STOREX(1);
      if (kt + 3 < nk) G4_LOADX(kt + 3);
      __syncthreads();
      G4_COMPUTE(1);
      if (kt + 2 < nk) G4_STOREY(0);
      if (kt + 4 < nk) G4_LOADY(kt + 4);
      __syncthreads();
    }
    { int lr_ = lr, lh_ = lh; asm volatile("" : "+v"(lr_), "+v"(lh_));
      epi.template operator()<4>(acc, mt * 256 + wm * 128, nt * 128 + wn * 64, nt, wn, lr_, lh_); }
  }
}

DI void phase_da_prep(const Params& p, char* smem) {
  u16* qk = (u16*)((char*)p.out + DO_QK);
  const int tid0 = opaque_tid();
  const int lane = tid0 & 63, wid = tid0 >> 6;
  const int nw = gridDim.x * 4;
  const int qq = lane & 3;
  const bool isk = lane >= 32;
  const float* gain = p.in[isk ? I_KN : I_QN] + qq * 16;
  for (int row = blockIdx.x * 4 + wid; row < MROWS; row += nw) {
    uint4* ptr = reinterpret_cast<uint4*>(qk + (size_t)row * 1024 + lane * 16);
    const uint4 v0 = ptr[0], v1 = ptr[1];
    float x[16];
    x[0] = bflo(v0.x); x[1] = bfhi(v0.x); x[2] = bflo(v0.y); x[3] = bfhi(v0.y); x[4] = bflo(v0.z); x[5] = bfhi(v0.z); x[6] = bflo(v0.w); x[7] = bfhi(v0.w);
    x[8] = bflo(v1.x); x[9] = bfhi(v1.x); x[10] = bflo(v1.y); x[11] = bfhi(v1.y); x[12] = bflo(v1.z); x[13] = bfhi(v1.z); x[14] = bflo(v1.w); x[15] = bfhi(v1.w);
    float ss = 0.f;
#pragma unroll
    for (int i = 0; i < 16; ++i) ss += x[i] * x[i];
    ss += __shfl_xor(ss, 1); ss += __shfl_xor(ss, 2);
    const float rinv = rsqrtf(ss * (1.f / 64.f) + EPSF) * (isk ? 1.f : 0.125f * 1.4426950408889634f);
#pragma unroll
    for (int i = 0; i < 16; ++i) x[i] = x[i] * rinv * gain[i];
    if (row >= LAT0) {
      const int t = (row - LAT0) & (SEQ - 1);
      const float pos = (float)((qq >> 1) ? (t & 63) : (t >> 6));
#pragma unroll
      for (int i = 0; i < 16; ++i) {
        const float other = __shfl_xor(x[i], 1);
        const float inv = exp2f(-(float)i * (13.287712379549449f / 16.f));
        const float ang = pos * inv;
        float rev = ang * 0.15915494309189535f;
        rev -= floorf(rev);
        const float sn = __builtin_amdgcn_sinf(rev), cs = __builtin_amdgcn_cosf(rev);
        x[i] = (qq & 1) ? (x[i] * cs + other * sn) : (x[i] * cs - other * sn);
      }
    }
    ptr[0] = make_uint4(pk2(x[0], x[1]), pk2(x[2], x[3]), pk2(x[4], x[5]), pk2(x[6], x[7]));
    ptr[1] = make_uint4(pk2(x[8], x[9]), pk2(x[10], x[11]), pk2(x[12], x[13]), pk2(x[14], x[15]));
  }
  const u16* vraw = (const u16*)(p.ws + WS_VRAW);
  u16* vt = (u16*)((char*)p.out + DO_VT);
  u16* sv = (u16*)smem;
  const int tid = tid0;
  for (int item = blockIdx.x; item < 2 * 4 * NCH; item += gridDim.x) {
    const int t = item % NCH, bh = item / NCH, b = bh >> 2, h = bh & 3;
    const int row0 = t < 4 ? b * CTXL + t * 64 : LAT0 + b * SEQ + (t - 4) * 64;
    {
      const int key = tid >> 2, ec = (tid & 3) * 32;
      const uint4* s = reinterpret_cast<const uint4*>(vraw + (size_t)(row0 + key) * 512 + h * 128 + ec);
#pragma unroll
      for (int i = 0; i < 4; ++i) {
        const uint4 v = s[i];
        u32* d = reinterpret_cast<u32*>(sv + key * 130 + ec + i * 8);
        d[0] = v.x; d[1] = v.y; d[2] = v.z; d[3] = v.w;
      }
    }
    __syncthreads();
    {
      const int e = tid >> 1, half = tid & 1;
      u32 w[16];
#pragma unroll
      for (int i = 0; i < 16; ++i) {
        const int p0 = half * 32 + 2 * i, p1 = p0 + 1;
        const int k0 = (p0 & ~12) | ((p0 & 4) << 1) | ((p0 & 8) >> 1);
        const int k1 = (p1 & ~12) | ((p1 & 4) << 1) | ((p1 & 8) >> 1);
        w[i] = (u32)sv[k0 * 130 + e] | ((u32)sv[k1 * 130 + e] << 16);
      }
      uint4* d = reinterpret_cast<uint4*>(vt + ((size_t)(bh * 128 + e)) * SK + t * 64 + half * 32);
      d[0] = make_uint4(w[0], w[1], w[2], w[3]); d[1] = make_uint4(w[4], w[5], w[6], w[7]);
      d[2] = make_uint4(w[8], w[9], w[10], w[11]); d[3] = make_uint4(w[12], w[13], w[14], w[15]);
    }
    __syncthreads();
  }
}

#define LDS_AS __attribute__((address_space(3)))
DI void glds16(const void* g, char* lds_wave_base) {
  __builtin_amdgcn_global_load_lds((const unsigned*)g, (LDS_AS unsigned*)lds_wave_base, 16, 0, 0);
}
#define RAW_BARRIER() do { asm volatile("s_waitcnt lgkmcnt(0)" ::: "memory"); __builtin_amdgcn_s_barrier(); } while (0)
DI void phase_da_attn(const Params& p, char* smem) {
  const u16* qk = (const u16*)((const char*)p.out + DO_QK);
  const u16* vt = (const u16*)((const char*)p.out + DO_VT);
  u16* mix = (u16*)(p.ws + WS_MIX);
  char* sK = smem;
  char* sV = smem + 32768;
  float* ex = (float*)smem;
  const int tid = opaque_tid(), lane = tid & 63, wid = __builtin_amdgcn_readfirstlane(tid >> 6), lr = lane & 31, lh = lane >> 5;
  const int qg = wid >> 1, mp = wid & 1;
  float lam;
  {
    const float a = p.in[I_LQ1][lane] * p.in[I_LK1][lane], b2 = p.in[I_LQ2][lane] * p.in[I_LK2][lane];
    lam = __expf(wave_sum(a)) - __expf(wave_sum(b2)) + 0.2f;
  }
  int* cnt = (int*)(p.ws + WS_CNT);
  int* sitem = (int*)(smem + 73728);
  if (tid == 0) { sitem[1] = (int)((unsigned)__builtin_amdgcn_s_getreg((3 << 11) | 20) & 7u); sitem[2] = 0; }
  const int x15 = lr & 15, f3 = (lr >> 2) & 3;
  for (;;) {
    if (tid == 0) {
      int got = -1, tries = sitem[2];
      const int home = sitem[1];
      while (tries < 8) {
        const int it = atomicAdd(&cnt[(home + tries) & 7], 1);
        if (it < 260) { got = ((home + tries) & 7) | (it << 3); break; }
        ++tries;
      }
      sitem[2] = tries;
      *sitem = got;
    }
    __syncthreads();
    const int item = *sitem;
    if (item < 0) break;
    const int bh = item & 7, b = bh >> 2, h = bh & 3, qb = item >> 3;
    const bool isctx = qb >= 256;
    const int qrow0 = isctx ? b * CTXL + (qb - 256) * 64 : LAT0 + b * SEQ + qb * 64;
    const int ntile = isctx ? 8 : 2 * NCH;
    const int myq = qrow0 + qg * 32 + lr;
    bf16x8 qf[4];
#pragma unroll
    for (int ks = 0; ks < 4; ++ks) qf[ks] = ld8(qk + (size_t)myq * 1024 + h * 128 + mp * 64 + ks * 16 + lh * 8);
    f32x16 O[4];
#pragma unroll
    for (int dt = 0; dt < 4; ++dt) O[dt] = zero16();
    float l = 0.f;
    const u16* vsrc0 = vt + (size_t)(bh * 128) * SK;
#define DA_DMA(T) do { const int t_ = (T); const int st_ = t_ & 3; \
      int lq = lane; asm volatile("" : "+v"(lq)); \
      const int krl_ = lq >> 4, kpl_ = lq & 15, vrl_ = lq >> 2, vpl_ = lq & 3; \
      const int krow0 = t_ < 8 ? b * CTXL + t_ * 32 : LAT0 + b * SEQ + (t_ - 8) * 32; \
      const char* kbt = (const char*)(qk + (size_t)krow0 * 1024 + 512 + h * 128); \
      const char* vbt = (const char*)(vsrc0 + t_ * 32); \
      char* kd = sK + st_ * 8192 + wid * 2048; char* vd = sV + st_ * 8192 + wid * 2048; \
      const unsigned kob = (unsigned)((wid * 8 + krl_) * 2048), vob = (unsigned)(((wid * 32 + vrl_) * SK) * 2); \
      glds16(kbt + (kob + (unsigned)(0 * 2048 + ((kpl_ ^ ((wid * 8 + 0 + krl_) & 15)) << 4))), kd); \
      glds16(kbt + (kob + (unsigned)(4 * 2048 + ((kpl_ ^ ((wid * 8 + 4 + krl_) & 15)) << 4))), kd + 1024); \
      glds16(vbt + (vob + (unsigned)(0 * SK * 2 + ((vpl_ ^ (((0 + vrl_) >> 2) & 3)) << 4))), vd); \
      glds16(vbt + (vob + (unsigned)(16 * SK * 2 + ((vpl_ ^ (((16 + vrl_) >> 2) & 3)) << 4))), vd + 1024); } while (0)
    DA_DMA(0); DA_DMA(1); DA_DMA(2);
#pragma unroll 1
    for (int t = 0; t < ntile; ++t) {
      if (t + 2 < ntile) asm volatile("s_waitcnt vmcnt(8)" ::: "memory");
      else if (t + 1 < ntile) asm volatile("s_waitcnt vmcnt(4)" ::: "memory");
      else asm volatile("s_waitcnt vmcnt(0)" ::: "memory");
      RAW_BARRIER();
      if (t + 3 < ntile) DA_DMA(t + 3);
      const int st = t & 3;
      const unsigned kb = (unsigned)(size_t)(LDS_AS char*)(sK + st * 8192 + lr * 256);
      const unsigned vb = (unsigned)(size_t)(LDS_AS char*)(sV + st * 8192 + lr * 64);
      bf16x8 k0, k1, k2, k3, v0, v1, v2, v3, v4, v5, v6, v7;
      asm volatile("ds_read_b128 %0, %4\n\tds_read_b128 %1, %5\n\tds_read_b128 %2, %6\n\tds_read_b128 %3, %7"
                   : "=&v"(k0), "=&v"(k1), "=&v"(k2), "=&v"(k3)
                   : "v"(kb + (((mp * 8 + 0 + lh) ^ x15) << 4)), "v"(kb + (((mp * 8 + 2 + lh) ^ x15) << 4)),
                     "v"(kb + (((mp * 8 + 4 + lh) ^ x15) << 4)), "v"(kb + (((mp * 8 + 6 + lh) ^ x15) << 4)) : "memory");
      const unsigned va = vb + (((0 + lh) ^ f3) << 4), vc = vb + (((2 + lh) ^ f3) << 4);
      asm volatile("ds_read_b128 %0, %8\n\tds_read_b128 %1, %9\n\tds_read_b128 %2, %8 offset:2048\n\tds_read_b128 %3, %9 offset:2048\n\t"
                   "ds_read_b128 %4, %8 offset:4096\n\tds_read_b128 %5, %9 offset:4096\n\tds_read_b128 %6, %8 offset:6144\n\tds_read_b128 %7, %9 offset:6144"
                   : "=&v"(v0), "=&v"(v1), "=&v"(v2), "=&v"(v3), "=&v"(v4), "=&v"(v5), "=&v"(v6), "=&v"(v7)
                   : "v"(va), "v"(vc) : "memory");
      asm volatile("s_waitcnt lgkmcnt(8)" : "+v"(k0), "+v"(k1), "+v"(k2), "+v"(k3) :: "memory");
      f32x16 s = zero16();
      s = mfma32(k0, qf[0], s); s = mfma32(k1, qf[1], s); s = mfma32(k2, qf[2], s); s = mfma32(k3, qf[3], s);
      float rs = 0.f;
#pragma unroll
      for (int i = 0; i < 16; ++i) { s[i] = __builtin_amdgcn_exp2f(s[i]); rs += s[i]; }
      l += rs;
      const bf16x8 pb0 = pack_step(s, 0), pb1 = pack_step(s, 1);
      asm volatile("s_waitcnt lgkmcnt(0)" : "+v"(v0), "+v"(v1), "+v"(v2), "+v"(v3), "+v"(v4), "+v"(v5), "+v"(v6), "+v"(v7) :: "memory");
      O[0] = mfma32(v0, pb0, O[0]); O[1] = mfma32(v2, pb0, O[1]); O[2] = mfma32(v4, pb0, O[2]); O[3] = mfma32(v6, pb0, O[3]);
      O[0] = mfma32(v1, pb1, O[0]); O[1] = mfma32(v3, pb1, O[1]); O[2] = mfma32(v5, pb1, O[2]); O[3] = mfma32(v7, pb1, O[3]);
    }
    __syncthreads();
    l += __shfl_xor(l, 32);
    if (mp == 1) {
      const float sc = lam / l;
#pragma unroll
      for (int dt = 0; dt < 4; ++dt)
#pragma unroll
        for (int i = 0; i < 16; ++i) ex[((qg * 4 + dt) * 16 + i) * 64 + lane] = O[dt][i] * sc;
    }
    __syncthreads();
    if (mp == 0) {
      const float i0 = 1.f / l;
      float ss = 0.f;
#pragma unroll
      for (int dt = 0; dt < 4; ++dt)
#pragma unroll
        for (int i = 0; i < 16; ++i) {
          const float v = O[dt][i] * i0 - ex[((qg * 4 + dt) * 16 + i) * 64 + lane];
          O[dt][i] = v; ss += v * v;
        }
      ss += __shfl_xor(ss, 32);
      const float rinv = rsqrtf(ss * (1.f / 128.f) + EPSF) * 0.8f;
      const float* sn = p.in[I_SUBN];
#pragma unroll
      for (int dt = 0; dt < 4; ++dt)
#pragma unroll
        for (int g = 0; g < 4; ++g) {
          const int dv = dt * 32 + 8 * g + 4 * lh;
          const float4 gn = *reinterpret_cast<const float4*>(sn + dv);
          const u32 w0 = pk2(O[dt][4 * g] * rinv * gn.x, O[dt][4 * g + 1] * rinv * gn.y);
          const u32 w1 = pk2(O[dt][4 * g + 2] * rinv * gn.z, O[dt][4 * g + 3] * rinv * gn.w);
          *reinterpret_cast<uint2*>(mix + (size_t)myq * 1024 + h * 128 + dv) = make_uint2(w0, w1);
        }
    }
    __syncthreads();
  }
}

template <int DIR>
DI void gdn_solve(float (&X)[64], int c, const float* sAm, const float* gc, const float* bt, const u16* skn, const u16* svv) {
  if (c < 128) {
#pragma unroll
    for (int i = 0; i < 64; ++i) {
      const int tok = DIR ? 63 - i : i;
      X[i] = bt[i] * bf2f(svv[tok * 128 + c]);
    }
  } else {
#pragma unroll
    for (int i = 0; i < 64; ++i) {
      const int tok = DIR ? 63 - i : i;
      X[i] = bt[i] * __expf(gc[i]) * bf2f(skn[tok * 136 + c - 128]);
    }
  }
  __builtin_amdgcn_sched_barrier(0);
#pragma unroll
  for (int i = 1; i < 64; ++i) {
    float acc = X[i];
    const float4* arow = reinterpret_cast<const float4*>(sAm + i * 64);
#pragma unroll
    for (int j4 = 0; j4 < (i + 3) / 4; ++j4) {
      const float4 a4 = arow[j4];
      if (4 * j4 + 0 < i) acc = __builtin_fmaf(-a4.x, X[4 * j4 + 0], acc);
      if (4 * j4 + 1 < i) acc = __builtin_fmaf(-a4.y, X[4 * j4 + 1], acc);
      if (4 * j4 + 2 < i) acc = __builtin_fmaf(-a4.z, X[4 * j4 + 2], acc);
      if (4 * j4 + 3 < i) acc = __builtin_fmaf(-a4.w, X[4 * j4 + 3], acc);
    }
    X[i] = acc;
    __builtin_amdgcn_sched_barrier(0);
  }
}

constexpr int QS = 136;
DI void phase_gdn_prep(const Params& p, char* smem) {
  u16* sq = (u16*)smem;
  u16* skn = sq + 64 * QS;
  float* sAm = (float*)(skn + 64 * QS);
  u16* sat = (u16*)(sAm + 64 * 64);
  float* sgc = (float*)(sat + 64 * 72);
  float* sbt = sgc + 128;
  u16* svv = (u16*)(sbt + 128);
  const u16* u0g = (const u16*)(p.ws + WS_U0G);
  const float* g0 = (const float*)(p.ws + WS_G0);
  const float* cw = p.in[I_GCONV];
  for (int item = blockIdx.x; item < 2 * NCH * 4; item += gridDim.x) {
    int tid = opaque_tid();
    const int lane = tid & 63, wid = __builtin_amdgcn_readfirstlane(tid >> 6), lr = lane & 31, lh = lane >> 5;
    const int h = item & 3, n = (item >> 2) % NCH, b = item / (4 * NCH);
    const int row0 = n < 4 ? b * CTXL + n * 64 : LAT0 + b * SEQ + (n - 4) * 64;
    const int t0 = n < 4 ? n * 64 : (n - 4) * 64;
    const int slen = n < 4 ? CTXL : SEQ;
    {
      int t1 = tid; asm volatile("" : "+v"(t1));
      const int cgp = t1 & 15, rg = t1 >> 4;
#pragma unroll
      for (int qk_ = 0; qk_ < 3; ++qk_) {
        const int chb = qk_ * 512 + h * 128 + cgp * 8;
        float wv[4][8];
#pragma unroll
        for (int j = 0; j < 4; ++j)
#pragma unroll
          for (int e = 0; e < 8; ++e) wv[j][e] = cw[j * 1536 + chb + e];
        float xin[7][8];
#pragma unroll
        for (int r = 0; r < 7; ++r) {
          const int tt = rg * 4 + r - 2;
          const int pos = t0 + tt;
          if (pos >= 0 && pos < slen) {
            const uint4 v = *reinterpret_cast<const uint4*>(u0g + (size_t)(row0 + tt) * 1536 + chb);
            xin[r][0] = bflo(v.x); xin[r][1] = bfhi(v.x); xin[r][2] = bflo(v.y); xin[r][3] = bfhi(v.y);
            xin[r][4] = bflo(v.z); xin[r][5] = bfhi(v.z); xin[r][6] = bflo(v.w); xin[r][7] = bfhi(v.w);
          } else {
#pragma unroll
            for (int e = 0; e < 8; ++e) xin[r][e] = 0.f;
          }
        }
#pragma unroll
        for (int r = 0; r < 4; ++r) {
          float y[8]; float ss = 0.f;
#pragma unroll
          for (int e = 0; e < 8; ++e) {
            float a = 0.f;
#pragma unroll
            for (int j = 0; j < 4; ++j) a += wv[j][e] * xin[r + j][e];
            y[e] = siluf_fast(a); ss += y[e] * y[e];
          }
          ss += __shfl_xor(ss, 1); ss += __shfl_xor(ss, 2); ss += __shfl_xor(ss, 4); ss += __shfl_xor(ss, 8);
          const float rinv = qk_ == 2 ? 1.f : rsqrtf(ss + EPSF);
          u16* d = qk_ == 2 ? svv + (rg * 4 + r) * 128 + cgp * 8 : (qk_ ? skn : sq) + (rg * 4 + r) * QS + cgp * 8;
          *reinterpret_cast<uint4*>(d) = make_uint4(pk2(y[0] * rinv, y[1] * rinv), pk2(y[2] * rinv, y[3] * rinv),
                                                    pk2(y[4] * rinv, y[5] * rinv), pk2(y[6] * rinv, y[7] * rinv));
        }
      }
    }
    if (wid < 2) {
      const int d = wid, tok = d ? 63 - lane : lane;
      const float* gr = g0 + (size_t)(row0 + tok) * 16;
      const float beta = sigmoidf_(gr[d * 4 + h]);
      const float g = -__expf(p.in[I_ALOG][d * 4 + h]) * softplusf_(gr[8 + d * 4 + h] + p.in[I_DTB][d * 4 + h]);
      float cs = g;
#pragma unroll
      for (int o = 1; o < 64; o <<= 1) { const float v = __shfl_up(cs, o); if (lane >= o) cs += v; }
      sgc[d * 64 + lane] = cs; sbt[d * 64 + lane] = beta;
    }
    __syncthreads();
    for (int d = 0; d < 2; ++d) {
      char* fr = p.ws + WS_FRAGS + (size_t)(((b * 2 + d) * 4 + h) * NCH + n) * FRAG_ITEM;
      const float* gc = sgc + d * 64;
      const float* bt = sbt + d * 64;
      {
        int lr_ = lr; asm volatile("" : "+v"(lr_));
        const int ti = wid >> 1, tj = wid & 1;
        const int ri = d ? 63 - (ti * 32 + lr_) : ti * 32 + lr_;
        const int rj = d ? 63 - (tj * 32 + lr_) : tj * 32 + lr_;
        f32x16 kk = zero16(), qkk = zero16();
#pragma unroll
        for (int ks = 0; ks < 8; ++ks) {
          const bf16x8 bk = ld8(skn + rj * QS + ks * 16 + lh * 8);
          kk = mfma32(ld8(skn + ri * QS + ks * 16 + lh * 8), bk, kk);
          qkk = mfma32(ld8(sq + ri * QS + ks * 16 + lh * 8), bk, qkk);
        }
        const int j = tj * 32 + lr_;
        const float gcj = gc[j];
#pragma unroll
        for (int r = 0; r < 16; ++r) {
          const int i = ti * 32 + crow(r, lh);
          const float dec = __expf(fminf(gc[i] - gcj, 0.f));
          sAm[i * 64 + j] = (i > j) ? bt[i] * kk[r] * dec : 0.f;
          sat[i * 72 + j] = f2bf((i >= j) ? qkk[r] * dec * 0.08838834764831845f : 0.f);
        }
      }
      __syncthreads();
      float X[64];
      if (d == 0) gdn_solve<0>(X, tid, sAm, gc, bt, skn, svv);
      else gdn_solve<1>(X, tid, sAm, gc, bt, skn, svv);
      __syncthreads();
      u16* sW = (u16*)sAm;
      if (tid >= 128) {
#pragma unroll
        for (int i = 0; i < 64; ++i) sW[i * 128 + tid - 128] = f2bf(-X[i]);
      } else {
        int tu = tid; asm volatile("" : "+v"(tu));
        const int sl = tu >> 5, n_ = tu & 31;
        u16* ud = (u16*)(fr + FR_U);
#pragma unroll
        for (int mt = 0; mt < 2; ++mt)
#pragma unroll
          for (int hh = 0; hh < 2; ++hh) {
            u32 w[8];
#pragma unroll
            for (int r2 = 0; r2 < 8; ++r2) w[r2] = pk2(X[mt * 32 + crow(2 * r2, hh)], X[mt * 32 + crow(2 * r2 + 1, hh)]);
            uint4* dd = reinterpret_cast<uint4*>(ud + ((size_t)((sl * 2 + mt) * 64 + hh * 32 + n_)) * 16);
            dd[0] = make_uint4(w[0], w[1], w[2], w[3]); dd[1] = make_uint4(w[4], w[5], w[6], w[7]);
          }
      }
      __syncthreads();
      int tq = tid; asm volatile("" : "+v"(tq));
      const float glast = gc[63];
      if (tid == 0) ((float*)(p.ws + WS_GL))[((b * 2 + d) * 4 + h) * NCH + n] = __expf(glast);
#pragma unroll 1
      for (int idx = tq; idx < 16 * 64; idx += 256) {
        const int L = idx & 63, f = idx >> 6, mt = f >> 3, ks = f & 7, m = L & 31, hh = L >> 5;
        const int i = mt * 32 + m, tok = d ? 63 - i : i;
        const int dk0 = 32 * (ks >> 1) + 16 * (ks & 1) + 4 * hh;
        const uint2 wa = *reinterpret_cast<const uint2*>(sW + i * 128 + dk0);
        const uint2 wb = *reinterpret_cast<const uint2*>(sW + i * 128 + dk0 + 8);
        reinterpret_cast<uint4*>(fr + FR_W)[idx] = make_uint4(wa.x, wa.y, wb.x, wb.y);
        const float sc = __expf(gc[i]) * 0.08838834764831845f;
        const uint2 qa = *reinterpret_cast<const uint2*>(sq + tok * QS + dk0);
        const uint2 qb = *reinterpret_cast<const uint2*>(sq + tok * QS + dk0 + 8);
        reinterpret_cast<uint4*>(fr + FR_Q)[idx] = make_uint4(pk2(bflo(qa.x) * sc, bfhi(qa.x) * sc), pk2(bflo(qa.y) * sc, bfhi(qa.y) * sc),
                                                             pk2(bflo(qb.x) * sc, bfhi(qb.x) * sc), pk2(bflo(qb.y) * sc, bfhi(qb.y) * sc));
      }
#pragma unroll 1
      for (int idx = tq; idx < 16 * 64; idx += 256) {
        const int L = idx & 63, f = idx >> 6, kt = f >> 2, ks = f & 3, m = L & 31, hh = L >> 5;
        float v[8];
#pragma unroll
        for (int j = 0; j < 8; ++j) {
          const int i = 32 * (ks >> 1) + krow(ks & 1, hh, j), tok = d ? 63 - i : i;
          v[j] = bf2f(skn[tok * QS + kt * 32 + m]) * __expf(glast - gc[i]);
        }
        reinterpret_cast<uint4*>(fr + FR_KT)[idx] = make_uint4(pk2(v[0], v[1]), pk2(v[2], v[3]), pk2(v[4], v[5]), pk2(v[6], v[7]));
      }
#pragma unroll 1
      for (int idx = tq; idx < 8 * 64; idx += 256) {
        const int L = idx & 63, f = idx >> 6, it = f >> 2, ks = f & 3, m = L & 31, hh = L >> 5;
        const int j0 = 32 * (ks >> 1) + 16 * (ks & 1) + 4 * hh;
        const uint2 a = *reinterpret_cast<const uint2*>(sat + (it * 32 + m) * 72 + j0);
        const uint2 bq = *reinterpret_cast<const uint2*>(sat + (it * 32 + m) * 72 + j0 + 8);
        reinterpret_cast<uint4*>(fr + FR_AT)[idx] = make_uint4(a.x, a.y, bq.x, bq.y);
      }
      __syncthreads();
    }
  }
}

DI void gdn_scan_chain(const Params& p, char* smem, int chain) {
  const int tid = opaque_tid(), lane = tid & 63, sl = __builtin_amdgcn_readfirstlane(tid >> 6);
  const int d = (chain >> 2) & 1;
  const float* GL = (const float*)(p.ws + WS_GL) + chain * NCH;
  uint4* sfr = reinterpret_cast<uint4*>(smem);
  f32x16 S[4];
#pragma unroll
  for (int kt = 0; kt < 4; ++kt) S[kt] = zero16();
  uint4 pf0, pf1, pf2, pf3, pf4, pf5, pf6, pf7, pf8, pf9, pf10, pf11, pf12, pf13;
  {
    const int n0 = d ? 3 : 0;
    const char* fr = p.ws + WS_FRAGS + (size_t)(chain * NCH + n0) * FRAG_ITEM;
    const uint4* g = reinterpret_cast<const uint4*>(fr) + tid;
    pf0 = g[0 * 256]; pf1 = g[1 * 256]; pf2 = g[2 * 256]; pf3 = g[3 * 256]; pf4 = g[4 * 256]; pf5 = g[5 * 256]; pf6 = g[6 * 256]; pf7 = g[7 * 256]; pf8 = g[8 * 256]; pf9 = g[9 * 256]; pf10 = g[10 * 256]; pf11 = g[11 * 256]; pf12 = g[12 * 256]; pf13 = g[13 * 256];
  }
  for (int step = 0; step < NCH; ++step) {
    const int n = d ? (step < 4 ? 3 - step : 263 - step) : step;
    char* frc = p.ws + WS_FRAGS + (size_t)(chain * NCH + n) * FRAG_ITEM;
    __syncthreads();
    sfr[0 * 256 + tid] = pf0; sfr[1 * 256 + tid] = pf1; sfr[2 * 256 + tid] = pf2; sfr[3 * 256 + tid] = pf3; sfr[4 * 256 + tid] = pf4; sfr[5 * 256 + tid] = pf5; sfr[6 * 256 + tid] = pf6; sfr[7 * 256 + tid] = pf7; sfr[8 * 256 + tid] = pf8; sfr[9 * 256 + tid] = pf9; sfr[10 * 256 + tid] = pf10; sfr[11 * 256 + tid] = pf11; sfr[12 * 256 + tid] = pf12; sfr[13 * 256 + tid] = pf13;
    __syncthreads();
    f32x16 Vn[2], O[2];
    const uint4* fuc = reinterpret_cast<const uint4*>(frc + FR_U) + (size_t)(sl * 128 + lane) * 2;
    const uint4 un0 = fuc[0], un1 = fuc[1], un2 = fuc[128], un3 = fuc[129];
    Vn[0] = zero16(); Vn[1] = zero16();
    O[0] = zero16(); O[1] = zero16();
    {
      const int s1 = step + 1 < NCH ? step + 1 : step;
      const int n1 = d ? (s1 < 4 ? 3 - s1 : 263 - s1) : s1;
      const char* fr = p.ws + WS_FRAGS + (size_t)(chain * NCH + n1) * FRAG_ITEM;
      const uint4* g = reinterpret_cast<const uint4*>(fr) + tid;
      pf0 = g[0 * 256]; pf1 = g[1 * 256]; pf2 = g[2 * 256]; pf3 = g[3 * 256]; pf4 = g[4 * 256]; pf5 = g[5 * 256]; pf6 = g[6 * 256]; pf7 = g[7 * 256]; pf8 = g[8 * 256]; pf9 = g[9 * 256]; pf10 = g[10 * 256]; pf11 = g[11 * 256]; pf12 = g[12 * 256]; pf13 = g[13 * 256];
    }
    const uint4* lw = sfr + lane;
    const uint4* lq = sfr + 1024 + lane;
    const uint4* lk = sfr + 2048 + lane;
    const uint4* la = sfr + 3072 + lane;
#pragma unroll
    for (int ks = 0; ks < 8; ++ks) {
      const bf16x8 sb = pack_step(S[ks >> 1], ks & 1);
#pragma unroll
      for (int mt = 0; mt < 2; ++mt) {
        Vn[mt] = mfma32(__builtin_bit_cast(bf16x8, lw[(mt * 8 + ks) * 64]), sb, Vn[mt]);
        O[mt] = mfma32(__builtin_bit_cast(bf16x8, lq[(mt * 8 + ks) * 64]), sb, O[mt]);
      }
    }
    {
      const uint4 a = un0, b2 = un1;
      Vn[0][0] += bflo(a.x); Vn[0][1] += bfhi(a.x); Vn[0][2] += bflo(a.y); Vn[0][3] += bfhi(a.y);
      Vn[0][4] += bflo(a.z); Vn[0][5] += bfhi(a.z); Vn[0][6] += bflo(a.w); Vn[0][7] += bfhi(a.w);
      Vn[0][8] += bflo(b2.x); Vn[0][9] += bfhi(b2.x); Vn[0][10] += bflo(b2.y); Vn[0][11] += bfhi(b2.y);
      Vn[0][12] += bflo(b2.z); Vn[0][13] += bfhi(b2.z); Vn[0][14] += bflo(b2.w); Vn[0][15] += bfhi(b2.w);
    }
    {
      const uint4 a = un2, b2 = un3;
      Vn[1][0] += bflo(a.x); Vn[1][1] += bfhi(a.x); Vn[1][2] += bflo(a.y); Vn[1][3] += bfhi(a.y);
      Vn[1][4] += bflo(a.z); Vn[1][5] += bfhi(a.z); Vn[1][6] += bflo(a.w); Vn[1][7] += bfhi(a.w);
      Vn[1][8] += bflo(b2.x); Vn[1][9] += bfhi(b2.x); Vn[1][10] += bflo(b2.y); Vn[1][11] += bfhi(b2.y);
      Vn[1][12] += bflo(b2.z); Vn[1][13] += bfhi(b2.z); Vn[1][14] += bflo(b2.w); Vn[1][15] += bfhi(b2.w);
    }
    bf16x8 Vb[2][2];
#pragma unroll
    for (int mt = 0; mt < 2; ++mt) { Vb[mt][0] = pack_step(Vn[mt], 0); Vb[mt][1] = pack_step(Vn[mt], 1); }
#pragma unroll
    for (int it = 0; it < 2; ++it)
#pragma unroll
      for (int ks = 0; ks < 4; ++ks) O[it] = mfma32(__builtin_bit_cast(bf16x8, la[(it * 4 + ks) * 64]), Vb[ks >> 1][ks & 1], O[it]);
    const float gl = GL[n];
#pragma unroll
    for (int kt = 0; kt < 4; ++kt) {
#pragma unroll
      for (int i = 0; i < 16; ++i) S[kt][i] *= gl;
#pragma unroll
      for (int ks = 0; ks < 4; ++ks) S[kt] = mfma32(__builtin_bit_cast(bf16x8, lk[(kt * 4 + ks) * 64]), Vb[ks >> 1][ks & 1], S[kt]);
    }
    uint4* fo = reinterpret_cast<uint4*>(frc + FR_U) + (size_t)(sl * 128 + lane) * 2;
#pragma unroll
    for (int mt = 0; mt < 2; ++mt) {
      fo[mt * 128] = make_uint4(pk2(O[mt][0], O[mt][1]), pk2(O[mt][2], O[mt][3]), pk2(O[mt][4], O[mt][5]), pk2(O[mt][6], O[mt][7]));
      fo[mt * 128 + 1] = make_uint4(pk2(O[mt][8], O[mt][9]), pk2(O[mt][10], O[mt][11]), pk2(O[mt][12], O[mt][13]), pk2(O[mt][14], O[mt][15]));
    }
  }
  __syncthreads();
}

DI void phase_gdn_finish(const Params& p, char* smem) {
  u16* so = (u16*)smem;
  const u16* zb = (const u16*)(p.ws + WS_Z);
  u16* mix = (u16*)(p.ws + WS_MIX);
  const float* on = p.in[I_ONORM];
  const int tid = opaque_tid();
  for (int item = blockIdx.x; item < 2 * NCH * 4; item += gridDim.x) {
    const int h = item & 3, n = (item >> 2) % NCH, b = item / (4 * NCH);
    const int row0 = n < 4 ? b * CTXL + n * 64 : LAT0 + b * SEQ + (n - 4) * 64;
#pragma unroll
    for (int d = 0; d < 2; ++d) {
      const uint4* src = reinterpret_cast<const uint4*>(p.ws + WS_FRAGS + (size_t)(((b * 2 + d) * 4 + h) * NCH + n) * FRAG_ITEM + FR_U);
      uint4* dst = reinterpret_cast<uint4*>(so + d * 8192);
#pragma unroll
      for (int i = 0; i < 4; ++i) dst[tid + 256 * i] = src[tid + 256 * i];
    }
    __syncthreads();
    const int t = tid >> 2, sl = tid & 3;
    float v[32]; float ss = 0.f;
    {
      const int i0 = t, i1 = 63 - t;
      const int mt0 = i0 >> 5, m0 = i0 & 31, hh0 = (m0 >> 2) & 1, rg0 = (m0 & 3) + 4 * (m0 >> 3);
      const int mt1 = i1 >> 5, m1 = i1 & 31, hh1 = (m1 >> 2) & 1, rg1 = (m1 & 3) + 4 * (m1 >> 3);
#pragma unroll
      for (int e = 0; e < 32; ++e) {
        const float a = bf2f(so[((sl * 2 + mt0) * 64 + hh0 * 32 + e) * 16 + rg0]);
        const float c = bf2f(so[8192 + ((sl * 2 + mt1) * 64 + hh1 * 32 + e) * 16 + rg1]);
        v[e] = a + c; ss += v[e] * v[e];
      }
    }
    ss += __shfl_xor(ss, 1); ss += __shfl_xor(ss, 2);
    const float rinv = rsqrtf(ss * (1.f / 128.f) + EPSF);
    const u16* zr = zb + (size_t)(row0 + t) * 512 + h * 128 + sl * 32;
    u16* mr = mix + (size_t)(row0 + t) * 1024 + 512 + h * 128 + sl * 32;
    uint4 zq0 = *reinterpret_cast<const uint4*>(zr), zq1 = *reinterpret_cast<const uint4*>(zr + 8);
    uint4 zq2 = *reinterpret_cast<const uint4*>(zr + 16), zq3 = *reinterpret_cast<const uint4*>(zr + 24);
#pragma unroll
    for (int e8 = 0; e8 < 4; ++e8) {
      const uint4 zz = e8 == 0 ? zq0 : (e8 == 1 ? zq1 : (e8 == 2 ? zq2 : zq3));
      const u32 zw[4] = {zz.x, zz.y, zz.z, zz.w};
      u32 w[4];
#pragma unroll
      for (int q = 0; q < 4; ++q) {
        const int e = e8 * 8 + 2 * q;
        const float o0 = v[e] * rinv * on[sl * 32 + e] * siluf_fast(bflo(zw[q]));
        const float o1 = v[e + 1] * rinv * on[sl * 32 + e + 1] * siluf_fast(bfhi(zw[q]));
        w[q] = pk2(o0, o1);
      }
      *reinterpret_cast<uint4*>(mr + e8 * 8) = make_uint4(w[0], w[1], w[2], w[3]);
    }
    __syncthreads();
  }
}

DI void phase_lru_conv(const Params& p) {
  const u16* ur = (const u16*)(p.ws + WS_UR);
  u16* xc = (u16*)(p.ws + WS_XC);
  const float* cw = p.in[I_OCONVW];
  const float* cb = p.in[I_OCONVB];
  const size_t total = (size_t)MROWS * 128;
  for (size_t idx = (size_t)blockIdx.x * 256 + opaque_tid(); idx < total; idx += (size_t)gridDim.x * 256) {
    const int row = (int)(idx >> 7), c0 = (int)(idx & 127) * 8;
    int pos, slen;
    if (row < LAT0) { pos = row & (CTXL - 1); slen = CTXL; } else { pos = (row - LAT0) & (SEQ - 1); slen = SEQ; }
    float a[8];
#pragma unroll
    for (int e = 0; e < 8; ++e) a[e] = cb[c0 + e];
#pragma unroll
    for (int j = 0; j < 4; ++j) {
      const int pp = pos + j - 2;
      if (pp >= 0 && pp < slen) {
        const uint4 v = *reinterpret_cast<const uint4*>(ur + (size_t)(row + j - 2) * DM + c0);
        const float4 w0 = *reinterpret_cast<const float4*>(cw + j * 1024 + c0);
        const float4 w1 = *reinterpret_cast<const float4*>(cw + j * 1024 + c0 + 4);
        a[0] += w0.x * bflo(v.x); a[1] += w0.y * bfhi(v.x); a[2] += w0.z * bflo(v.y); a[3] += w0.w * bfhi(v.y);
        a[4] += w1.x * bflo(v.z); a[5] += w1.y * bfhi(v.z); a[6] += w1.z * bflo(v.w); a[7] += w1.w * bfhi(v.w);
      }
    }
    *reinterpret_cast<uint4*>(xc + (size_t)row * DM + c0) = make_uint4(pk2(a[0], a[1]), pk2(a[2], a[3]), pk2(a[4], a[5]), pk2(a[6], a[7]));
  }
}

DI int chunk_row0(int b, int n) { return n < 4 ? b * CTXL + n * 64 : LAT0 + b * SEQ + (n - 4) * 64; }
DI void phase_lru_pass1(const Params& p) {
  const u16* ab = (const u16*)(p.ws + WS_AB);
  float* ph = (float*)(p.ws + WS_PH);
  const int total = 2 * 2 * NCH * 512;
  for (int idx = blockIdx.x * 256 + opaque_tid(); idx < total; idx += gridDim.x * 256) {
    const int cp = idx & 511, n = (idx >> 9) % NCH, b = ((idx >> 9) / NCH) & 1, d = (idx >> 9) / (2 * NCH);
    const u16* la = ab + (size_t)d * 2 * MROWS * DM + (size_t)chunk_row0(b, n) * DM + 2 * cp;
    const u16* bb = la + (size_t)MROWS * DM;
    float P0 = 0.f, H0 = 0.f, P1 = 0.f, H1 = 0.f;
#pragma unroll 8
    for (int i = 0; i < 64; ++i) {
      const int t = d ? 63 - i : i;
      const u32 lg = *reinterpret_cast<const u32*>(la + (size_t)t * DM);
      const u32 bv = *reinterpret_cast<const u32*>(bb + (size_t)t * DM);
      const float l0 = bflo(lg), l1 = bfhi(lg);
      H0 = __expf(l0) * H0 + bflo(bv); P0 += l0;
      H1 = __expf(l1) * H1 + bfhi(bv); P1 += l1;
    }
    const size_t o = ((size_t)((d * 2 + b) * NCH + n) * 1024 + 2 * cp) * 2;
    *reinterpret_cast<float4*>(ph + o) = make_float4(P0, H0, P1, H1);
  }
}
DI void phase_lru_pass2(const Params& p) {
  const float2* __restrict__ ph = (const float2*)(p.ws + WS_PH);
  float* __restrict__ cin = (float*)(p.ws + WS_CIN);
  const int total = 2 * 2 * 1024;
  for (int idx = blockIdx.x * 256 + opaque_tid(); idx < total; idx += gridDim.x * 256) {
    const int ch = idx & 1023, b = (idx >> 10) & 1, d = idx >> 11;
    float hcar = 0.f;
    for (int s0 = 0; s0 < NCH; s0 += 20) {
      float2 v[20];
#pragma unroll
      for (int u = 0; u < 20; ++u) {
        const int step = s0 + u;
        const int n = d ? (step < 4 ? 3 - step : 263 - step) : step;
        v[u] = ph[(size_t)((d * 2 + b) * NCH + n) * 1024 + ch];
      }
#pragma unroll
      for (int u = 0; u < 20; ++u) {
        const int step = s0 + u;
        const int n = d ? (step < 4 ? 3 - step : 263 - step) : step;
        cin[(size_t)((d * 2 + b) * NCH + n) * 1024 + ch] = hcar;
        hcar = __expf(v[u].x) * hcar + v[u].y;
      }
    }
  }
}
DI float gelu_tanh(float x) {
  const float u = 0.7978845608028654f * (x + 0.044715f * x * x * x);
  const float t = 1.f - 2.f * __builtin_amdgcn_rcpf(1.f + __expf(2.f * u));
  return 0.5f * x * (1.f + t);
}
DI void phase_lru_pass3(const Params& p) {
  const u16* ab = (const u16*)(p.ws + WS_AB);
  const float* cin = (const float*)(p.ws + WS_CIN);
  u16* ug = (u16*)(p.ws + WS_UG);
  const int total = 2 * 256 * 512;
  for (int idx = blockIdx.x * 256 + opaque_tid(); idx < total; idx += gridDim.x * 256) {
    const int cp = idx & 511, nl = (idx >> 9) & 255, b = idx >> 17, n = nl + 4;
    const size_t rowoff = (size_t)chunk_row0(b, n) * DM + 2 * cp;
    u32 hf[64];
    {
      const u16* la = ab + rowoff;
      const u16* bb = la + (size_t)MROWS * DM;
      const float2 c2 = *reinterpret_cast<const float2*>(cin + (size_t)((0 * 2 + b) * NCH + n) * 1024 + 2 * cp);
      float h0 = c2.x, h1 = c2.y;
#pragma unroll
      for (int i = 0; i < 64; ++i) {
        const u32 lg = *reinterpret_cast<const u32*>(la + (size_t)i * DM);
        const u32 bv = *reinterpret_cast<const u32*>(bb + (size_t)i * DM);
        h0 = __expf(bflo(lg)) * h0 + bflo(bv);
        h1 = __expf(bfhi(lg)) * h1 + bfhi(bv);
        hf[i] = pk2(h0, h1);
      }
    }
    {
      const u16* la = ab + (size_t)2 * MROWS * DM + rowoff;
      const u16* bb = la + (size_t)MROWS * DM;
      const float2 c2 = *reinterpret_cast<const float2*>(cin + (size_t)((1 * 2 + b) * NCH + n) * 1024 + 2 * cp);
      float h0 = c2.x, h1 = c2.y;
      u16* y = ug + ((size_t)(b * SEQ + nl * 64)) * DM + 2 * cp;
#pragma unroll
      for (int g4 = 3; g4 >= 0; --g4) {
        u32 yv[16], lgv[16], bvv[16];
#pragma unroll
        for (int i = 0; i < 16; ++i) {
          yv[i] = *reinterpret_cast<const u32*>(y + (size_t)(g4 * 16 + i) * DM);
          lgv[i] = *reinterpret_cast<const u32*>(la + (size_t)(g4 * 16 + i) * DM);
          bvv[i] = *reinterpret_cast<const u32*>(bb + (size_t)(g4 * 16 + i) * DM);
        }
#pragma unroll
        for (int i = 15; i >= 0; --i) {
          h0 = __expf(bflo(lgv[i])) * h0 + bflo(bvv[i]);
          h1 = __expf(bfhi(lgv[i])) * h1 + bfhi(bvv[i]);
          const u32 f = hf[g4 * 16 + i];
          *reinterpret_cast<u32*>(y + (size_t)(g4 * 16 + i) * DM) =
              pk2(gelu_tanh(bflo(yv[i])) * (bflo(f) + h0), gelu_tanh(bfhi(yv[i])) * (bfhi(f) + h1));
        }
      }
    }
  }
}
#define XB_TMO      128
#define XB_XCNT(j)  (256  + 64 * (j))
#define XB_XSUB(j)  (1280 + 64 * (j))
#define XB_XGEN(j)  (2304 + 64 * (j))
#define XB_TOP      3328
#define XB_TOPGEN   3392
#define XCD_BAR_WORDS 3456
#define XB_SPIN_CAP (1u << 18)
#define LAS __attribute__((address_space(3)))

__device__ __forceinline__ unsigned xb_ld(unsigned* p)              { return __hip_atomic_load(p, __ATOMIC_RELAXED, __HIP_MEMORY_SCOPE_AGENT); }
__device__ __forceinline__ unsigned xb_add(unsigned* p, unsigned v) { return __hip_atomic_fetch_add(p, v, __ATOMIC_RELAXED, __HIP_MEMORY_SCOPE_AGENT); }
__device__ __forceinline__ unsigned xb_xcc_id() { return (unsigned)__builtin_amdgcn_s_getreg((3 << 11) | 20) & 0xFu; }
#define XB_SPIN(cond, bar) do { unsigned _sp = 0; while (cond) { __builtin_amdgcn_s_sleep(1); \
    if ((++_sp & 255u) == 0u) { if (xb_ld(&(bar)[XB_TMO])) break; if (_sp > XB_SPIN_CAP) { atomicAdd(&(bar)[XB_TMO], 1u); break; } } } } while (0)

struct XcdBarrier {
    unsigned* bar; unsigned x;
    volatile LAS unsigned* st;
};

__device__ __forceinline__ XcdBarrier xcd_barrier_post(unsigned* bar, volatile LAS unsigned* st) {
    XcdBarrier b; b.bar = bar; b.x = xb_xcc_id(); b.st = st;
    if (threadIdx.x == 0) (void)xb_add(&bar[XB_XCNT(b.x)], 1u);
    return b;
}
__device__ __forceinline__ void xcd_barrier_complete(unsigned* bar, unsigned x, unsigned& nloc, unsigned& nx) {
    const unsigned G = gridDim.x * gridDim.y * gridDim.z;
    unsigned sum, cnt, mine, sp = 0u;
    for (;;) {
        sum = 0u; cnt = 0u; mine = 0u;
#pragma unroll
        for (unsigned j = 0; j < 16; ++j) { const unsigned c = xb_ld(&bar[XB_XCNT(j)]); sum += c; cnt += (c > 0u) ? 1u : 0u; mine = (j == x) ? c : mine; }
        if (sum == G) break;
        __builtin_amdgcn_s_sleep(1);
        if ((++sp & 255u) == 0u) { if (xb_ld(&bar[XB_TMO])) break; if (sp > XB_SPIN_CAP) { atomicAdd(&bar[XB_TMO], 1u); break; } }
    }
    nloc = mine > 0u ? mine : 1u; nx = cnt > 0u ? cnt : 1u;
}

__device__ __forceinline__ void xcd_barrier(const XcdBarrier& b) {
    asm volatile("s_waitcnt vmcnt(0)" ::: "memory");
    __syncthreads();
    if (opaque_tid() == 0) {
        unsigned* bar = b.bar;
        __builtin_amdgcn_s_waitcnt(0);
        unsigned nloc = b.st[0], nx = b.st[1];
        if (nloc == 0u) { xcd_barrier_complete(bar, b.x, nloc, nx); b.st[0] = nloc; b.st[1] = nx; }
        const unsigned old = xb_add(&bar[XB_XSUB(b.x)], 1u);
        const unsigned gen = old / nloc;
        if (old + 1u == (gen + 1u) * nloc) {
            __builtin_amdgcn_fence(__ATOMIC_RELEASE, "agent");
            asm volatile("s_waitcnt vmcnt(0)" ::: "memory");
            const unsigned og = xb_add(&bar[XB_TOP], 1u);
            const unsigned tg = og / nx;
            if (og + 1u == (tg + 1u) * nx) xb_add(&bar[XB_TOPGEN], 1u);
            else XB_SPIN(xb_ld(&bar[XB_TOPGEN]) == tg, bar);
            __builtin_amdgcn_fence(__ATOMIC_ACQUIRE, "agent");
            xb_add(&bar[XB_XGEN(b.x)], 1u);
            asm volatile("s_waitcnt vmcnt(0)" ::: "memory");
        } else {
            XB_SPIN(xb_ld(&bar[XB_XGEN(b.x)]) == gen, bar);
            __builtin_amdgcn_fence(__ATOMIC_ACQUIRE, "agent");
            asm volatile("s_waitcnt vmcnt(0)" ::: "memory");
        }
    }
    __syncthreads();
}


template <int PH>
DI void run_phase(const Params& p, char* smem) {
  char* ws = p.ws;
  const float* MOD = (const float*)(ws + WS_MOD);
  float* HC = (float*)(ws + WS_HCTX);
  if constexpr (PH == 0) { phase_convert(p, smem); phase_mod(p, smem); }
  else if constexpr (PH == 1) phase_modulate(p.in[I_CTX], p.in[I_X], p.in[I_EN1], MOD, 0, 0, (u16*)(ws + WS_A));
  else if constexpr (PH == 2) {
    EpiIn0 e{(u16*)((char*)p.out + DO_QK), (u16*)(ws + WS_VRAW), (u16*)(ws + WS_U0G), (u16*)(ws + WS_Z), (float*)(ws + WS_G0)};
    gemm_phase4((const u16*)(ws + WS_A), 1024, (const u16*)(ws + WS_WT0IN), 1024, 1024, 0, 130, 29, smem, e);
  }
  else if constexpr (PH == 3) phase_da_prep(p, smem);
  else if constexpr (PH == 4) phase_gdn_prep(p, smem);
  else if constexpr (PH == 5) { }
  else if constexpr (PH == 6) { if (blockIdx.x < 16) gdn_scan_chain(p, smem, blockIdx.x); phase_da_attn(p, smem); }
  else if constexpr (PH == 7) phase_gdn_finish(p, smem);
  else if constexpr (PH == 8) {
    EpiResid e{p.in[I_CTX], p.in[I_X], HC, p.out, MOD + 2 * 1024};
    gemm_phase((const u16*)(ws + WS_MIX), 1024, (const u16*)(ws + WS_WT0OUT), 1024, 1024, 0, 260, 8, 1 << 20, smem, e);
  }
  else if constexpr (PH == 9) phase_modulate(HC, p.out, p.in[I_EN2], MOD, 3, 0, (u16*)(ws + WS_A));
  else if constexpr (PH == 10) {
    EpiSwiglu e{(u16*)(ws + WS_ACT)};
    gemm_phase4((const u16*)(ws + WS_A), 1024, (const u16*)(ws + WS_WT0GU), 1024, 1024, 0, 130, 44, smem, e);
  }
  else if constexpr (PH == 11) {
    EpiResid e{HC, p.out, HC, p.out, MOD + 5 * 1024};
    gemm_phase((const u16*)(ws + WS_ACT), FFH, (const u16*)(ws + WS_WT0DN), FFH, FFH, 0, 260, 8, 1 << 20, smem, e);
  }
  else if constexpr (PH == 12) phase_modulate(HC, p.out, p.in[I_ON1], MOD + 3 * 6144, 0, 0, (u16*)(ws + WS_A));
  else if constexpr (PH == 13) {
    EpiIn1 e{(u16*)(ws + WS_UG), (u16*)(ws + WS_UR)};
    gemm_phase4((const u16*)(ws + WS_A), 1024, (const u16*)(ws + WS_WT1IN), 1024, 1024, 0, 130, 16, smem, e);
  }
  else if constexpr (PH == 14) phase_lru_conv(p);
  else if constexpr (PH == 15) {
    EpiGates e{(const u16*)(ws + WS_XC), (u16*)(ws + WS_AB), p.in[I_OBR], p.in[I_OBI], p.in[I_OLAM]};
    gemm_phase((const u16*)(ws + WS_XC), 1024, (const u16*)(ws + WS_WT1G), 128, 128, 0, 260, 32, 4, smem, e);
  }
  else if constexpr (PH == 16) phase_lru_pass1(p);
  else if constexpr (PH == 17) phase_lru_pass2(p);
  else if constexpr (PH == 18) phase_lru_pass3(p);
  else if constexpr (PH == 19) {
    EpiResid e{nullptr, p.out, nullptr, p.out, MOD + 3 * 6144 + 2 * 1024};
    gemm_phase((const u16*)(ws + WS_UG) - (size_t)LAT0 * DM, 1024, (const u16*)(ws + WS_WT1OUT), 1024, 1024, 4, 256, 8, 1 << 20, smem, e);
  }
  else if constexpr (PH == 20) phase_modulate(HC, p.out, p.in[I_ON2], MOD + 3 * 6144, 3, LAT0, (u16*)(ws + WS_A));
  else if constexpr (PH == 21) {
    EpiSwiglu e{(u16*)(ws + WS_ACT)};
    gemm_phase4((const u16*)(ws + WS_A), 1024, (const u16*)(ws + WS_WT1GU), 1024, 1024, 2, 128, 44, smem, e);
  }
  else if constexpr (PH == 22) {
    EpiResid e{nullptr, p.out, nullptr, p.out, MOD + 3 * 6144 + 5 * 1024};
    gemm_phase((const u16*)(ws + WS_ACT), FFH, (const u16*)(ws + WS_WT1DN), FFH, FFH, 4, 256, 8, 1 << 20, smem, e);
  }
}
constexpr int NPHASE = 23;

#if MULTI_LAUNCH
template <int PH>
__global__ void __launch_bounds__(256, 2) phase_kernel(Params p) {
  __shared__ __attribute__((aligned(16))) char smem[SMEM_BYTES];
  run_phase<PH>(p, smem);
}
template <int PH>
static void launch_all(const Params& p, int grid, hipStream_t stream) {
  if constexpr (PH < NPHASE) {
    hipLaunchKernelGGL(phase_kernel<PH>, dim3(grid), dim3(256), 0, stream, p);
    launch_all<PH + 1>(p, grid, stream);
  }
}
#else
template <int PH>
DI void run_all(const Params& p, char* smem, cg::grid_group& grid, const XcdBarrier& xb) {
  if constexpr (PH < NPHASE) {
    run_phase<PH>(p, smem);
    if constexpr (PH == PROBE_DUP || PH == PROBE_DUP2) { xcd_barrier(xb); run_phase<PH>(p, smem); }
    if constexpr (PH == 0) grid.sync();
    else if constexpr (PH + 1 < NPHASE && PH != 5) xcd_barrier(xb);
    run_all<PH + 1>(p, smem, grid, xb);
  }
}
__global__ void __launch_bounds__(256, 2) mega_kernel(Params p) {
  __shared__ __attribute__((aligned(16))) char smem[SMEM_BYTES];
  __shared__ uint4 xb_words;
  if (threadIdx.x == 0) xb_words = make_uint4(0u, 0u, 0u, 0u);
  if ((threadIdx.x & 63) == 0) g_wtab[hw_wave_slot()] = threadIdx.x >> 6;
  __syncthreads();
  cg::grid_group grid = cg::this_grid();
  XcdBarrier xb = xcd_barrier_post((unsigned*)(p.ws + WS_BAR), (volatile LAS unsigned*)&xb_words);
  for (int i = 0; i < PROBE_SYNCS; ++i) xcd_barrier(xb);
  run_all<0>(p, smem, grid, xb);
}
#endif

extern "C" void kernel_launch(void* const* d_in, const int* in_sizes, int n_in, void* d_out, int out_size, void* d_ws, size_t ws_size,
                              hipStream_t stream) {
  if (n_in != 38 || ws_size < WS_NEED || out_size != 2 * SEQ * DM) {
    fprintf(stderr, "kernel_launch: unexpected shapes (n_in %d, ws %zu, out %d)\n", n_in, ws_size, out_size);
    return;
  }
  Params p{};
  for (int i = 0; i < 38; ++i) p.in[i] = (const float*)d_in[i];
  p.out = (float*)d_out;
  p.ws = (char*)d_ws;
#if MULTI_LAUNCH
  launch_all<0>(p, 512, stream);
#else
  static int grid_blocks = 0;
  if (!grid_blocks) {
    int dev = 0, cus = 0, per_cu = 0;
    hipGetDevice(&dev);
    hipDeviceGetAttribute(&cus, hipDeviceAttributeMultiprocessorCount, dev);
    hipOccupancyMaxActiveBlocksPerMultiprocessor(&per_cu, mega_kernel, 256, 0);
    if (per_cu < 1) per_cu = 1;
    if (per_cu > 2) per_cu = 2;
    grid_blocks = cus * per_cu;
  }
  (void)hipMemsetAsync((char*)d_ws + WS_CNT, 0, 65536 + XCD_BAR_WORDS * 4, stream);
  void* args[] = {&p};
  hipError_t e = hipLaunchCooperativeKernel((void*)mega_kernel, dim3(grid_blocks), dim3(256), args, 0, stream);
  if (e != hipSuccess) fprintf(stderr, "cooperative launch failed: %s (grid %d)\n", hipGetErrorString(e), grid_blocks);
#endif
}
```
